# Optimizing an MI355X kernel written in HIP

```python
import jax
import jax.numpy as jnp
from jax import lax
import numpy as np

D_MODEL = 1024
BATCH = 8
SEQ = 8192
DEPTH = 4

D_MIX = D_MODEL
HEAD_DIM = 64
ATTN_WIDTH = D_MIX // 2
ATTN_HEADS = ATTN_WIDTH // HEAD_DIM
DILATED_BRANCHES = ((128, 1), (512, 4), (2048, 16))
BAND = 128
ROPE_THETA = 10000.0
SGU_WIDTH = D_MIX // 4
SGU_GROUPS = 4
SGU_GROUP_DIM = SGU_WIDTH // SGU_GROUPS
SGU_CHUNK = 128
CONV_WIDTH = D_MIX - ATTN_WIDTH - SGU_WIDTH
CONV_TAPS = 3
PROJ_SIZES = (ATTN_WIDTH, ATTN_WIDTH, ATTN_WIDTH, SGU_WIDTH, SGU_WIDTH, CONV_WIDTH, CONV_WIDTH, CONV_WIDTH)
PROJ_WIDTH = 3 * ATTN_WIDTH + 2 * SGU_WIDTH + 3 * CONV_WIDTH
MOE_GROUPS = 4
EXPERTS_PER_GROUP = 8
N_EXPERTS = MOE_GROUPS * EXPERTS_PER_GROUP
TOP_K_INNER = 2
D_EXPERT = D_MODEL // 2
MOE_BLOCK = 256
ALPHA = (2.0 * DEPTH) ** 0.25
BETA = (8.0 * DEPTH) ** -0.25
EPS = 1e-5

kernel_name = 'hybrid_dilated_sgu_conv_hmoe'


def layer_norm(t, g, b):
    t32 = t.astype(jnp.float32)
    mu = jnp.mean(t32, -1, keepdims=True)
    var = jnp.mean(jnp.square(t32 - mu), -1, keepdims=True)
    return ((t32 - mu) * lax.rsqrt(var + EPS) * g + b).astype(t.dtype)


def rms_norm(t, g):
    t32 = t.astype(jnp.float32)
    return (t32 * lax.rsqrt(jnp.mean(jnp.square(t32), -1, keepdims=True) + EPS) * g).astype(t.dtype)


def rope(t):
    seq, hd = t.shape[1], t.shape[-1]
    half = hd // 2
    inv_freq = ROPE_THETA ** (-jnp.arange(half, dtype=jnp.float32) / half)
    ang = jnp.arange(seq, dtype=jnp.float32)[:, None] * inv_freq[None, :]
    cos = jnp.cos(ang)[None, :, None, :]
    sin = jnp.sin(ang)[None, :, None, :]
    t32 = t.astype(jnp.float32)
    t1, t2 = t32[..., :half], t32[..., half:]
    return jnp.concatenate([t1 * cos - t2 * sin, t2 * cos + t1 * sin], -1).astype(t.dtype)


def _to_strided(t, d, nb):
    b, s, h, hd = t.shape
    m = s // d
    t = t.reshape(b, m, d, h, hd).transpose(0, 2, 3, 1, 4)
    t = jnp.pad(t, ((0, 0), (0, 0), (0, 0), (0, nb * BAND - m), (0, 0)))
    return t.reshape(b, d, h, nb, BAND, hd)


def _with_prev(t):
    prev = jnp.pad(t[:, :, :, :-1], ((0, 0), (0, 0), (0, 0), (1, 0), (0, 0), (0, 0)))
    return jnp.concatenate([prev, t], axis=4)


def dilated_branch(q, k, v, d, n_back):
    b, s, h, hd = q.shape
    m = s // d
    nb = -(-m // BAND)
    qs = _to_strided(q, d, nb)
    ks = _with_prev(_to_strided(k, d, nb))
    vs = _with_prev(_to_strided(v, d, nb))
    sc = jnp.einsum('bdhnqc,bdhnkc->bdhnqk', qs, ks).astype(jnp.float32)
    qi = jnp.arange(BAND)[:, None] + BAND
    ki = jnp.arange(2 * BAND)[None, :]
    dist = qi - ki
    in_band = (dist >= 0) & (dist <= n_back)
    has_prev = (jnp.arange(nb)[:, None, None] > 0) | (ki[None] >= BAND)
    mask = in_band[None] & has_prev
    sc = jnp.where(mask, sc, -jnp.inf)
    mx = jnp.max(sc, -1, keepdims=True)
    p = jnp.exp(sc - mx)
    den = jnp.sum(p, -1, keepdims=True)
    o = jnp.einsum('bdhnqk,bdhnkc->bdhnqc', p, vs.astype(jnp.float32)) / den
    lse = (mx + jnp.log(den))[..., 0]
    o = o.reshape(b, d, h, nb * BAND, hd)[:, :, :, :m].transpose(0, 3, 1, 2, 4).reshape(b, s, h, hd)
    lse = lse.reshape(b, d, h, nb * BAND)[:, :, :, :m].transpose(0, 3, 1, 2).reshape(b, s, h)
    return o, lse


def dilated_attention(q, k, v):
    b, s, _ = q.shape
    q = rope(q.reshape(b, s, ATTN_HEADS, HEAD_DIM)) * (HEAD_DIM ** -0.5)
    k = rope(k.reshape(b, s, ATTN_HEADS, HEAD_DIM))
    v = v.reshape(b, s, ATTN_HEADS, HEAD_DIM)
    outs, lses = [], []
    for window, dil in DILATED_BRANCHES:
        o, l = dilated_branch(q, k, v, dil, window // dil)
        outs.append(o)
        lses.append(l)
    wts = jax.nn.softmax(jnp.stack(lses), axis=0)
    out = jnp.sum(wts[..., None] * jnp.stack(outs), axis=0)
    return out.reshape(b, s, ATTN_WIDTH).astype(q.dtype)


def spatial_gating(u, z, gain, w_s, b_s):
    b, s, _ = u.shape
    nc = s // SGU_CHUNK
    u = jax.nn.gelu(u)
    z = jax.nn.gelu(z).reshape(b, s, SGU_GROUPS, SGU_GROUP_DIM).astype(jnp.float32)
    mu = jnp.mean(z, -1, keepdims=True)
    var = jnp.mean(jnp.square(z - mu), -1, keepdims=True)
    z = (z - mu) * lax.rsqrt(var + EPS) * gain.reshape(SGU_GROUPS, SGU_GROUP_DIM)
    z = z.reshape(b, nc, SGU_CHUNK, SGU_GROUPS, SGU_GROUP_DIM)
    causal = jnp.tril(jnp.ones((SGU_CHUNK, SGU_CHUNK), dtype=bool))
    w = jnp.where(causal[None], w_s, 0)
    sp = jnp.einsum('gts,bnsgc->bntgc', w, z) + b_s.T[None, None, :, :, None]
    return (u * sp.reshape(b, s, SGU_WIDTH)).astype(u.dtype)


def short_conv(gb, gc, h, conv_w):
    z = gc * h
    y = lax.conv_general_dilated(z, conv_w[:, None, :], window_strides=(1,), padding=((CONV_TAPS - 1, 0),), dimension_numbers=('NWC', 'WIO', 'NWC'), feature_group_count=CONV_WIDTH)
    return gb * y


def hierarchical_moe(x, wg, bg, we, be, w_gate, w_up, w_down):
    b, s, dm = x.shape
    n = b * s
    xt = x.reshape(n, dm)
    g_logit = (xt @ wg).astype(jnp.float32) + bg.astype(jnp.float32)
    g_prob = jax.nn.softmax(g_logit, -1)
    _, g_idx = lax.top_k(g_logit, 1)
    g_p = jnp.take_along_axis(g_prob, g_idx, axis=1)
    e_logit = ((xt @ we).astype(jnp.float32) + be.astype(jnp.float32)).reshape(n, MOE_GROUPS, EXPERTS_PER_GROUP)
    e_logit = jnp.take_along_axis(e_logit, jnp.broadcast_to(g_idx[:, :, None], (n, 1, EXPERTS_PER_GROUP)), axis=1)[:, 0]
    top_logit, top_local = lax.top_k(e_logit, TOP_K_INNER)
    gate = g_p * jax.nn.softmax(top_logit, -1)
    expert = g_idx * EXPERTS_PER_GROUP + top_local
    n_assign = n * TOP_K_INNER
    e_flat = expert.reshape(n_assign)
    tok_flat = jnp.repeat(jnp.arange(n, dtype=jnp.int32), TOP_K_INNER)
    order = jnp.argsort(e_flat, stable=True)
    e_sorted = e_flat[order]
    tok_sorted = tok_flat[order]
    gate_sorted = gate.reshape(n_assign)[order]
    counts = jnp.bincount(e_flat, length=N_EXPERTS)
    padded = (counts + MOE_BLOCK - 1) // MOE_BLOCK * MOE_BLOCK
    pad_end = jnp.cumsum(padded)
    pad_start = pad_end - padded
    cnt_start = jnp.cumsum(counts) - counts
    dest = pad_start[e_sorted] + jnp.arange(n_assign, dtype=jnp.int32) - cnt_start[e_sorted]
    n_blocks = (n_assign + N_EXPERTS * (MOE_BLOCK - 1) + MOE_BLOCK - 1) // MOE_BLOCK
    row_tok = jnp.full((n_blocks * MOE_BLOCK,), n, jnp.int32).at[dest].set(tok_sorted)
    block_expert = jnp.minimum(jnp.searchsorted(pad_end, jnp.arange(n_blocks, dtype=jnp.int32) * MOE_BLOCK, side='right'), N_EXPERTS - 1)
    x_pad = jnp.concatenate([xt, jnp.zeros((1, dm), xt.dtype)], 0)

    def run_block(args):
        rows, e = args
        xb = x_pad[rows]
        hdn = jax.nn.silu(xb @ w_gate[e]) * (xb @ w_up[e])
        return hdn @ w_down[e]

    y_rows = lax.map(run_block, (row_tok.reshape(n_blocks, MOE_BLOCK), block_expert)).reshape(n_blocks * MOE_BLOCK, dm)
    y_assign = y_rows[dest] * gate_sorted[:, None].astype(y_rows.dtype)
    out = jax.ops.segment_sum(y_assign, tok_sorted, num_segments=n)
    return out.reshape(b, s, dm)


def setup_inputs(seed: int = 0) -> dict:
    key = jax.random.key(seed)
    ks = jax.random.split(key, 17)

    def nrm(k, shape, scale):
        return jax.random.normal(k, shape, jnp.float32) * scale

    return {
        'x': nrm(ks[0], (BATCH, SEQ, D_MODEL), 1.0),
        'w_in': nrm(ks[1], (DEPTH, D_MODEL, PROJ_WIDTH), D_MODEL ** -0.5),
        'w_out': nrm(ks[2], (DEPTH, D_MIX, D_MODEL), BETA * D_MIX ** -0.5),
        'branch_gain': 1.0 + nrm(ks[3], (DEPTH, D_MIX), 0.02),
        'sgu_gain': 1.0 + nrm(ks[4], (DEPTH, SGU_WIDTH), 0.02),
        'sgu_w': nrm(ks[5], (DEPTH, SGU_GROUPS, SGU_CHUNK, SGU_CHUNK), SGU_CHUNK ** -0.5),
        'sgu_b': 1.0 + nrm(ks[6], (DEPTH, SGU_GROUPS, SGU_CHUNK), 0.1),
        'conv_w': nrm(ks[7], (DEPTH, CONV_TAPS, CONV_WIDTH), CONV_TAPS ** -0.5),
        'ln_gain': 1.0 + nrm(ks[8], (DEPTH, 2, D_MODEL), 0.02),
        'ln_bias': nrm(ks[9], (DEPTH, 2, D_MODEL), 0.02),
        'router_group_w': nrm(ks[10], (DEPTH, D_MODEL, MOE_GROUPS), D_MODEL ** -0.5),
        'router_group_b': nrm(ks[11], (DEPTH, MOE_GROUPS), 0.01),
        'router_expert_w': nrm(ks[12], (DEPTH, D_MODEL, N_EXPERTS), D_MODEL ** -0.5),
        'router_expert_b': nrm(ks[13], (DEPTH, N_EXPERTS), 0.01),
        'expert_w_gate': nrm(ks[14], (DEPTH, N_EXPERTS, D_MODEL, D_EXPERT), D_MODEL ** -0.5),
        'expert_w_up': nrm(ks[15], (DEPTH, N_EXPERTS, D_MODEL, D_EXPERT), D_MODEL ** -0.5),
        'expert_w_down': nrm(ks[16], (DEPTH, N_EXPERTS, D_EXPERT, D_MODEL), BETA * D_EXPERT ** -0.5),
    }


def reference(x, w_in, w_out, branch_gain, sgu_gain, sgu_w, sgu_b, conv_w, ln_gain, ln_bias, router_group_w, router_group_b, router_expert_w, router_expert_b, expert_w_gate, expert_w_up, expert_w_down):
    a_end = ATTN_WIDTH
    b_end = ATTN_WIDTH + SGU_WIDTH
    split_at = []
    acc = 0
    for size in PROJ_SIZES[:-1]:
        acc += size
        split_at.append(acc)
    for l in range(DEPTH):
        proj = x @ w_in[l]
        q, k, v, u, z, gb, gc, h = jnp.split(proj, split_at, axis=-1)
        y_a = dilated_attention(q, k, v)
        y_b = spatial_gating(u, z, sgu_gain[l], sgu_w[l], sgu_b[l])
        y_c = short_conv(gb, gc, h, conv_w[l])
        g = branch_gain[l]
        mixed = jnp.concatenate([rms_norm(y_a, g[:a_end]), rms_norm(y_b, g[a_end:b_end]), rms_norm(y_c, g[b_end:])], axis=-1)
        x = layer_norm(ALPHA * x + mixed @ w_out[l], ln_gain[l, 0], ln_bias[l, 0])
        ffn = hierarchical_moe(x, router_group_w[l], router_group_b[l], router_expert_w[l], router_expert_b[l], expert_w_gate[l], expert_w_up[l], expert_w_down[l])
        x = layer_norm(ALPHA * x + ffn, ln_gain[l, 1], ln_bias[l, 1])
    return x
```

```cpp
#include <hip/hip_runtime.h>
#include <cstdio>
#include <cstdint>
#include <cmath>
namespace nv {
constexpr int D_MODEL = 1024, BATCH = 8, SEQ = 8192, DEPTH = 4, NTOK = BATCH * SEQ;
constexpr int PW = 2816;
constexpr int OQ = 0, OK_ = 512, OV = 1024, OU = 1536, OZ = 1792, OGB = 2048, OGC = 2304, OH = 2560;
constexpr int NEXP = 32, DEXP = 512;
constexpr float EPS = 1e-5f;
constexpr float ALPHA = 1.6817928305074290f;
constexpr int LCAP = 2 * NTOK;

__device__ __forceinline__ float gelu_tanh(float x) {
    const float c = 0.7978845608028654f;
    return 0.5f * x * (1.0f + tanhf(c * (x + 0.044715f * x * x * x)));
}
__device__ __forceinline__ float wsum(float v) {
#pragma unroll
    for (int o = 32; o > 0; o >>= 1) v += __shfl_xor(v, o);
    return v;
}
__device__ __forceinline__ float wmax(float v) {
#pragma unroll
    for (int o = 32; o > 0; o >>= 1) v = fmaxf(v, __shfl_xor(v, o));
    return v;
}

struct GP { const float* A; const float* B; const float* B2; float* C; int M, N, K, lda, ldb, ldc; const int* list; const int* cnt; const float* gate; };
template <int MODE>
__global__ void __launch_bounds__(256) k_gemm(GP p) {
    __shared__ float As[8][128 + 4];
    __shared__ float Bs[8][128];
    __shared__ int rowid[128];
    const int tid = threadIdx.x, e = blockIdx.z;
    int M = p.M;
    const int m0 = blockIdx.y * 128, n0 = blockIdx.x * 128;
    const float* B = p.B; int ldb = p.ldb; int nb = n0;
    if (MODE == 1) { M = p.cnt[e]; if (n0 >= 512) { B = p.B2; nb = n0 - 512; } B += (size_t)e * 1024 * 512; }
    if (MODE == 2) { M = p.cnt[e]; B += (size_t)e * 512 * 1024; }
    if (m0 >= M) return;
    if (tid < 128) { const int r = m0 + tid; int a = -1; if (r < M) a = MODE ? p.list[(size_t)e * LCAP + r] : r; rowid[tid] = a; }
    __syncthreads();
    const int tx = tid & 15, ty = tid >> 4;
    float acc[8][8];
#pragma unroll
    for (int i = 0; i < 8; ++i)
#pragma unroll
        for (int j = 0; j < 8; ++j) acc[i][j] = 0.f;
    const int lr = tid >> 1, lk = (tid & 1) * 4;
    const int la = rowid[lr];
    const int bk = tid >> 5, bn = (tid & 31) * 4;
    for (int k0 = 0; k0 < p.K; k0 += 8) {
        float4 av = make_float4(0.f, 0.f, 0.f, 0.f);
        if (la >= 0) {
            if (MODE == 0) av = *(const float4*)(p.A + (size_t)la * p.lda + k0 + lk);
            if (MODE == 1) av = *(const float4*)(p.A + (size_t)(la >> 1) * p.lda + k0 + lk);
            if (MODE == 2) {
                const float4 g = *(const float4*)(p.A + (size_t)la * p.lda + k0 + lk);
                const float4 u = *(const float4*)(p.A + (size_t)la * p.lda + 512 + k0 + lk);
                av.x = g.x / (1.f + expf(-g.x)) * u.x; av.y = g.y / (1.f + expf(-g.y)) * u.y;
                av.z = g.z / (1.f + expf(-g.z)) * u.z; av.w = g.w / (1.f + expf(-g.w)) * u.w;
            }
        }
        const float4 bv = *(const float4*)(B + (size_t)(k0 + bk) * ldb + nb + bn);
        __syncthreads();
        As[lk + 0][lr] = av.x; As[lk + 1][lr] = av.y; As[lk + 2][lr] = av.z; As[lk + 3][lr] = av.w;
        *(float4*)&Bs[bk][bn] = bv;
        __syncthreads();
#pragma unroll
        for (int k = 0; k < 8; ++k) {
            float a[8], b[8];
            *(float4*)&a[0] = *(const float4*)&As[k][ty * 4];
            *(float4*)&a[4] = *(const float4*)&As[k][64 + ty * 4];
            *(float4*)&b[0] = *(const float4*)&Bs[k][tx * 4];
            *(float4*)&b[4] = *(const float4*)&Bs[k][64 + tx * 4];
#pragma unroll
            for (int i = 0; i < 8; ++i)
#pragma unroll
                for (int j = 0; j < 8; ++j) acc[i][j] = fmaf(a[i], b[j], acc[i][j]);
        }
    }
#pragma unroll
    for (int i = 0; i < 8; ++i) {
        const int lrow = (i < 4) ? (ty * 4 + i) : (64 + ty * 4 + i - 4);
        const int a = rowid[lrow];
        if (a < 0) continue;
#pragma unroll
        for (int jh = 0; jh < 2; ++jh) {
            const int n = n0 + jh * 64 + tx * 4;
            if (MODE == 2) {
                const float gt = p.gate[a];
                float* c = p.C + (size_t)(a >> 1) * p.ldc + n;
#pragma unroll
                for (int j = 0; j < 4; ++j) unsafeAtomicAdd(c + j, gt * acc[i][jh * 4 + j]);
            } else {
                *(float4*)(p.C + (size_t)a * p.ldc + n) = make_float4(acc[i][jh * 4 + 0], acc[i][jh * 4 + 1], acc[i][jh * 4 + 2], acc[i][jh * 4 + 3]);
            }
        }
    }
}

__global__ void __launch_bounds__(256) k_rope(float* proj) {
    const int m = blockIdx.x, h = threadIdx.x >> 5, i = threadIdx.x & 31;
    const int t = m % SEQ;
    const float inv_freq = powf(10000.0f, -(float)i / 32.0f);
    const float ang = (float)t * inv_freq;
    float s, c; sincosf(ang, &s, &c);
    float* q = proj + (size_t)m * PW + OQ + h * 64;
    float* k = proj + (size_t)m * PW + OK_ + h * 64;
    const float q1 = q[i], q2 = q[i + 32], k1 = k[i], k2 = k[i + 32];
    q[i] = (q1 * c - q2 * s) * 0.125f; q[i + 32] = (q2 * c + q1 * s) * 0.125f;
    k[i] = k1 * c - k2 * s; k[i + 32] = k2 * c + k1 * s;
}

__global__ void __launch_bounds__(256) k_attn(const float* proj, float* mixed, int m_base) {
    __shared__ float sq[4][64];
    __shared__ float sp[4][392];
    const int w = threadIdx.x >> 6, lane = threadIdx.x & 63;
    const int m = m_base + (blockIdx.x >> 1), h = (blockIdx.x & 1) * 4 + w;
    const int b = m / SEQ, t = m % SEQ;
    sq[w][lane] = proj[(size_t)m * PW + OQ + h * 64 + lane];
    __syncthreads();
    float sc[7]; float mx = -INFINITY;
#pragma unroll
    for (int r = 0; r < 7; ++r) {
        const int idx = lane + 64 * r; float s = -INFINITY;
        if (idx < 387) {
            const int br = idx / 129, j = idx % 129, d = (br == 0) ? 1 : (br == 1 ? 4 : 16);
            const int tk = t - j * d;
            if (tk >= 0) {
                const float* kr = proj + (size_t)(b * SEQ + tk) * PW + OK_ + h * 64;
                float a = 0.f;
#pragma unroll
                for (int x = 0; x < 16; ++x) { const float4 kv = *(const float4*)(kr + 4 * x); a += sq[w][4 * x] * kv.x + sq[w][4 * x + 1] * kv.y + sq[w][4 * x + 2] * kv.z + sq[w][4 * x + 3] * kv.w; }
                s = a;
            }
        }
        sc[r] = s; mx = fmaxf(mx, s);
    }
    mx = wmax(mx);
    float sum = 0.f;
#pragma unroll
    for (int r = 0; r < 7; ++r) { const int idx = lane + 64 * r; const float pv = (sc[r] == -INFINITY) ? 0.f : expf(sc[r] - mx); sum += pv; if (idx < 387) sp[w][idx] = pv; }
    sum = wsum(sum);
    __syncthreads();
    float o = 0.f;
    for (int idx = 0; idx < 387; ++idx) {
        const int br = idx / 129, j = idx % 129, d = (br == 0) ? 1 : (br == 1 ? 4 : 16);
        const int tk = t - j * d;
        if (tk >= 0) o += sp[w][idx] * proj[(size_t)(b * SEQ + tk) * PW + OV + h * 64 + lane];
    }
    mixed[(size_t)m * 1024 + h * 64 + lane] = o / sum;
}

__global__ void __launch_bounds__(256) k_sgu_prep(float* proj, const float* sgu_gain) {
    const int m = blockIdx.x, g = threadIdx.x >> 6, lane = threadIdx.x & 63;
    float* u = proj + (size_t)m * PW + OU + g * 64 + lane;
    float* z = proj + (size_t)m * PW + OZ + g * 64 + lane;
    *u = gelu_tanh(*u);
    const float zg = gelu_tanh(*z);
    const float mu = wsum(zg) * (1.f / 64.f);
    const float dz = zg - mu;
    const float var = wsum(dz * dz) * (1.f / 64.f);
    *z = dz * rsqrtf(var + EPS) * sgu_gain[g * 64 + lane];
}
__global__ void __launch_bounds__(256) k_sgu(const float* proj, const float* sgu_w, const float* sgu_b, float* mixed) {
    const int m = blockIdx.x, c = threadIdx.x, g = c >> 6;
    const int tl = m & 127;
    const float* wrow = sgu_w + ((size_t)g * 128 + tl) * 128;
    float acc = 0.f;
    for (int s = 0; s <= tl; ++s) acc += wrow[s] * proj[(size_t)(m - tl + s) * PW + OZ + c];
    acc += sgu_b[g * 128 + tl];
    mixed[(size_t)m * 1024 + 512 + c] = proj[(size_t)m * PW + OU + c] * acc;
}
__global__ void __launch_bounds__(256) k_conv(const float* proj, const float* conv_w, float* mixed) {
    const int m = blockIdx.x, c = threadIdx.x, t = m % SEQ;
    float acc = 0.f;
#pragma unroll
    for (int j = 0; j < 3; ++j) { const int tt = t - 2 + j; if (tt >= 0) { const size_t r = (size_t)(m - 2 + j) * PW; acc += conv_w[j * 256 + c] * proj[r + OGC + c] * proj[r + OH + c]; } }
    mixed[(size_t)m * 1024 + 768 + c] = proj[(size_t)m * PW + OGB + c] * acc;
}
__global__ void __launch_bounds__(256) k_rms3(float* mixed, const float* gain) {
    __shared__ float red[4];
    const int m = blockIdx.x, tid = threadIdx.x, w = tid >> 6;
    float* r = mixed + (size_t)m * 1024;
    const float a0 = r[tid], a1 = r[256 + tid];
    float s = wsum(a0 * a0 + a1 * a1);
    if ((tid & 63) == 0) red[w] = s;
    __syncthreads();
    const float ra = rsqrtf((red[0] + red[1] + red[2] + red[3]) * (1.f / 512.f) + EPS);
    __syncthreads();
    const float bv = r[512 + tid];
    s = wsum(bv * bv);
    if ((tid & 63) == 0) red[w] = s;
    __syncthreads();
    const float rb = rsqrtf((red[0] + red[1] + red[2] + red[3]) * (1.f / 256.f) + EPS);
    __syncthreads();
    const float cv = r[768 + tid];
    s = wsum(cv * cv);
    if ((tid & 63) == 0) red[w] = s;
    __syncthreads();
    const float rc = rsqrtf((red[0] + red[1] + red[2] + red[3]) * (1.f / 256.f) + EPS);
    r[tid] = a0 * ra * gain[tid]; r[256 + tid] = a1 * ra * gain[256 + tid];
    r[512 + tid] = bv * rb * gain[512 + tid]; r[768 + tid] = cv * rc * gain[768 + tid];
}
__global__ void __launch_bounds__(256) k_ln_res(float* x, const float* add, const float* g, const float* bta) {
    __shared__ float red[4];
    const int m = blockIdx.x, tid = threadIdx.x, w = tid >> 6;
    const float4 xv = *(const float4*)(x + (size_t)m * 1024 + tid * 4);
    const float4 av = *(const float4*)(add + (size_t)m * 1024 + tid * 4);
    float v[4] = {ALPHA * xv.x + av.x, ALPHA * xv.y + av.y, ALPHA * xv.z + av.z, ALPHA * xv.w + av.w};
    float s = wsum(v[0] + v[1] + v[2] + v[3]);
    if ((tid & 63) == 0) red[w] = s;
    __syncthreads();
    const float mu = (red[0] + red[1] + red[2] + red[3]) * (1.f / 1024.f);
    __syncthreads();
    float q = 0.f;
#pragma unroll
    for (int i = 0; i < 4; ++i) { v[i] -= mu; q += v[i] * v[i]; }
    q = wsum(q);
    if ((tid & 63) == 0) red[w] = q;
    __syncthreads();
    const float rstd = rsqrtf((red[0] + red[1] + red[2] + red[3]) * (1.f / 1024.f) + EPS);
    const float4 gv = *(const float4*)(g + tid * 4), bv = *(const float4*)(bta + tid * 4);
    *(float4*)(x + (size_t)m * 1024 + tid * 4) = make_float4(v[0] * rstd * gv.x + bv.x, v[1] * rstd * gv.y + bv.y, v[2] * rstd * gv.z + bv.z, v[3] * rstd * gv.w + bv.w);
}
__global__ void __launch_bounds__(256) k_router(const float* x, const float* wg, const float* bg, const float* we, const float* be, float* gate, int* list, int* cnt, int* eidx) {
    const int w = threadIdx.x >> 6, lane = threadIdx.x & 63;
    const int m = blockIdx.x * 4 + w;
    float lg[36];
#pragma unroll
    for (int o = 0; o < 36; ++o) lg[o] = 0.f;
    for (int i = 0; i < 16; ++i) {
        const int k = lane + 64 * i;
        const float xv = x[(size_t)m * 1024 + k];
        const float4 g4 = *(const float4*)(wg + (size_t)k * 4);
        lg[0] += xv * g4.x; lg[1] += xv * g4.y; lg[2] += xv * g4.z; lg[3] += xv * g4.w;
#pragma unroll
        for (int j = 0; j < 8; ++j) { const float4 e4 = *(const float4*)(we + (size_t)k * 32 + 4 * j); lg[4 + 4 * j] += xv * e4.x; lg[5 + 4 * j] += xv * e4.y; lg[6 + 4 * j] += xv * e4.z; lg[7 + 4 * j] += xv * e4.w; }
    }
#pragma unroll
    for (int o = 0; o < 36; ++o) lg[o] = wsum(lg[o]);
    if (lane == 0) {
        const float g0 = lg[0] + bg[0], g1 = lg[1] + bg[1], g2 = lg[2] + bg[2], g3 = lg[3] + bg[3];
        float gmax = g0; int gi = 0;
        if (g1 > gmax) { gmax = g1; gi = 1; }
        if (g2 > gmax) { gmax = g2; gi = 2; }
        if (g3 > gmax) { gmax = g3; gi = 3; }
        const float den = expf(g0 - gmax) + expf(g1 - gmax) + expf(g2 - gmax) + expf(g3 - gmax);
        const float gp = 1.f / den;
        float v0 = -INFINITY, v1 = -INFINITY; int i0 = 0, i1 = 0;
#pragma unroll
        for (int j = 0; j < 8; ++j) { float v = 0.f;
#pragma unroll
            for (int gg = 0; gg < 4; ++gg) if (gg == gi) v = lg[4 + gg * 8 + j] + be[gg * 8 + j];
            if (v > v0) { v1 = v0; i1 = i0; v0 = v; i0 = j; } else if (v > v1) { v1 = v; i1 = j; } }
        const float e1 = expf(v1 - v0);
        const float p0 = 1.f / (1.f + e1), p1 = e1 / (1.f + e1);
        gate[2 * m] = gp * p0; gate[2 * m + 1] = gp * p1;
        const int ex0 = gi * 8 + i0, ex1 = gi * 8 + i1;
        eidx[2 * m] = ex0; eidx[2 * m + 1] = ex1;
        const int s0 = atomicAdd(cnt + ex0, 1); list[(size_t)ex0 * LCAP + s0] = 2 * m;
        const int s1 = atomicAdd(cnt + ex1, 1); list[(size_t)ex1 * LCAP + s1] = 2 * m + 1;
    }
}

static void forward(void* const* d_in, float* xbuf, unsigned char* ws, hipStream_t stream) {
    const float* x_in = (const float*)d_in[0];
    const float* w_in = (const float*)d_in[1]; const float* w_out = (const float*)d_in[2];
    const float* branch_gain = (const float*)d_in[3]; const float* sgu_gain = (const float*)d_in[4];
    const float* sgu_w = (const float*)d_in[5]; const float* sgu_b = (const float*)d_in[6]; const float* conv_w = (const float*)d_in[7];
    const float* ln_gain = (const float*)d_in[8]; const float* ln_bias = (const float*)d_in[9];
    const float* rgw = (const float*)d_in[10]; const float* rgb = (const float*)d_in[11]; const float* rew = (const float*)d_in[12]; const float* reb = (const float*)d_in[13];
    const float* ewg = (const float*)d_in[14]; const float* ewu = (const float*)d_in[15]; const float* ewd = (const float*)d_in[16];
    constexpr size_t MB = 1000000;
    float* proj = (float*)ws;
    float* mixed = (float*)(ws + 740 * MB);
    float* tmp = (float*)ws;
    float* GU = (float*)ws;
    float* ffn = (float*)(ws + 540 * MB);
    float* gate = (float*)(ws + 1010 * MB);
    int* eidx = (int*)(ws + 1011 * MB);
    int* cnt = (int*)(ws + 1012 * MB);
    int* list = (int*)(ws + 1013 * MB);
    hipMemcpyAsync(xbuf, x_in, (size_t)NTOK * 1024 * 4, hipMemcpyDeviceToDevice, stream);
    for (int l = 0; l < DEPTH; ++l) {
        { GP p{}; p.A = xbuf; p.B = w_in + (size_t)l * 1024 * PW; p.C = proj; p.M = NTOK; p.N = PW; p.K = 1024; p.lda = 1024; p.ldb = PW; p.ldc = PW;
          hipLaunchKernelGGL(k_gemm<0>, dim3(PW / 128, NTOK / 128, 1), dim3(256), 0, stream, p); }
        hipLaunchKernelGGL(k_rope, dim3(NTOK), dim3(256), 0, stream, proj);
        hipLaunchKernelGGL(k_attn, dim3(NTOK * 2), dim3(256), 0, stream, (const float*)proj, mixed, 0);
        hipLaunchKernelGGL(k_sgu_prep, dim3(NTOK), dim3(256), 0, stream, proj, sgu_gain + (size_t)l * 256);
        hipLaunchKernelGGL(k_sgu, dim3(NTOK), dim3(256), 0, stream, (const float*)proj, sgu_w + (size_t)l * 4 * 128 * 128, sgu_b + (size_t)l * 4 * 128, mixed);
        hipLaunchKernelGGL(k_conv, dim3(NTOK), dim3(256), 0, stream, (const float*)proj, conv_w + (size_t)l * 3 * 256, mixed);
        hipLaunchKernelGGL(k_rms3, dim3(NTOK), dim3(256), 0, stream, mixed, branch_gain + (size_t)l * 1024);
        { GP p{}; p.A = mixed; p.B = w_out + (size_t)l * 1024 * 1024; p.C = tmp; p.M = NTOK; p.N = 1024; p.K = 1024; p.lda = 1024; p.ldb = 1024; p.ldc = 1024;
          hipLaunchKernelGGL(k_gemm<0>, dim3(8, NTOK / 128, 1), dim3(256), 0, stream, p); }
        hipLaunchKernelGGL(k_ln_res, dim3(NTOK), dim3(256), 0, stream, xbuf, (const float*)tmp, ln_gain + (size_t)l * 2048, ln_bias + (size_t)l * 2048);
        hipMemsetAsync(cnt, 0, 32 * 4, stream);
        hipMemsetAsync(ffn, 0, (size_t)NTOK * 1024 * 4, stream);
        hipLaunchKernelGGL(k_router, dim3(NTOK / 4), dim3(256), 0, stream, (const float*)xbuf, rgw + (size_t)l * 1024 * 4, rgb + (size_t)l * 4, rew + (size_t)l * 1024 * 32, reb + (size_t)l * 32, gate, list, cnt, eidx);
        { GP p{}; p.A = xbuf; p.B = ewg + (size_t)l * 32 * 1024 * 512; p.B2 = ewu + (size_t)l * 32 * 1024 * 512; p.C = GU; p.M = 0; p.N = 1024; p.K = 1024; p.lda = 1024; p.ldb = 512; p.ldc = 1024; p.list = list; p.cnt = cnt;
          hipLaunchKernelGGL(k_gemm<1>, dim3(8, LCAP / 128, 32), dim3(256), 0, stream, p); }
        { GP p{}; p.A = GU; p.B = ewd + (size_t)l * 32 * 512 * 1024; p.C = ffn; p.M = 0; p.N = 1024; p.K = 512; p.lda = 1024; p.ldb = 1024; p.ldc = 1024; p.list = list; p.cnt = cnt; p.gate = gate;
          hipLaunchKernelGGL(k_gemm<2>, dim3(8, LCAP / 128, 32), dim3(256), 0, stream, p); }
        hipLaunchKernelGGL(k_ln_res, dim3(NTOK), dim3(256), 0, stream, xbuf, (const float*)ffn, ln_gain + (size_t)l * 2048 + 1024, ln_bias + (size_t)l * 2048 + 1024);
    }
}
}
extern "C" void kernel_launch(void* const* d_in, const int* in_sizes, int n_in, void* d_out, int out_size, void* d_ws, size_t ws_size, hipStream_t stream) {
    if (n_in != 17 || ws_size < (size_t)1035 * 1000000) { fprintf(stderr, "kernel_launch: unexpected n_in %d / ws_size %zu\n", n_in, ws_size); return; }
    nv::forward(d_in, (float*)d_out, (unsigned char*)d_ws, stream);
}
```

```cpp
#include <hip/hip_runtime.h>
#include <cstdio>
#include <cstdint>
#include <cmath>
namespace pg8 {
#define PG8_LAS __attribute__((address_space(3)))
typedef unsigned short bf16_t;
typedef short bf16x8 __attribute__((ext_vector_type(8)));
typedef float f32x4 __attribute__((ext_vector_type(4)));
typedef float f32x2 __attribute__((ext_vector_type(2)));
typedef unsigned u32x4 __attribute__((ext_vector_type(4)));
typedef unsigned u32x2 __attribute__((ext_vector_type(2)));
constexpr int BM = 256, BK = 64, HALF = 128, HTB = HALF * BK * 2  , STAGE_BYTES = 8 * HTB, NXCD = 8, WGM = 8;

__host__ __device__ __forceinline__ int lds_byte(int r, int c) { const int st = (r >> 4) * 2 + (c >> 5), rr = r & 15, cc = c & 31, ob = rr * 64 + cc * 2; return st * 1024 + (ob ^ (((ob >> 9) & 1) << 5)); }
__host__ __device__ __forceinline__ void stage_rc(int b, int& R, int& C) { const int st = b / 1024, sb = b % 1024, swz = sb ^ (((sb >> 9) & 1) << 5); R = (st >> 1) * 16 + swz / 64; C = (st & 1) * 32 + (swz % 64) / 2; }
__host__ __device__ __forceinline__ int perm32(int rho) { const int n = rho >> 4, i = rho & 15; return 8 * (i >> 2) + 4 * n + (i & 3); }

struct Unit { int pm, pn, e, bin, rbase, nvalid; };
struct Gemm { const bf16_t* A; const bf16_t* Bt; int K; };

struct DenseOrder {
    int nM, nN, nwg, G, c, K;
    __device__ __forceinline__ void init(int M, int N, int K_, int G_, int c_) { nM = M / BM; nN = N / BM; nwg = nM * nN; G = G_; c = c_; K = K_; }
    __device__ __forceinline__ bool next(int i, Unit& u) const {
        const long L = (long)i * G + c; if (L >= nwg) return false;
        int wgid = (int)L; { const int q = nwg / NXCD, r = nwg % NXCD, xcd = wgid % NXCD, off = wgid / NXCD; wgid = (xcd < r ? xcd * (q + 1) : r * (q + 1) + (xcd - r) * q) + off; }
        const int nig = WGM * nN, gid = wgid / nig, fm = gid * WGM, gsz = (nM - fm) < WGM ? (nM - fm) : WGM;
        u.pm = fm + ((wgid % nig) % gsz); u.pn = (wgid % nig) / gsz; u.e = 0; u.bin = 0; u.rbase = 0; u.nvalid = 256; return true;
    }
    __device__ __forceinline__ size_t a_off(const Unit& u) const { return (size_t)u.pm * (size_t)(BM * 2) * K; }
    __device__ __forceinline__ size_t b_off(const Unit& u) const { return (size_t)u.pn * (size_t)(BM * 2) * K; }
};

__device__ __forceinline__ int lane_id_v() { int l; asm volatile("v_mbcnt_lo_u32_b32 %0, -1, 0\n\tv_mbcnt_hi_u32_b32 %0, -1, %0" : "=v"(l)); return l; }
__device__ __forceinline__ unsigned cvt_pk_bf16(float lo, float hi) { unsigned r; asm volatile("v_cvt_pk_bf16_f32 %0, %1, %2" : "=v"(r) : "v"(lo), "v"(hi)); return r; }

template <class Epi, class Sched, bool GATHER>
__device__ __forceinline__ void gemm_phase(PG8_LAS unsigned char* lds, const Gemm g, const Sched& S, const Epi& E, const PG8_LAS int* tab, int wave_s) {
    const int lane = lane_id_v(), wid = wave_s, tid = wid * 64 + lane,
              wr = wid >> 2, wc = wid & 3, fr = lane & 15, fq = lane >> 4;
    const int K = g.K, nt = K / BK;
    unsigned voffA[2], voffB[2]; int RA[2]; unsigned CA2[2];
#pragma unroll
    for (int i = 0; i < 2; ++i) { int R, C; stage_rc(tid * 16 + i * 8192, R, C); const int Rb = Epi::PERM ? ((R & ~31) + perm32(R & 31)) : R;
        voffA[i] = (unsigned)(R * K + C) * 2u; voffB[i] = (unsigned)(Rb * K + C) * 2u; RA[i] = R; CA2[i] = (unsigned)C * 2u; }
    const size_t kstep = (size_t)(BK * 2);
    const size_t hstep = (size_t)HALF * K * 2;
    const unsigned ldsw = (unsigned)wid * 1024u;
    const int aoff = lds_byte(wr * 64 + fr, fq * 8), boff = lds_byte(wc * 32 + fr, fq * 8);
#define PG8_SA(b, h) (((b) * 2 + (h)) * HTB)
#define PG8_SB(b, h) ((4 + (b) * 2 + (h)) * HTB)
#define PG8_STAGE(bufoff, gbase, voff) do { _Pragma("unroll") for (int _i = 0; _i < 2; ++_i) \
        __builtin_amdgcn_global_load_lds((const unsigned*)((const char*)(gbase) + (voff)[_i]), (PG8_LAS unsigned*)(lds + (bufoff) + ldsw + _i * 8192), 16, 0, 0); } while (0)
#define PG8_LDA(dst, b, h) do { _Pragma("unroll") for (int m = 0; m < 4; ++m) _Pragma("unroll") for (int k = 0; k < 2; ++k) dst[m][k] = *(const PG8_LAS bf16x8*)(lds + PG8_SA(b, h) + aoff + m * 2048 + k * 1024); } while (0)
#define PG8_LDB(dst, b, h) do { _Pragma("unroll") for (int n = 0; n < 2; ++n) _Pragma("unroll") for (int k = 0; k < 2; ++k) dst[n][k] = *(const PG8_LAS bf16x8*)(lds + PG8_SB(b, h) + boff + n * 2048 + k * 1024); } while (0)
#define PG8_MMA(ai, bj, At, Bt) do { __builtin_amdgcn_s_setprio(1); _Pragma("unroll") for (int m = 0; m < 4; ++m) _Pragma("unroll") for (int n = 0; n < 2; ++n) _Pragma("unroll") for (int k = 0; k < 2; ++k) \
        acc[ai][bj][m][n] = __builtin_amdgcn_mfma_f32_16x16x32_bf16(Bt[n][k], At[m][k], acc[ai][bj][m][n], 0, 0, 0); __builtin_amdgcn_s_setprio(0); } while (0)
#define PG8_WAIT_V(n) asm volatile("s_waitcnt vmcnt(" #n ")" ::: "memory")
#define PG8_WAIT_L(n) asm volatile("s_waitcnt lgkmcnt(" #n ")" ::: "memory")
#define PG8_BAR __builtin_amdgcn_s_barrier()
#define PG8_SCHED __builtin_amdgcn_sched_barrier(0)
    Unit cur, nxt; int ui = 0;
    if (!S.next(0, cur)) return;
    f32x4 acc[2][2][4][2];
#pragma unroll
    for (int a = 0; a < 2; ++a)
#pragma unroll
        for (int b = 0; b < 2; ++b)
#pragma unroll
            for (int m = 0; m < 4; ++m)
#pragma unroll
                for (int n = 0; n < 2; ++n) acc[a][b][m][n] = (f32x4){0.f, 0.f, 0.f, 0.f};
    bf16x8 At[4][2], B0[2][2], B1[2][2];
    unsigned vc0[2], vc1[2], vn0[2], vn1[2];
#pragma unroll
    for (int i = 0; i < 2; ++i) {
        if constexpr (GATHER) { vc0[i] = (unsigned)tab[RA[i]] * (unsigned)(K * 2) + CA2[i]; vc1[i] = (unsigned)tab[128 + RA[i]] * (unsigned)(K * 2) + CA2[i]; }
        else { vc0[i] = voffA[i]; vc1[i] = voffA[i] + (unsigned)hstep; }
        vn0[i] = vc0[i]; vn1[i] = vc1[i];
    }
    const char* cA = (const char*)g.A + (GATHER ? (size_t)0 : S.a_off(cur)); const char* cB = (const char*)g.Bt + S.b_off(cur);
    PG8_STAGE(PG8_SB(0, 0), cB, voffB); PG8_STAGE(PG8_SB(0, 1), cB + hstep, voffB); PG8_STAGE(PG8_SA(0, 0), cA, vc0); PG8_STAGE(PG8_SA(0, 1), cA, vc1);
    if (wr == 1) PG8_BAR;
    PG8_WAIT_V(2); PG8_BAR;
    PG8_STAGE(PG8_SB(1, 0), cB + kstep, voffB); PG8_STAGE(PG8_SA(1, 0), cA + kstep, vc0); PG8_STAGE(PG8_SB(1, 1), cB + hstep + kstep, voffB);
    PG8_WAIT_V(6); PG8_BAR;
    for (;;) {
        const bool has_next = S.next(ui + 1, nxt);
        const char* nA = has_next ? (const char*)g.A + (GATHER ? (size_t)0 : S.a_off(nxt)) : cA; const char* nB = has_next ? (const char*)g.Bt + S.b_off(nxt) : cB;
        if constexpr (GATHER) { if (has_next) {
#pragma unroll
            for (int i = 0; i < 2; ++i) { vn0[i] = (unsigned)tab[(ui + 1) * 256 + RA[i]] * (unsigned)(K * 2) + CA2[i]; vn1[i] = (unsigned)tab[(ui + 1) * 256 + 128 + RA[i]] * (unsigned)(K * 2) + CA2[i]; } } }
        for (int t = 0; t < nt; t += 2) {
            const bool last = (t == nt - 2);
            const char* a1 = cA + (size_t)(t + 1) * kstep;
            const char* a2 = last ? nA : cA + (size_t)(t + 2) * kstep; const char* b2 = last ? nB : cB + (size_t)(t + 2) * kstep;
            const char* a3 = a2 + kstep; const char* b3 = b2 + kstep;
            unsigned x0[2], x1[2];
#pragma unroll
            for (int i = 0; i < 2; ++i) { x0[i] = last ? vn0[i] : vc0[i]; x1[i] = last ? vn1[i] : vc1[i]; }
            PG8_LDB(B0, 0, 0); PG8_LDB(B1, 0, 1); PG8_SCHED; PG8_LDA(At, 0, 0); PG8_STAGE(PG8_SA(1, 1), a1, vc1);
            PG8_WAIT_V(8); PG8_WAIT_L(0); PG8_BAR; PG8_MMA(0, 0, At, B0); PG8_MMA(0, 1, At, B1); PG8_BAR; PG8_SCHED;
            PG8_LDA(At, 0, 1); PG8_STAGE(PG8_SB(0, 0), b2, voffB); PG8_STAGE(PG8_SB(0, 1), b2 + hstep, voffB); PG8_STAGE(PG8_SA(0, 0), a2, x0);
            PG8_WAIT_V(8); PG8_WAIT_L(0); PG8_BAR; PG8_MMA(1, 0, At, B0); PG8_MMA(1, 1, At, B1); PG8_BAR; PG8_SCHED;
            PG8_LDB(B0, 1, 0); PG8_LDB(B1, 1, 1); PG8_SCHED; PG8_LDA(At, 1, 0); PG8_STAGE(PG8_SA(0, 1), a2, x1);
            PG8_WAIT_V(8); PG8_WAIT_L(0); PG8_BAR; PG8_MMA(0, 0, At, B0); PG8_MMA(0, 1, At, B1); PG8_BAR; PG8_SCHED;
            PG8_LDA(At, 1, 1); PG8_STAGE(PG8_SB(1, 0), b3, voffB); PG8_STAGE(PG8_SB(1, 1), b3 + hstep, voffB); PG8_STAGE(PG8_SA(1, 0), a3, x0);
            PG8_WAIT_V(8); PG8_WAIT_L(0); PG8_BAR; PG8_MMA(1, 0, At, B0); PG8_MMA(1, 1, At, B1); PG8_BAR; PG8_SCHED;
        }
        if (wr == 0) PG8_BAR;
        E(acc, cur, wr, wc, fr, fq);
        if (!has_next) break;
#pragma unroll
        for (int a = 0; a < 2; ++a)
#pragma unroll
            for (int b = 0; b < 2; ++b)
#pragma unroll
                for (int m = 0; m < 4; ++m)
#pragma unroll
                    for (int n = 0; n < 2; ++n) acc[a][b][m][n] = (f32x4){0.f, 0.f, 0.f, 0.f};
        cur = nxt; cA = nA; cB = nB; ++ui;
#pragma unroll
        for (int i = 0; i < 2; ++i) { vc0[i] = vn0[i]; vc1[i] = vn1[i]; }
        if (wr == 1) PG8_BAR;
    }
    PG8_WAIT_V(0);
    PG8_BAR;
#undef PG8_SA
#undef PG8_SB
#undef PG8_STAGE
#undef PG8_LDA
#undef PG8_LDB
#undef PG8_MMA
#undef PG8_WAIT_V
#undef PG8_WAIT_L
#undef PG8_BAR
#undef PG8_SCHED
}
}
#define GAS __attribute__((address_space(1)))
#define LAS __attribute__((address_space(3)))
typedef unsigned short bf16;
typedef unsigned v4u __attribute__((ext_vector_type(4)));
typedef unsigned v2u __attribute__((ext_vector_type(2)));
typedef float f32x4 __attribute__((ext_vector_type(4)));
typedef float f32x2 __attribute__((ext_vector_type(2)));
typedef float f32x16 __attribute__((ext_vector_type(16)));
typedef short bf16x8 __attribute__((ext_vector_type(8)));
typedef short s16x4 __attribute__((ext_vector_type(4)));
typedef GAS unsigned gu32;
#define RLX_AGENT __ATOMIC_RELAXED, __HIP_MEMORY_SCOPE_AGENT
#define LDS_WAIT() asm volatile("s_waitcnt lgkmcnt(0)" ::: "memory")
#define VM_WAIT() asm volatile("s_waitcnt vmcnt(0)" ::: "memory")

constexpr int NWAVES = 8;
constexpr int NTOK = 65536, SEQ = 8192, DM = 1024, PW = 2816, NL = 4;
constexpr int OQ = 0, OKK = 512, OV = 1024, OU = 1536, OZ = 1792, OGB = 2048, OGC = 2304, OH = 2560;
constexpr float LN_EPS = 1e-5f, ALPHA = 1.6817928305074290f, LOG2E = 1.4426950408889634f, C2 = 0.125f * 1.4426950408889634f;
constexpr int NU_MAX = 10;

constexpr size_t MiB = 1u << 20;
constexpr size_t WS_CTL = 0, CTL_ZERO_BYTES = 1 * MiB;
constexpr size_t WS_ROPE = 1 * MiB;
constexpr size_t WS_VEC = 3 * MiB;
constexpr size_t WS_WIN = 4 * MiB;
constexpr size_t WS_WOUT = 26 * MiB;
constexpr size_t WS_WRT = 34 * MiB;
constexpr size_t WS_WSGU = 35 * MiB;
constexpr size_t WS_WGU = 36 * MiB;
constexpr size_t WS_WD = 100 * MiB;
constexpr size_t WS_CGU = 132 * MiB;
constexpr size_t WS_S = 134 * MiB;
constexpr size_t WS_ST = 262 * MiB;
constexpr size_t WS_RS0 = 270 * MiB;
constexpr size_t WS_RS1 = 271 * MiB;
constexpr size_t WS_PROJ = 272 * MiB;
constexpr size_t WS_MIXED = 624 * MiB;
constexpr size_t WS_PART = 752 * MiB;
constexpr size_t WS_ML = 944 * MiB;
constexpr size_t WS_H = 272 * MiB;
constexpr size_t WS_LIST = 416 * MiB;
constexpr size_t WS_GATE = 432 * MiB;
constexpr size_t WS_END = 956 * MiB;
constexpr int V_ONES = 0, V_ZEROS = 1024, V_CIN = 2048  , V_DIN = V_CIN + 4 * PW, V_CR = V_DIN + 4 * PW  , V_DR = V_CR + 256;
constexpr int CW_TMO = 0, CW_CODE = 1, CW_BAR = 4096, CW_CNT = 16384;
constexpr int RING_OFF = 0, RING_BYTES = 131072;
constexpr int TAB_OFF = 131072;
constexpr int UT_OFF = TAB_OFF + NU_MAX * 1024;
constexpr int TB_OFF = UT_OFF + 512;
constexpr int MISC_OFF = TB_OFF + 1280;
constexpr int LDS_BYTES = 147456;
static_assert(MISC_OFF + 128 <= LDS_BYTES, "LDS map");

__device__ __forceinline__ unsigned pkbf(float lo, float hi) { return pg8::cvt_pk_bf16(lo, hi); }
__device__ __forceinline__ float bflo(unsigned w) { return __uint_as_float(w << 16); }
__device__ __forceinline__ float bfhi(unsigned w) { return __uint_as_float(w & 0xffff0000u); }
__device__ __forceinline__ float bf2f(unsigned short b) { return __uint_as_float((unsigned)b << 16); }
__device__ __forceinline__ float rbf(float x) { return bflo(pkbf(x, 0.f)); }
__device__ __forceinline__ float fast_exp2(float x) { return __builtin_amdgcn_exp2f(x); }
__device__ __forceinline__ float fast_rcp(float x) { return __builtin_amdgcn_rcpf(x); }
__device__ __forceinline__ float gelu_t(float x) {
    const float u = 0.7978845608028654f * (x + 0.044715f * x * x * x);
    return x * fast_rcp(1.0f + fast_exp2(-2.0f * LOG2E * u));
}
__device__ __forceinline__ float silu_f(float x) { return x * fast_rcp(1.0f + fast_exp2(-LOG2E * x)); }
__device__ __forceinline__ float wave_sum(float v) {
#pragma unroll
    for (int o = 1; o < 64; o <<= 1) v += __shfl_xor(v, o);
    return v;
}

#define XB_TMO      128
#define XB_XCNT(j)  (256  + 64 * (j))
#define XB_XSUB(j)  (1280 + 64 * (j))
#define XB_XGEN(j)  (2304 + 64 * (j))
#define XB_TOP      3328
#define XB_TOPGEN   3392
#define XCD_BAR_WORDS 3456
#define XB_SPIN_CAP (1u << 18)
__device__ __forceinline__ unsigned xb_ld(unsigned* p)              { return __hip_atomic_load(p, __ATOMIC_RELAXED, __HIP_MEMORY_SCOPE_AGENT); }
__device__ __forceinline__ unsigned xb_add(unsigned* p, unsigned v) { return __hip_atomic_fetch_add(p, v, __ATOMIC_RELAXED, __HIP_MEMORY_SCOPE_AGENT); }
__device__ __forceinline__ unsigned xb_xcc_id() { return (unsigned)__builtin_amdgcn_s_getreg((3 << 11) | 20) & 0xFu; }
#define XB_SPIN(cond, bar) do { unsigned _sp = 0; while (cond) { __builtin_amdgcn_s_sleep(1); \
    if ((++_sp & 255u) == 0u) { if (xb_ld(&(bar)[XB_TMO])) break; if (_sp > XB_SPIN_CAP) { atomicAdd(&(bar)[XB_TMO], 1u); break; } } } } while (0)
struct XcdBarrier { unsigned* bar; unsigned x; volatile LAS unsigned* st; };
__device__ __forceinline__ XcdBarrier xcd_barrier_post(unsigned* bar, volatile LAS unsigned* st) {
    XcdBarrier b; b.bar = bar; b.x = xb_xcc_id(); b.st = st;
    if (threadIdx.x == 0) (void)xb_add(&bar[XB_XCNT(b.x)], 1u);
    return b;
}
__device__ __forceinline__ void xcd_barrier_complete(unsigned* bar, unsigned x, unsigned& nloc, unsigned& nx) {
    const unsigned G = gridDim.x * gridDim.y * gridDim.z;
    unsigned sum, cnt, mine, sp = 0u;
    for (;;) {
        sum = 0u; cnt = 0u; mine = 0u;
#pragma unroll
        for (unsigned j = 0; j < 16; ++j) { const unsigned c = xb_ld(&bar[XB_XCNT(j)]); sum += c; cnt += (c > 0u) ? 1u : 0u; mine = (j == x) ? c : mine; }
        if (sum == G) break;
        __builtin_amdgcn_s_sleep(1);
        if ((++sp & 255u) == 0u) { if (xb_ld(&bar[XB_TMO])) break; if (sp > XB_SPIN_CAP) { atomicAdd(&bar[XB_TMO], 1u); break; } }
    }
    nloc = mine > 0u ? mine : 1u; nx = cnt > 0u ? cnt : 1u;
}
__device__ __forceinline__ void xcd_barrier(const XcdBarrier& b) {
    asm volatile("s_waitcnt vmcnt(0)" ::: "memory");
    __syncthreads();
    if (threadIdx.x == 0) {
        unsigned* bar = b.bar;
        __builtin_amdgcn_s_waitcnt(0);
        unsigned nloc = b.st[0], nx = b.st[1];
        if (nloc == 0u) { xcd_barrier_complete(bar, b.x, nloc, nx); b.st[0] = nloc; b.st[1] = nx; }
        const unsigned old = xb_add(&bar[XB_XSUB(b.x)], 1u);
        const unsigned gen = old / nloc;
        if (old + 1u == (gen + 1u) * nloc) {
            __builtin_amdgcn_fence(__ATOMIC_RELEASE, "agent");
            asm volatile("s_waitcnt vmcnt(0)" ::: "memory");
            const unsigned og = xb_add(&bar[XB_TOP], 1u);
            const unsigned tg = og / nx;
            if (og + 1u == (tg + 1u) * nx) xb_add(&bar[XB_TOPGEN], 1u);
            else XB_SPIN(xb_ld(&bar[XB_TOPGEN]) == tg, bar);
            __builtin_amdgcn_fence(__ATOMIC_ACQUIRE, "agent");
            xb_add(&bar[XB_XGEN(b.x)], 1u);
            asm volatile("s_waitcnt vmcnt(0)" ::: "memory");
        } else {
            XB_SPIN(xb_ld(&bar[XB_XGEN(b.x)]) == gen, bar);
            __builtin_amdgcn_fence(__ATOMIC_ACQUIRE, "agent");
            asm volatile("s_waitcnt vmcnt(0)" ::: "memory");
        }
    }
    __syncthreads();
}

struct MoeOrder {
    const LAS int* ut; int K; size_t bstride;
    __device__ __forceinline__ bool next(int i, pg8::Unit& u) const {
        if (i >= NU_MAX) return false;
        const LAS int* p = ut + i * 8; const int nv = __builtin_amdgcn_readfirstlane(p[5]);
        if (nv < 0) return false;
        u.pm = __builtin_amdgcn_readfirstlane(p[0]); u.pn = __builtin_amdgcn_readfirstlane(p[1]); u.e = __builtin_amdgcn_readfirstlane(p[2]);
        u.bin = __builtin_amdgcn_readfirstlane(p[3]); u.rbase = __builtin_amdgcn_readfirstlane(p[4]); u.nvalid = nv; return true;
    }
    __device__ __forceinline__ size_t a_off(const pg8::Unit& u) const { return (size_t)u.pm * (size_t)(512) * K; }
    __device__ __forceinline__ size_t b_off(const pg8::Unit& u) const { return (size_t)u.e * bstride + (size_t)u.pn * (size_t)(512) * K; }
};

template <class T> __device__ __forceinline__ T ldg(const void* base, unsigned byteoff) { return *(const T*)((const char*)base + byteoff); }
template <class T> __device__ __forceinline__ void stg_(void* base, unsigned byteoff, T v) { *(T*)((char*)base + byteoff) = v; }
#define EPI_FENCE() asm volatile("" ::: "memory")
struct EpiProj {
    static constexpr bool PERM = true;
    bf16* O; const float* cvec; const float* dvec; const float* ST; float* RS; const float* CS;
    __device__ __forceinline__ void operator()(const f32x4 (&acc)[2][2][4][2], const pg8::Unit& u, int wr, int wc, int fr, int fq) const {
        const unsigned row0 = u.pm * 256 + wr * 64 + fr;
        const unsigned col0 = u.pn * 256 + wc * 32 + 8 * fq;
        const int seg = u.pn;
        float rsd[2][4], rsm[2][4];
#pragma unroll
        for (int ai = 0; ai < 2; ++ai)
#pragma unroll
            for (int m = 0; m < 4; ++m) {
                const unsigned row = row0 + ai * 128 + m * 16;
                const f32x4 p0 = ldg<f32x4>(ST, row * 128u + 32u * fq), p1 = ldg<f32x4>(ST, row * 128u + 32u * fq + 16u);
                float s = (p0[0] + p0[2]) + (p1[0] + p1[2]), q = (p0[1] + p0[3]) + (p1[1] + p1[3]);
                s += __shfl_xor(s, 16); s += __shfl_xor(s, 32); q += __shfl_xor(q, 16); q += __shfl_xor(q, 32);
                const float mu = s * (1.f / 1024.f); const float var = q * (1.f / 1024.f) - mu * mu; const float rstd = 1.0f / sqrtf(var + LN_EPS);
                if (seg == 0 && wc == 0 && fq == 0) stg_<f32x2>(RS, row * 8u, (f32x2){mu, rstd});
                rsd[ai][m] = rstd; rsm[ai][m] = rstd * mu;
            }
        EPI_FENCE();
#pragma unroll
        for (int bj = 0; bj < 2; ++bj) {
            const f32x4 cv0 = ldg<f32x4>(cvec, (col0 + bj * 128) * 4u), cv1 = ldg<f32x4>(cvec, (col0 + bj * 128) * 4u + 16u);
            const f32x4 dv0 = ldg<f32x4>(dvec, (col0 + bj * 128) * 4u), dv1 = ldg<f32x4>(dvec, (col0 + bj * 128) * 4u + 16u);
#pragma unroll
            for (int ai = 0; ai < 2; ++ai)
#pragma unroll
                for (int m = 0; m < 4; ++m) {
                    const unsigned row = row0 + ai * 128 + m * 16;
                    const float rstd = rsd[ai][m], rsmu = rsm[ai][m];
                    f32x4 v0 = acc[ai][bj][m][0] * rstd - cv0 * rsmu + dv0, v1 = acc[ai][bj][m][1] * rstd - cv1 * rsmu + dv1;
                    if (seg < 4) {
                        const unsigned t = row & (SEQ - 1), i0 = 16 * (wc & 1) + 4 * fq;
                        const f32x4 cs0 = ldg<f32x4>(CS, (t * 32u + i0) * 8u), cs1 = ldg<f32x4>(CS, (t * 32u + i0) * 8u + 16u);
                        const float sc = (seg < 2) ? C2 : 1.0f;
                        f32x4 w0, w1;
                        w0[0] = (v0[0] * cs0[0] - v0[1] * cs0[1]) * sc; w0[1] = (v0[1] * cs0[0] + v0[0] * cs0[1]) * sc;
                        w0[2] = (v0[2] * cs0[2] - v0[3] * cs0[3]) * sc; w0[3] = (v0[3] * cs0[2] + v0[2] * cs0[3]) * sc;
                        w1[0] = (v1[0] * cs1[0] - v1[1] * cs1[1]) * sc; w1[1] = (v1[1] * cs1[0] + v1[0] * cs1[1]) * sc;
                        w1[2] = (v1[2] * cs1[2] - v1[3] * cs1[3]) * sc; w1[3] = (v1[3] * cs1[2] + v1[2] * cs1[3]) * sc;
                        v0 = w0; v1 = w1;
                    } else if (seg == 6 || seg == 7) {
#pragma unroll
                        for (int e = 0; e < 4; ++e) { v0[e] = gelu_t(v0[e]); v1[e] = gelu_t(v1[e]); }
                    }
                    v4u w; w.x = pkbf(v0[0], v0[1]); w.y = pkbf(v0[2], v0[3]); w.z = pkbf(v1[0], v1[1]); w.w = pkbf(v1[2], v1[3]);
                    stg_<v4u>(O, (row * (unsigned)PW + col0 + bj * 128) * 2u, w);
                    if (m & 1) EPI_FENCE();
                }
        }
    }
};
struct EpiRes1 {
    static constexpr bool PERM = true;
    bf16* S; const float* RS; const float* G; const float* Bv;
    __device__ __forceinline__ void operator()(const f32x4 (&acc)[2][2][4][2], const pg8::Unit& u, int wr, int wc, int fr, int fq) const {
        const unsigned row0 = u.pm * 256 + wr * 64 + fr;
        const unsigned col0 = u.pn * 256 + wc * 32 + 8 * fq;
#pragma unroll
        for (int bj = 0; bj < 2; ++bj) {
            const f32x4 gv0 = ldg<f32x4>(G, (col0 + bj * 128) * 4u), gv1 = ldg<f32x4>(G, (col0 + bj * 128) * 4u + 16u);
            const f32x4 bv0 = ldg<f32x4>(Bv, (col0 + bj * 128) * 4u), bv1 = ldg<f32x4>(Bv, (col0 + bj * 128) * 4u + 16u);
#pragma unroll
            for (int ai = 0; ai < 2; ++ai)
#pragma unroll
                for (int m = 0; m < 4; ++m) {
                    const unsigned row = row0 + ai * 128 + m * 16;
                    const f32x2 st = ldg<f32x2>(RS, row * 8u);
                    const unsigned off = (row * (unsigned)DM + col0 + bj * 128) * 2u;
                    const v4u o = ldg<v4u>(S, off);
                    f32x4 x0 = (f32x4){bflo(o.x), bfhi(o.x), bflo(o.y), bfhi(o.y)}, x1 = (f32x4){bflo(o.z), bfhi(o.z), bflo(o.w), bfhi(o.w)};
                    x0 = ((x0 - st.x) * st.y * gv0 + bv0) * ALPHA + acc[ai][bj][m][0];
                    x1 = ((x1 - st.x) * st.y * gv1 + bv1) * ALPHA + acc[ai][bj][m][1];
                    v4u w; w.x = pkbf(x0[0], x0[1]); w.y = pkbf(x0[2], x0[3]); w.z = pkbf(x1[0], x1[1]); w.w = pkbf(x1[2], x1[3]);
                    stg_<v4u>(S, off, w);
                    if (m & 1) EPI_FENCE();
                }
        }
    }
};
struct EpiSwiglu {
    static constexpr bool PERM = true;
    bf16* H;
    __device__ __forceinline__ void operator()(const f32x4 (&acc)[2][2][4][2], const pg8::Unit& u, int wr, int wc, int fr, int fq) const {
        const unsigned lr0 = wr * 64 + fr;
        const unsigned col0 = u.pn * 256 + wc * 32 + 8 * fq;
#pragma unroll
        for (int ai = 0; ai < 2; ++ai)
#pragma unroll
            for (int m = 0; m < 4; ++m) {
                const unsigned lr = lr0 + ai * 128 + m * 16;
#pragma unroll
                for (int bj = 0; bj < 2; ++bj) {
                    const f32x4 v0 = acc[ai][bj][m][0], v1 = acc[ai][bj][m][1];
                    v2u w; w.x = pkbf(silu_f(v0[0]) * v0[1], silu_f(v0[2]) * v0[3]); w.y = pkbf(silu_f(v1[0]) * v1[1], silu_f(v1[2]) * v1[3]);
                    stg_<v2u>(H, (((unsigned)u.pm * 256u + lr) * 512u + ((col0 + bj * 128) >> 1)) * 2u, w);
                }
            }
    }
};
template <bool FINAL> struct EpiDown {
    static constexpr bool PERM = true;
    bf16* S; const bf16* XN; const int* LIST; const float* GATE; float* ST;
    __device__ __forceinline__ void operator()(const f32x4 (&acc)[2][2][4][2], const pg8::Unit& u, int wr, int wc, int fr, int fq) const {
        const unsigned lr0 = wr * 64 + fr;
        const unsigned col0 = u.pn * 256 + wc * 32 + 8 * fq;
        unsigned tk[2][4]; float gt[2][4];
#pragma unroll
        for (int ai = 0; ai < 2; ++ai)
#pragma unroll
            for (int m = 0; m < 4; ++m) {
                const unsigned lr = lr0 + ai * 128 + m * 16;
                unsigned tok = 0xffffffffu; float gate = 0.f;
                if ((int)lr < u.nvalid) { const unsigned idx = (unsigned)u.bin * (unsigned)NTOK + (unsigned)u.rbase + lr; tok = (unsigned)ldg<int>(LIST, idx * 4u); gate = ldg<float>(GATE, idx * 4u); }
                tk[ai][m] = tok; gt[ai][m] = gate;
            }
        EPI_FENCE();
#pragma unroll
        for (int ai = 0; ai < 2; ++ai)
#pragma unroll
            for (int m = 0; m < 4; ++m) {
                const bool valid = tk[ai][m] != 0xffffffffu;
                const unsigned tok = valid ? tk[ai][m] : 0u; const float gate = gt[ai][m];
                float ssum = 0.f, ssq = 0.f;
#pragma unroll
                for (int bj = 0; bj < 2; ++bj) {
                    const unsigned off = (tok * (unsigned)DM + col0 + bj * 128) * 2u;
                    const v4u o = ldg<v4u>(FINAL ? (const void*)S : (const void*)XN, off);
                    f32x4 x0 = (f32x4){bflo(o.x), bfhi(o.x), bflo(o.y), bfhi(o.y)}, x1 = (f32x4){bflo(o.z), bfhi(o.z), bflo(o.w), bfhi(o.w)};
                    if constexpr (!FINAL) { x0 = x0 * ALPHA + acc[ai][bj][m][0] * gate; x1 = x1 * ALPHA + acc[ai][bj][m][1] * gate; }
                    else { x0 = x0 + acc[ai][bj][m][0] * gate; x1 = x1 + acc[ai][bj][m][1] * gate; }
                    v4u w; w.x = pkbf(x0[0], x0[1]); w.y = pkbf(x0[2], x0[3]); w.z = pkbf(x1[0], x1[1]); w.w = pkbf(x1[2], x1[3]);
                    if (valid) stg_<v4u>(S, off, w);
                    if constexpr (FINAL) {
                        const f32x4 r0 = (f32x4){bflo(w.x), bfhi(w.x), bflo(w.y), bfhi(w.y)}, r1 = (f32x4){bflo(w.z), bfhi(w.z), bflo(w.w), bfhi(w.w)};
                        ssum += (r0[0] + r0[1]) + (r0[2] + r0[3]) + (r1[0] + r1[1]) + (r1[2] + r1[3]);
                        ssq += (r0[0] * r0[0] + r0[1] * r0[1]) + (r0[2] * r0[2] + r0[3] * r0[3]) + (r1[0] * r1[0] + r1[1] * r1[1]) + (r1[2] * r1[2] + r1[3] * r1[3]);
                    }
                }
                if constexpr (FINAL) {
                    ssum += __shfl_xor(ssum, 16); ssum += __shfl_xor(ssum, 32); ssq += __shfl_xor(ssq, 16); ssq += __shfl_xor(ssq, 32);
                    if (valid && fq == 0) stg_<f32x2>(ST, ((tok * 16u + u.pn * 4 + wc) * 2u) * 4u, (f32x2){ssum, ssq});
                }
                if (m & 1) EPI_FENCE();
            }
    }
};

struct ColId { __device__ __forceinline__ int operator()(int n) const { return n; } };
struct ColRope { __device__ __forceinline__ int operator()(int n) const { const int p = n & 63; return (n & ~63) + (p >> 1) + ((p & 1) << 5); } };
template <class CM>
__device__ __forceinline__ void conv_item(const float* W, int K, int ldw, CM cm, int n0, bf16* WT, int rstride, const float* scale, const float* biask, float* csum, float* dsum, LAS float* scr, int lane_) {
    int lane = lane_; asm volatile("" : "+v"(lane));
    const int col = cm(n0 + (lane & 31));
    float cs = 0.f, ds = 0.f;
    for (int k0 = 0; k0 < K; k0 += 64) {
        float w[32];
#pragma unroll
        for (int i = 0; i < 32; ++i) w[i] = W[(size_t)(k0 + 2 * i + (lane >> 5)) * ldw + col];
#pragma unroll
        for (int i = 0; i < 32; ++i) { const int kk = k0 + 2 * i + (lane >> 5); const float sc = scale ? scale[kk] : 1.0f; const float bk = biask ? biask[kk] : 0.0f;
            const float v = rbf(w[i] * sc); cs += v; ds += bk * w[i]; scr[(2 * i + (lane >> 5)) * 33 + (lane & 31)] = v; }
        LDS_WAIT(); asm volatile("" ::: "memory");
        const int c = lane & 7;
#pragma unroll
        for (int j = 0; j < 4; ++j) { const int n = (lane >> 3) + 8 * j; const LAS float* s = scr + (8 * c) * 33 + n;
            v4u o; o.x = pkbf(s[0 * 33], s[1 * 33]); o.y = pkbf(s[2 * 33], s[3 * 33]); o.z = pkbf(s[4 * 33], s[5 * 33]); o.w = pkbf(s[6 * 33], s[7 * 33]);
            *(GAS v4u*)(WT + (size_t)(n * rstride) * K + k0 + 8 * c) = o; }
        LDS_WAIT(); asm volatile("" ::: "memory");
    }
    cs += __shfl_xor(cs, 32); ds += __shfl_xor(ds, 32);
    if (lane < 32) { if (csum) csum[lane * rstride] = cs; if (dsum) dsum[lane * rstride] = ds; }
}

constexpr int AT_K = 0, AT_V = 49152, AT_WS = 98304, AT_OST = AT_WS + 8 * 256, AT_END = AT_OST + 8 * 4096;
static_assert(AT_END <= MISC_OFF, "attention LDS");
__device__ __forceinline__ void glds16(const void* gsrc, unsigned lds_dst) { unsigned keep;
    asm volatile("s_mov_b32 %0, m0\n\ts_mov_b32 m0, %2\n\ts_nop 0\n\tglobal_load_lds_dwordx4 %1, off\n\ts_mov_b32 m0, %0" : "=&s"(keep) : "v"(gsrc), "s"(lds_dst) : "memory"); }
__device__ __forceinline__ int crow(int r, int hi) { return (r & 3) + 8 * (r >> 2) + 4 * hi; }
typedef short v4i16_t __attribute__((ext_vector_type(4)));
__device__ __forceinline__ s16x4 vtr(const LAS char* p) { return __builtin_bit_cast(s16x4, __builtin_amdgcn_ds_read_tr16_b64_v4i16((LAS v4i16_t*)p)); }

__device__ __forceinline__ void attn_unit(const bf16* proj, bf16* part, float* ML, int b, int h, int br, int uidx, LAS unsigned char* lds, int wave_s) {
    const int lane = pg8::lane_id_v(), wid = wave_s, tid = wid * 64 + lane, r32 = lane & 31, hi = lane >> 5; (void)tid;
    const int dsh = 2 * br, d = 1 << dsh;
    const int r = uidx & (d - 1), qb = uidx >> dsh, m0 = qb * 256;
    const size_t rowbase = (size_t)b * SEQ;
    const unsigned lds0 = (unsigned)(uintptr_t)lds;
#pragma unroll
    for (int i = 0; i < 6; ++i) {
        const int x = wid * 6 + i, T = x >> 2, cp = x & 3;
        const int j = 32 * T + (lane & 31); int sidx = m0 - 128 + j; sidx = sidx < 0 ? 0 : sidx;
        const bf16* src = proj + (rowbase + (size_t)sidx * d + r) * PW + OKK + 64 * h + (2 * cp + (lane >> 5)) * 8;
        glds16(src, (unsigned)__builtin_amdgcn_readfirstlane(lds0 + AT_K + T * 4096 + cp * 1024));
    }
#pragma unroll
    for (int i = 0; i < 6; ++i) {
        const int x = wid * 6 + i, dh = x / 24, kg = x % 24;
        const int j = 16 * kg + (lane >> 2); int sidx = m0 - 128 + j; sidx = sidx < 0 ? 0 : sidx;
        const bf16* src = proj + (rowbase + (size_t)sidx * d + r) * PW + OV + 64 * h + dh * 32 + (lane & 3) * 8;
        glds16(src, (unsigned)__builtin_amdgcn_readfirstlane(lds0 + AT_V + dh * 24576 + kg * 1024));
    }
    const size_t qtok = rowbase + (size_t)(m0 + 32 * wid + r32) * d + r;
    bf16x8 qr[4];
#pragma unroll
    for (int d0 = 0; d0 < 4; ++d0) qr[d0] = *(const bf16x8*)(proj + qtok * PW + OQ + 64 * h + 16 * d0 + 8 * hi);
    asm volatile("s_waitcnt vmcnt(0)\n\ts_barrier" ::: "memory");
    f32x16 p[5];
#pragma unroll
    for (int j = 0; j < 5; ++j) {
        const LAS unsigned char* kb = lds + AT_K + (wid + j) * 4096 + hi * 512 + r32 * 16;
        f32x16 a = {};
#pragma unroll
        for (int d0 = 0; d0 < 4; ++d0) { const bf16x8 kf = *(const LAS bf16x8*)(kb + d0 * 1024); a = __builtin_amdgcn_mfma_f32_32x32x16_bf16(kf, qr[d0], a, 0, 0, 0); }
        p[j] = a;
    }
    const int kfirst = 128 - m0 - 32 * wid;
    float mx = -INFINITY;
#pragma unroll
    for (int j = 0; j < 5; ++j)
#pragma unroll
        for (int rg = 0; rg < 16; ++rg) {
            const int c = crow(rg, hi);
            bool ok = true;
            if (j == 0) ok = c >= r32;
            if (j == 4) ok = c <= r32;
            ok = ok && (32 * j + c >= kfirst);
            const float v = ok ? p[j][rg] : -INFINITY;
            p[j][rg] = v; mx = fmaxf(mx, v);
        }
    mx = fmaxf(mx, __shfl_xor(mx, 32));
    float l = 0.f;
#pragma unroll
    for (int j = 0; j < 5; ++j)
#pragma unroll
        for (int rg = 0; rg < 16; ++rg) { const float e = fast_exp2(p[j][rg] - mx); p[j][rg] = e; l += e; }
    l += __shfl_xor(l, 32);
    f32x16 o[2]; o[0] = f32x16{}; o[1] = f32x16{};
    const LAS char* vp0 = (const LAS char*)lds + AT_V + ((lane >> 4) & 1) * 32 + (lane & 3) * 8 + (4 * hi + ((lane & 15) >> 2)) * 64;
#pragma unroll
    for (int j = 0; j < 5; ++j)
#pragma unroll
        for (int s = 0; s < 2; ++s) {
            v4u pw; pw.x = pkbf(p[j][8 * s + 0], p[j][8 * s + 1]); pw.y = pkbf(p[j][8 * s + 2], p[j][8 * s + 3]); pw.z = pkbf(p[j][8 * s + 4], p[j][8 * s + 5]); pw.w = pkbf(p[j][8 * s + 6], p[j][8 * s + 7]);
            const bf16x8 pa = __builtin_bit_cast(bf16x8, pw);
#pragma unroll
            for (int dh = 0; dh < 2; ++dh) {
                const LAS char* vp = vp0 + dh * 24576 + (32 * (wid + j) + 16 * s) * 64;
                const s16x4 lo = vtr(vp), hv = vtr(vp + 512);
                const bf16x8 vf = (bf16x8){lo[0], lo[1], lo[2], lo[3], hv[0], hv[1], hv[2], hv[3]};
                o[dh] = __builtin_amdgcn_mfma_f32_32x32x16_bf16(pa, vf, o[dh], 0, 0, 0);
            }
        }
    LAS float* wsf = (LAS float*)(lds + AT_WS) + wid * 64;
    if (hi == 0) { wsf[r32] = l; *(f32x2*)(ML + (((size_t)br * NTOK + qtok) * 8 + h) * 2) = (f32x2){mx, l}; }
    LDS_WAIT();
    LAS bf16* stg = (LAS bf16*)(lds + AT_OST) + wid * 2048;
#pragma unroll
    for (int rg = 0; rg < 16; ++rg) { const int orow = crow(rg, hi); const float rl = fast_rcp(wsf[orow]);
#pragma unroll
        for (int dh = 0; dh < 2; ++dh) stg[orow * 64 + dh * 32 + r32] = (bf16)(pkbf(o[dh][rg] * rl, 0.f) & 0xffffu); }
    LDS_WAIT();
#pragma unroll
    for (int i = 0; i < 4; ++i) { const int row = i * 8 + (lane >> 3), ch = lane & 7; const v4u v = *(const LAS v4u*)(stg + row * 64 + ch * 8);
        const size_t ot = rowbase + (size_t)(m0 + 32 * wid + row) * d + r;
        *(v4u*)(part + ((size_t)br * NTOK + ot) * 512 + 64 * h + ch * 8) = v; }
    asm volatile("s_waitcnt lgkmcnt(0)\n\ts_barrier" ::: "memory");
}

constexpr int SG_ZT = 0, SG_ZT_STRIDE = 136  , SG_YT = 4 * 64 * SG_ZT_STRIDE * 2  , SG_END = SG_YT + 128 * 256 * 2;
static_assert(SG_END <= MISC_OFF, "sgu LDS");
__device__ __forceinline__ void sgu_unit(const bf16* proj, bf16* mixed, const bf16* WS, const float* sgain, const float* sbias, int chunk, LAS unsigned char* lds, int wave_s) {
    const int lane = pg8::lane_id_v(), wid = wave_s, tid = wid * 64 + lane, r32 = lane & 31, hi = lane >> 5;
    const size_t tok0 = (size_t)chunk * 128;
    LAS bf16* znT = (LAS bf16*)(lds + SG_ZT);
    LAS bf16* yt = (LAS bf16*)(lds + SG_YT);
    const int pce = tid & 31, g1 = pce >> 3, c1 = (pce & 7) * 8;
    f32x4 ga0 = *(const f32x4*)(sgain + g1 * 64 + c1), ga1 = *(const f32x4*)(sgain + g1 * 64 + c1 + 4);
#pragma unroll 2
    for (int it = 0; it < 8; ++it) {
        const int t = it * 16 + (tid >> 5);
        const bf16* rowp = proj + (tok0 + t) * PW;
        const v4u uv = *(const v4u*)(rowp + OU + 8 * pce);
        *(LAS v4u*)(yt + t * 256 + 8 * pce) = uv;
        const v4u zv = *(const v4u*)(rowp + OZ + 8 * pce);
        float z[8] = {bflo(zv.x), bfhi(zv.x), bflo(zv.y), bfhi(zv.y), bflo(zv.z), bfhi(zv.z), bflo(zv.w), bfhi(zv.w)};
        float s = 0.f;
#pragma unroll
        for (int e = 0; e < 8; ++e) s += z[e];
        s += __shfl_xor(s, 1); s += __shfl_xor(s, 2); s += __shfl_xor(s, 4);
        const float mean = s * (1.f / 64.f);
        float q = 0.f;
#pragma unroll
        for (int e = 0; e < 8; ++e) { z[e] -= mean; q += z[e] * z[e]; }
        q += __shfl_xor(q, 1); q += __shfl_xor(q, 2); q += __shfl_xor(q, 4);
        const float rstd = 1.0f / sqrtf(q * (1.f / 64.f) + LN_EPS);
        LAS bf16* zp = znT + (g1 * 64 + c1) * SG_ZT_STRIDE + t;
        zp[0 * SG_ZT_STRIDE] = (bf16)(pkbf(z[0] * rstd * ga0[0], 0.f) & 0xffffu); zp[1 * SG_ZT_STRIDE] = (bf16)(pkbf(z[1] * rstd * ga0[1], 0.f) & 0xffffu);
        zp[2 * SG_ZT_STRIDE] = (bf16)(pkbf(z[2] * rstd * ga0[2], 0.f) & 0xffffu); zp[3 * SG_ZT_STRIDE] = (bf16)(pkbf(z[3] * rstd * ga0[3], 0.f) & 0xffffu);
        zp[4 * SG_ZT_STRIDE] = (bf16)(pkbf(z[4] * rstd * ga1[0], 0.f) & 0xffffu); zp[5 * SG_ZT_STRIDE] = (bf16)(pkbf(z[5] * rstd * ga1[1], 0.f) & 0xffffu);
        zp[6 * SG_ZT_STRIDE] = (bf16)(pkbf(z[6] * rstd * ga1[2], 0.f) & 0xffffu); zp[7 * SG_ZT_STRIDE] = (bf16)(pkbf(z[7] * rstd * ga1[3], 0.f) & 0xffffu);
    }
    __syncthreads();
    {
        const int g = wid >> 1, ct = wid & 1;
        const bf16* wg_ = WS + (size_t)g * 128 * 128;
        const LAS bf16* zb = znT + (g * 64 + 32 * ct + r32) * SG_ZT_STRIDE + 8 * hi;
        for (int tt = 0; tt < 4; ++tt) {
            f32x16 a = {};
            for (int ks = 0; ks < 2 * (tt + 1); ++ks) {
                const bf16x8 af = *(const bf16x8*)(wg_ + (size_t)(32 * tt + r32) * 128 + 16 * ks + 8 * hi);
                const bf16x8 bfr = *(const LAS bf16x8*)(zb + 16 * ks);
                a = __builtin_amdgcn_mfma_f32_32x32x16_bf16(af, bfr, a, 0, 0, 0);
            }
#pragma unroll
            for (int rg = 0; rg < 16; ++rg) { const int t = 32 * tt + crow(rg, hi); LAS bf16* yp = yt + t * 256 + 64 * g + 32 * ct + r32;
                const float uval = bf2f(*yp); const float y = uval * (a[rg] + sbias[g * 128 + t]); *yp = (bf16)(pkbf(y, 0.f) & 0xffffu); }
        }
    }
    __syncthreads();
#pragma unroll 4
    for (int i = 0; i < 16; ++i) {
        const int t = wid * 16 + i;
        const v2u yv = *(const LAS v2u*)(yt + t * 256 + 4 * lane);
        const float y0 = bflo(yv.x), y1 = bfhi(yv.x), y2 = bflo(yv.y), y3 = bfhi(yv.y);
        const float ss = wave_sum((y0 * y0 + y1 * y1) + (y2 * y2 + y3 * y3));
        const float rs = 1.0f / sqrtf(ss * (1.f / 256.f) + LN_EPS);
        v2u w; w.x = pkbf(y0 * rs, y1 * rs); w.y = pkbf(y2 * rs, y3 * rs);
        *(v2u*)(mixed + (tok0 + t) * DM + 512 + 4 * lane) = w;
    }
    __syncthreads();
}
struct Args { const float* in[17]; float* out; unsigned char* ws; int ph_lo, ph_hi, nlayers, pad; };

__device__ __forceinline__ void combine_token(const bf16* part, const float* ML, bf16* mixed, size_t tok, int lane) {
    const int head = lane >> 3;
    f32x2 ml[3]; v4u pv[3];
#pragma unroll
    for (int br = 0; br < 3; ++br) { ml[br] = *(const f32x2*)(ML + (((size_t)br * NTOK + tok) * 8 + head) * 2); pv[br] = *(const v4u*)(part + ((size_t)br * NTOK + tok) * 512 + 8 * lane); }
    const float M = fmaxf(ml[0].x, fmaxf(ml[1].x, ml[2].x));
    float w[3], W = 0.f;
#pragma unroll
    for (int br = 0; br < 3; ++br) { w[br] = ml[br].y * fast_exp2(ml[br].x - M); W += w[br]; }
    const float rW = 1.0f / W;
    float o[8];
#pragma unroll
    for (int e = 0; e < 8; ++e) o[e] = 0.f;
#pragma unroll
    for (int br = 0; br < 3; ++br) { const float ww = w[br] * rW;
        o[0] += ww * bflo(pv[br].x); o[1] += ww * bfhi(pv[br].x); o[2] += ww * bflo(pv[br].y); o[3] += ww * bfhi(pv[br].y);
        o[4] += ww * bflo(pv[br].z); o[5] += ww * bfhi(pv[br].z); o[6] += ww * bflo(pv[br].w); o[7] += ww * bfhi(pv[br].w); }
    float ss = 0.f;
#pragma unroll
    for (int e = 0; e < 8; ++e) ss += o[e] * o[e];
    ss = wave_sum(ss);
    const float rs = 1.0f / sqrtf(ss * (1.f / 512.f) + LN_EPS);
    v4u ov; ov.x = pkbf(o[0] * rs, o[1] * rs); ov.y = pkbf(o[2] * rs, o[3] * rs); ov.z = pkbf(o[4] * rs, o[5] * rs); ov.w = pkbf(o[6] * rs, o[7] * rs);
    *(v4u*)(mixed + tok * DM + 8 * lane) = ov;
}
__device__ __forceinline__ void conv_token(const bf16* proj, const float* cw, bf16* mixed, size_t tok, int lane) {
    const int t = (int)(tok & (SEQ - 1));
    const f32x4 w0 = *(const f32x4*)(cw + 4 * lane), w1 = *(const f32x4*)(cw + 256 + 4 * lane), w2 = *(const f32x4*)(cw + 512 + 4 * lane);
    f32x4 acc = (f32x4){0.f, 0.f, 0.f, 0.f};
#pragma unroll
    for (int j = 0; j < 3; ++j) {
        if (t - 2 + j >= 0) {
            const bf16* rp = proj + (tok - 2 + j) * PW;
            const v2u gc = *(const v2u*)(rp + OGC + 4 * lane), hh = *(const v2u*)(rp + OH + 4 * lane);
            const f32x4 z = (f32x4){bflo(gc.x) * bflo(hh.x), bfhi(gc.x) * bfhi(hh.x), bflo(gc.y) * bflo(hh.y), bfhi(gc.y) * bfhi(hh.y)};
            acc += z * (j == 0 ? w0 : (j == 1 ? w1 : w2));
        }
    }
    const v2u gb = *(const v2u*)(proj + tok * PW + OGB + 4 * lane);
    const f32x4 y = (f32x4){bflo(gb.x), bfhi(gb.x), bflo(gb.y), bfhi(gb.y)} * acc;
    const float ss = wave_sum((y[0] * y[0] + y[1] * y[1]) + (y[2] * y[2] + y[3] * y[3]));
    const float rs = 1.0f / sqrtf(ss * (1.f / 256.f) + LN_EPS);
    v2u w; w.x = pkbf(y[0] * rs, y[1] * rs); w.y = pkbf(y[2] * rs, y[3] * rs);
    *(v2u*)(mixed + tok * DM + 768 + 4 * lane) = w;
}

__device__ __forceinline__ void route_block(const bf16* S, const bf16* Wrt  , const float* cr, const float* dr, const float* g1v, const float* b1v, bf16* XN, int* LIST, float* GATEL, gu32* cnt  ,
                                            int blk, LAS unsigned char* lds, int wave_s) {
    const int lane = pg8::lane_id_v(), wid = wave_s, tid = wid * 64 + lane, r32 = lane & 31, hi = lane >> 5;
    LAS unsigned* hist = (LAS unsigned*)(lds + TB_OFF + 129 * 4);
    LAS unsigned* base = hist + 64;
    if (tid < 64) hist[tid] = 0u;
    __syncthreads();
    const size_t tok = (size_t)blk * 256 + 32 * wid + r32;
    const bf16* srow = S + tok * DM + 8 * hi;
    const bf16* w0 = Wrt + (size_t)r32 * DM + 8 * hi; const bf16* w1 = w0 + 32 * DM;
    f32x16 a0 = {}, a1 = {};
    float ssum = 0.f, ssq = 0.f;
#pragma unroll 4
    for (int ks = 0; ks < 64; ++ks) {
        const v4u sv = *(const v4u*)(srow + 16 * ks);
        const bf16x8 bfr = __builtin_bit_cast(bf16x8, sv);
        const bf16x8 A0 = *(const bf16x8*)(w0 + 16 * ks), A1 = *(const bf16x8*)(w1 + 16 * ks);
        a0 = __builtin_amdgcn_mfma_f32_32x32x16_bf16(A0, bfr, a0, 0, 0, 0);
        a1 = __builtin_amdgcn_mfma_f32_32x32x16_bf16(A1, bfr, a1, 0, 0, 0);
        const float x0 = bflo(sv.x), x1 = bfhi(sv.x), x2 = bflo(sv.y), x3 = bfhi(sv.y), x4 = bflo(sv.z), x5 = bfhi(sv.z), x6 = bflo(sv.w), x7 = bfhi(sv.w);
        ssum += ((x0 + x1) + (x2 + x3)) + ((x4 + x5) + (x6 + x7));
        ssq += ((x0 * x0 + x1 * x1) + (x2 * x2 + x3 * x3)) + ((x4 * x4 + x5 * x5) + (x6 * x6 + x7 * x7));
    }
    ssum += __shfl_xor(ssum, 32); ssq += __shfl_xor(ssq, 32);
    const float mu = ssum * (1.f / 1024.f); const float var = ssq * (1.f / 1024.f) - mu * mu; const float rstd = 1.0f / sqrtf(var + LN_EPS);
    const float rsmu = rstd * mu;
    {
        bf16* xrow = XN + tok * DM + 8 * hi;
#pragma unroll 4
        for (int ks = 0; ks < 64; ++ks) {
            const v4u sv = *(const v4u*)(srow + 16 * ks);
            const f32x4 ga = *(const f32x4*)(g1v + 16 * ks + 8 * hi), gb = *(const f32x4*)(g1v + 16 * ks + 8 * hi + 4), ba = *(const f32x4*)(b1v + 16 * ks + 8 * hi), bb = *(const f32x4*)(b1v + 16 * ks + 8 * hi + 4);
            f32x4 x0 = (f32x4){bflo(sv.x), bfhi(sv.x), bflo(sv.y), bfhi(sv.y)}, x1 = (f32x4){bflo(sv.z), bfhi(sv.z), bflo(sv.w), bfhi(sv.w)};
            x0 = (x0 - mu) * rstd * ga + ba; x1 = (x1 - mu) * rstd * gb + bb;
            v4u w; w.x = pkbf(x0[0], x0[1]); w.y = pkbf(x0[2], x0[3]); w.z = pkbf(x1[0], x1[1]); w.w = pkbf(x1[2], x1[3]);
            *(v4u*)(xrow + 16 * ks) = w;
        }
    }
    float gl0 = rstd * a1[0] - rsmu * cr[32] + dr[32], gl1 = rstd * a1[1] - rsmu * cr[33] + dr[33], gl2 = rstd * a1[2] - rsmu * cr[34] + dr[34], gl3 = rstd * a1[3] - rsmu * cr[35] + dr[35];
    gl0 = __shfl(gl0, r32); gl1 = __shfl(gl1, r32); gl2 = __shfl(gl2, r32); gl3 = __shfl(gl3, r32);
    float gmax = gl0; int gi = 0;
    if (gl1 > gmax) { gmax = gl1; gi = 1; }
    if (gl2 > gmax) { gmax = gl2; gi = 2; }
    if (gl3 > gmax) { gmax = gl3; gi = 3; }
    const float gp = 1.0f / (expf(gl0 - gmax) + expf(gl1 - gmax) + expf(gl2 - gmax) + expf(gl3 - gmax));
    float own[4];
#pragma unroll
    for (int j = 0; j < 4; ++j) {
        const float raw = (gi == 0) ? a0[j] : (gi == 1) ? a0[4 + j] : (gi == 2) ? a0[8 + j] : a0[12 + j];
        const int n = 8 * gi + 4 * hi + j;
        own[j] = rstd * raw - rsmu * cr[n] + dr[n];
    }
    float oth[4];
#pragma unroll
    for (int j = 0; j < 4; ++j) oth[j] = __shfl_xor(own[j], 32);
    float v0 = -INFINITY, v1 = -INFINITY; int i0 = 0, i1 = 0;
#pragma unroll
    for (int j = 0; j < 8; ++j) {
        const float lo = (hi == 0) ? own[j & 3] : oth[j & 3], hv = (hi == 0) ? oth[j & 3] : own[j & 3];
        const float v = (j < 4) ? lo : hv;
        if (v > v0) { v1 = v0; i1 = i0; v0 = v; i0 = j; } else if (v > v1) { v1 = v; i1 = j; }
    }
    const float e1 = expf(v1 - v0);
    const float p0 = 1.0f / (1.0f + e1), p1 = e1 / (1.0f + e1);
    const int b0 = gi * 8 + i0, b1 = 32 + gi * 8 + i1;
    unsigned r0 = 0u, r1 = 0u;
    if (hi == 0) { r0 = __hip_atomic_fetch_add(hist + b0, 1u, __ATOMIC_RELAXED, __HIP_MEMORY_SCOPE_WORKGROUP); r1 = __hip_atomic_fetch_add(hist + b1, 1u, __ATOMIC_RELAXED, __HIP_MEMORY_SCOPE_WORKGROUP); }
    __syncthreads();
    if (tid < 64) base[tid] = __hip_atomic_fetch_add(cnt + 16 * tid, hist[tid], RLX_AGENT);
    __syncthreads();
    if (hi == 0) {
        const size_t s0 = (size_t)b0 * NTOK + base[b0] + r0, s1 = (size_t)b1 * NTOK + base[b1] + r1;
        LIST[s0] = (int)tok; GATEL[s0] = gp * p0; LIST[s1] = (int)tok; GATEL[s1] = gp * p1;
    }
    __syncthreads();
}

__device__ __forceinline__ void moe_setup(const gu32* cnt, const int* LIST, int kind, bool gather, int G, int vcu, LAS unsigned char* lds, int wave_s) {
    const int tid = wave_s * 64 + pg8::lane_id_v();
    LAS int* tb = (LAS int*)(lds + TB_OFF);
    LAS int* cl = tb + 65;
    LAS int* ut = (LAS int*)(lds + UT_OFF);
    LAS int* tab = (LAS int*)(lds + TAB_OFF);
    if (tid < 64) cl[tid] = (int)__hip_atomic_load(cnt + 16 * tid, RLX_AGENT);
    __syncthreads();
    if (tid == 0) { int a = 0; for (int b = 0; b < 64; ++b) { tb[b] = a; a += (cl[b] + 255) >> 8; } tb[64] = a; }
    __syncthreads();
    if (tid < NU_MAX) {
        const int tlo = (kind == 2) ? tb[32] : 0, thi = (kind == 1) ? tb[32] : tb[64];
        const int L = tid * G + vcu;
        int nv = -1, tile = 0, pn = 0, bin = 0, rb = 0;
        if (L < (thi - tlo) * 4) {
            tile = tlo + (L >> 2); pn = L & 3;
            for (int b = 0; b < 64; ++b) if (tile >= tb[b] && tile < tb[b + 1]) bin = b;
            rb = (tile - tb[bin]) * 256; nv = cl[bin] - rb; nv = nv > 256 ? 256 : nv;
        }
        ut[tid * 8 + 0] = tile; ut[tid * 8 + 1] = pn; ut[tid * 8 + 2] = bin & 31; ut[tid * 8 + 3] = bin; ut[tid * 8 + 4] = rb; ut[tid * 8 + 5] = nv;
    }
    __syncthreads();
    if (gather) {
        for (int i = 0; i < NU_MAX; ++i) { const int nv = ut[i * 8 + 5]; if (nv < 0) break;
            if (tid < 256) { int tok = 0; if (tid < nv) tok = LIST[(size_t)ut[i * 8 + 3] * NTOK + ut[i * 8 + 4] + tid]; tab[i * 256 + tid] = tok; } }
        __syncthreads();
    }
}

__global__ void __launch_bounds__(NWAVES * 64, 2) mega_fwd(Args args) {
    extern __shared__ __attribute__((aligned(16))) unsigned char lds_raw[];
    LAS unsigned char* lds = (LAS unsigned char*)lds_raw;
    volatile LAS unsigned* MISC = (volatile LAS unsigned*)(lds + MISC_OFF);
    const int wave = __builtin_amdgcn_readfirstlane((int)threadIdx.x >> 6);
#define LANE_TID() const int lane = pg8::lane_id_v(); const int tid = wave * 64 + lane; (void)tid
    const int G = gridDim.x; const int bx = blockIdx.x; const int vcu = (G % 8 == 0) ? (bx % 8) * (G / 8) + bx / 8 : bx;
    unsigned char* ws_top = args.ws;
    gu32* ctl = (gu32*)(ws_top + WS_CTL);
#define WS_PTRS() unsigned char* ws = ws_top; asm volatile("" : "+s"(ws)); \
    float* VEC = (float*)(ws + WS_VEC); float* CS = (float*)(ws + WS_ROPE); \
    bf16* WIN = (bf16*)(ws + WS_WIN); bf16* WOUT = (bf16*)(ws + WS_WOUT); bf16* WRT = (bf16*)(ws + WS_WRT); bf16* WSGU = (bf16*)(ws + WS_WSGU); \
    bf16* WGU = (bf16*)(ws + WS_WGU); bf16* WD = (bf16*)(ws + WS_WD); \
    bf16* Sb = (bf16*)(ws + WS_S); float* ST = (float*)(ws + WS_ST); float* RS0 = (float*)(ws + WS_RS0); bf16* XN1 = (bf16*)(ws + WS_MIXED); \
    bf16* PROJ = (bf16*)(ws + WS_PROJ); bf16* MIXED = (bf16*)(ws + WS_MIXED); bf16* PART = (bf16*)(ws + WS_PART); float* ML = (float*)(ws + WS_ML); \
    bf16* Hb = (bf16*)(ws + WS_H); int* LIST = (int*)(ws + WS_LIST); float* GATEL = (float*)(ws + WS_GATE); \
    (void)VEC; (void)CS; (void)WIN; (void)WOUT; (void)WRT; (void)WSGU; (void)WGU; (void)WD; (void)Sb; (void)ST; (void)RS0; (void)XN1; (void)PROJ; (void)MIXED; (void)PART; (void)ML; (void)Hb; (void)LIST; (void)GATEL
    const float* x_in = args.in[0]; const float* w_in = args.in[1]; const float* w_out = args.in[2]; const float* branch_gain = args.in[3]; const float* sgu_gain = args.in[4];
    const float* sgu_w = args.in[5]; const float* sgu_b = args.in[6]; const float* conv_w = args.in[7]; const float* ln_gain = args.in[8]; const float* ln_bias = args.in[9];
    const float* rgw = args.in[10]; const float* rgb = args.in[11]; const float* rew = args.in[12]; const float* reb = args.in[13];
    const float* ewg = args.in[14]; const float* ewu = args.in[15]; const float* ewd = args.in[16];

    { LANE_TID(); for (int u = tid; u < (LDS_BYTES - TAB_OFF) / 4; u += NWAVES * 64) ((LAS unsigned*)(lds + TAB_OFF))[u] = 0u; }
    __syncthreads();
    XcdBarrier bar = xcd_barrier_post((unsigned*)(ctl + CW_BAR), MISC + 8);
    const int gw = vcu * NWAVES + wave, NGW = G * NWAVES;
    LAS float* scr = (LAS float*)(lds + RING_OFF + wave * 16384);
    const int lo = args.ph_lo, hi_ph = args.ph_hi;
#ifndef PHASE_MASK
#define PHASE_MASK 0xFFFFu
#endif
#define IN(k) (((PHASE_MASK >> ((k) == 0 ? 0 : ((k) == 99 ? 9 : 1 + (((k) - 1) & 15)))) & 1u) && lo <= (k) && (k) < hi_ph)

    if (IN(0)) {
        WS_PTRS(); LANE_TID();
        for (int i = gw * 64 + lane; i < 1024; i += NGW * 64) { VEC[V_ONES + i] = 1.0f; VEC[V_ZEROS + i] = 0.0f; }
        for (int m = gw; m < NTOK; m += NGW) {
            const GAS f32x4* xr = (const GAS f32x4*)(x_in + (size_t)m * DM) + lane;
            GAS v2u* o8 = (GAS v2u*)(Sb + (size_t)m * DM) + lane;
#pragma unroll
            for (int j = 0; j < 4; ++j) { const f32x4 v = xr[64 * j]; v2u w; w.x = pkbf(v[0], v[1]); w.y = pkbf(v[2], v[3]); o8[64 * j] = w; }
            if (lane < 32) ST[(size_t)m * 32 + lane] = (lane == 1) ? 1024.0f * (1.0f - LN_EPS) : 0.0f;
        }
        for (int i = gw * 64 + lane; i < SEQ * 32; i += NGW * 64) { const int t = i >> 5, f = i & 31; const float inv_freq = powf(10000.0f, -(float)f / 32.0f); const float ang = (float)t * inv_freq;
            float sn, cn; sincosf(ang, &sn, &cn); CS[2 * i] = cn; CS[2 * i + 1] = sn; }
        constexpr int I_IN = 4 * 88, I_OUT = 4 * 32;
        for (int it = gw; it < I_IN + I_OUT; it += NGW) {
            if (it < I_IN) { const int l = it / 88, nb = it % 88, n0 = nb * 32;
                const float* sc = (l == 0) ? nullptr : ln_gain + (size_t)(l - 1) * 2048 + 1024; const float* bk = (l == 0) ? nullptr : ln_bias + (size_t)(l - 1) * 2048 + 1024;
                bf16* wt = WIN + ((size_t)l * PW + n0) * DM; float* cs = VEC + V_CIN + l * PW + n0; float* ds = VEC + V_DIN + l * PW + n0;
                if (n0 < 1024) conv_item(w_in + (size_t)l * DM * PW, DM, PW, ColRope(), n0, wt, 1, sc, bk, cs, ds, scr, lane);
                else conv_item(w_in + (size_t)l * DM * PW, DM, PW, ColId(), n0, wt, 1, sc, bk, cs, ds, scr, lane);
            } else { const int r = it - I_IN, l = r / 32, n0 = (r % 32) * 32;
                conv_item(w_out + (size_t)l * DM * DM, DM, DM, ColId(), n0, WOUT + ((size_t)l * DM + n0) * DM, 1, branch_gain + (size_t)l * 1024, nullptr, nullptr, nullptr, scr, lane); }
        }
        for (int i = gw * 64 + lane; i < 4 * 4 * 128 * 128; i += NGW * 64) { const int s = i & 127, t = (i >> 7) & 127; WSGU[i] = (bf16)(pkbf((s <= t) ? sgu_w[i] : 0.0f, 0.f) & 0xffffu); }
        for (int it = gw; it < 4 * 64; it += NGW) {
            const int l = it >> 6, n = it & 63; const float* g1 = ln_gain + (size_t)l * 2048; const float* b1 = ln_bias + (size_t)l * 2048;
            float cs = 0.f, ds = 0.f;
            for (int k = lane; k < DM; k += 64) { float w = 0.f; if (n < 32) w = rew[((size_t)l * DM + k) * 32 + n]; else if (n < 36) w = rgw[((size_t)l * DM + k) * 4 + (n - 32)];
                const float v = rbf(w * g1[k]); cs += v; ds += b1[k] * w; WRT[((size_t)l * 64 + n) * DM + k] = (bf16)(pkbf(v, 0.f) & 0xffffu); }
            cs = wave_sum(cs); ds = wave_sum(ds);
            if (lane == 0) { float bias = 0.f; if (n < 32) bias = reb[l * 32 + n]; else if (n < 36) bias = rgb[l * 4 + n - 32]; VEC[V_CR + l * 64 + n] = cs; VEC[V_DR + l * 64 + n] = ds + bias; }
        }
        xcd_barrier(bar);
    }

    for (int l = 0; l < args.nlayers; ++l) {
        const int pb = 1 + l * 16;
        const float* G1 = ln_gain + (size_t)l * 2048; const float* B1 = ln_bias + (size_t)l * 2048;
        gu32* cnt = ctl + CW_CNT + l * 64 * 16;

        if (IN(pb + 0)) {
            WS_PTRS();
            pg8::Gemm g{Sb, WIN + (size_t)l * PW * DM, DM}; pg8::DenseOrder S; S.init(NTOK, PW, DM, G, bx);
            EpiProj E{PROJ, VEC + V_CIN + l * PW, VEC + V_DIN + l * PW, ST, RS0, CS};
            pg8::gemm_phase<EpiProj, pg8::DenseOrder, false>(lds + RING_OFF, g, S, E, nullptr, wave);
            xcd_barrier(bar);
        }
        if (IN(pb + 1)) {
            WS_PTRS();
            for (int U = vcu; U < 8 * 8 * 96; U += G) { const int bh = U / 96, rem = U % 96; attn_unit(PROJ, PART, ML, bh >> 3, bh & 7, rem >> 5, rem & 31, lds, wave); }
            xcd_barrier(bar);
        }
        if (IN(pb + 2)) {
            WS_PTRS(); LANE_TID();
            for (int c = vcu; c < NTOK / 128; c += G) sgu_unit(PROJ, MIXED, WSGU + (size_t)l * 4 * 128 * 128, sgu_gain + (size_t)l * 256, sgu_b + (size_t)l * 512, c, lds, wave);
            for (int m = gw; m < NTOK; m += NGW) { combine_token(PART, ML, MIXED, (size_t)m, lane); conv_token(PROJ, conv_w + (size_t)l * 768, MIXED, (size_t)m, lane); }
            xcd_barrier(bar);
        }
        if (IN(pb + 3)) {
            WS_PTRS();
            pg8::Gemm g{MIXED, WOUT + (size_t)l * DM * DM, DM}; pg8::DenseOrder S; S.init(NTOK, DM, DM, G, bx);
            const float* Gp = (l == 0) ? VEC + V_ONES : ln_gain + (size_t)(l - 1) * 2048 + 1024;
            const float* Bp = (l == 0) ? VEC + V_ZEROS : ln_bias + (size_t)(l - 1) * 2048 + 1024;
            EpiRes1 E{Sb, RS0, Gp, Bp};
            pg8::gemm_phase<EpiRes1, pg8::DenseOrder, false>(lds + RING_OFF, g, S, E, nullptr, wave);
            xcd_barrier(bar);
        }
        if (IN(pb + 4)) {
            WS_PTRS(); LANE_TID();
            for (int blk = vcu; blk < NTOK / 256; blk += G) route_block(Sb, WRT + (size_t)l * 64 * DM, VEC + V_CR + l * 64, VEC + V_DR + l * 64, G1, B1, XN1, LIST, GATEL, cnt, blk, lds, wave);
            for (int it = gw; it < 2048; it += NGW) {
                if (it < 1024) { const int e = it >> 5, mat = (it >> 4) & 1, n0 = (it & 15) * 32;
                    const float* W = (mat ? ewu : ewg) + ((size_t)l * 32 + e) * DM * 512;
                    conv_item(W, DM, 512, ColId(), n0, WGU + ((size_t)e * 1024 + 2 * n0 + mat) * DM, 2, nullptr, nullptr, nullptr, nullptr, scr, lane);
                } else { const int r = it - 1024, e = r >> 5, n0 = (r & 31) * 32;
                    conv_item(ewd + ((size_t)l * 32 + e) * 512 * DM, 512, DM, ColId(), n0, WD + ((size_t)e * 1024 + n0) * 512, 1, nullptr, nullptr, nullptr, nullptr, scr, lane); }
            }
            xcd_barrier(bar);
        }
        if (IN(pb + 5)) {
            WS_PTRS();
            moe_setup(cnt, LIST, 0, true, G, vcu, lds, wave);
            pg8::Gemm g{XN1, WGU, DM}; MoeOrder S{(const LAS int*)(lds + UT_OFF), DM, (size_t)1024 * DM * 2};
            EpiSwiglu E{Hb};
            pg8::gemm_phase<EpiSwiglu, MoeOrder, true>(lds + RING_OFF, g, S, E, (const LAS int*)(lds + TAB_OFF), wave);
            xcd_barrier(bar);
        }
        if (IN(pb + 6)) {
            WS_PTRS();
            moe_setup(cnt, LIST, 1, false, G, vcu, lds, wave);
            pg8::Gemm g{Hb, WD, 512}; MoeOrder S{(const LAS int*)(lds + UT_OFF), 512, (size_t)1024 * 512 * 2};
            EpiDown<false> E{Sb, XN1, LIST, GATEL, ST};
            pg8::gemm_phase<EpiDown<false>, MoeOrder, false>(lds + RING_OFF, g, S, E, nullptr, wave);
            xcd_barrier(bar);
        }
        if (IN(pb + 7)) {
            WS_PTRS();
            moe_setup(cnt, LIST, 2, false, G, vcu, lds, wave);
            pg8::Gemm g{Hb, WD, 512}; MoeOrder S{(const LAS int*)(lds + UT_OFF), 512, (size_t)1024 * 512 * 2};
            EpiDown<true> E{Sb, XN1, LIST, GATEL, ST};
            pg8::gemm_phase<EpiDown<true>, MoeOrder, false>(lds + RING_OFF, g, S, E, nullptr, wave);
            xcd_barrier(bar);
        }
    }
    if (IN(99)) {
        WS_PTRS(); LANE_TID();
        const int l = args.nlayers - 1;
        const float* G2 = ln_gain + (size_t)l * 2048 + 1024; const float* B2 = ln_bias + (size_t)l * 2048 + 1024;
        const unsigned poison = (__hip_atomic_load(ctl + CW_BAR + XB_TMO, RLX_AGENT) != 0u);
        for (int m = gw; m < NTOK; m += NGW) {
            float s = 0.f, q = 0.f;
            if (lane < 16) { const f32x2 p = *(const f32x2*)(ST + (size_t)m * 32 + 2 * lane); s = p.x; q = p.y; }
            s = wave_sum(s); q = wave_sum(q);
            const float mu = s * (1.f / 1024.f); const float var = q * (1.f / 1024.f) - mu * mu; float rstd = 1.0f / sqrtf(var + LN_EPS);
            if (poison) rstd = __builtin_nanf("");
#pragma unroll
            for (int j = 0; j < 2; ++j) {
                const int c = 512 * j + 8 * lane;
                const v4u o = *(const v4u*)(Sb + (size_t)m * DM + c);
                const f32x4 g0 = *(const f32x4*)(G2 + c), g1 = *(const f32x4*)(G2 + c + 4), b0 = *(const f32x4*)(B2 + c), b1 = *(const f32x4*)(B2 + c + 4);
                f32x4 x0 = (f32x4){bflo(o.x), bfhi(o.x), bflo(o.y), bfhi(o.y)}, x1 = (f32x4){bflo(o.z), bfhi(o.z), bflo(o.w), bfhi(o.w)};
                x0 = (x0 - mu) * rstd * g0 + b0; x1 = (x1 - mu) * rstd * g1 + b1;
                *(f32x4*)(args.out + (size_t)m * DM + c) = x0; *(f32x4*)(args.out + (size_t)m * DM + c + 4) = x1;
            }
        }
    }
#undef IN
}

static int g_grid = 0;
static int mega_prepare() {
    if (g_grid != 0) return g_grid;
    int dev = 0, cus = 0, per_cu = 0;
    if (hipGetDevice(&dev) != hipSuccess || hipDeviceGetAttribute(&cus, hipDeviceAttributeMultiprocessorCount, dev) != hipSuccess) { g_grid = -1; return g_grid; }
    if (hipFuncSetAttribute((const void*)mega_fwd, hipFuncAttributeMaxDynamicSharedMemorySize, LDS_BYTES) != hipSuccess) { fprintf(stderr, "hipFuncSetAttribute failed\n"); g_grid = -1; return g_grid; }
    if (hipOccupancyMaxActiveBlocksPerMultiprocessor(&per_cu, (const void*)mega_fwd, NWAVES * 64, LDS_BYTES) != hipSuccess || per_cu < 1) { fprintf(stderr, "occupancy query: %d blocks per CU\n", per_cu); }
    (void)hipGetLastError();
    g_grid = cus;
    return g_grid;
}
static void mega_launch(void* const* d_in, float* out, unsigned char* ws, hipStream_t stream, int ph_lo, int ph_hi, int nlayers) {
    const int grid = mega_prepare(); if (grid <= 0) return;
    (void)hipMemsetAsync(ws + WS_CTL, 0, CTL_ZERO_BYTES, stream);
    Args a{};
    for (int i = 0; i < 17; ++i) a.in[i] = (const float*)d_in[i];
    a.out = out; a.ws = ws; a.ph_lo = ph_lo; a.ph_hi = ph_hi; a.nlayers = nlayers; a.pad = 0;
    hipLaunchKernelGGL(mega_fwd, dim3(grid), dim3(NWAVES * 64), LDS_BYTES, stream, a);
}
extern "C" void kernel_launch(void* const* d_in, const int* in_sizes, int n_in, void* d_out, int out_size, void* d_ws, size_t ws_size, hipStream_t stream) {
    if (n_in != 17 || ws_size < WS_END) { fprintf(stderr, "kernel_launch: unexpected n_in %d / ws_size %zu\n", n_in, ws_size); return; }
    mega_launch(d_in, (float*)d_out, (unsigned char*)d_ws, stream, 0, 100, NL);
}
```

```cpp
#include <hip/hip_runtime.h>
#include <cstdio>
#include <cstdint>
#include <cmath>
namespace pg8 {
#define PG8_LAS __attribute__((address_space(3)))
typedef unsigned short bf16_t;
typedef short bf16x8 __attribute__((ext_vector_type(8)));
typedef float f32x4 __attribute__((ext_vector_type(4)));
typedef float f32x2 __attribute__((ext_vector_type(2)));
typedef unsigned u32x4 __attribute__((ext_vector_type(4)));
typedef unsigned u32x2 __attribute__((ext_vector_type(2)));
constexpr int BM = 256, BK = 64, HALF = 128, HTB = HALF * BK * 2  , STAGE_BYTES = 8 * HTB, NXCD = 8, WGM = 8;

__host__ __device__ __forceinline__ int lds_byte(int r, int c) { const int st = (r >> 4) * 2 + (c >> 5), rr = r & 15, cc = c & 31, ob = rr * 64 + cc * 2; return st * 1024 + (ob ^ (((ob >> 9) & 1) << 5)); }
__host__ __device__ __forceinline__ void stage_rc(int b, int& R, int& C) { const int st = b / 1024, sb = b % 1024, swz = sb ^ (((sb >> 9) & 1) << 5); R = (st >> 1) * 16 + swz / 64; C = (st & 1) * 32 + (swz % 64) / 2; }
__host__ __device__ __forceinline__ int perm32(int rho) { const int n = rho >> 4, i = rho & 15; return 8 * (i >> 2) + 4 * n + (i & 3); }

struct Unit { int pm, pn, e, bin, rbase, nvalid, e2; };
struct Gemm { const bf16_t* A; const bf16_t* Bt; int K; };

struct DenseOrder {
    int nM, nN, nwg, G, c, K;
    __device__ __forceinline__ void init(int M, int N, int K_, int G_, int c_) { nM = M / BM; nN = N / BM; nwg = nM * nN; G = G_; c = c_; K = K_; }
    __device__ __forceinline__ bool next(int i, Unit& u) const {
        const long L = (long)i * G + c; if (L >= nwg) return false;
        int wgid = (int)L; { const int q = nwg / NXCD, r = nwg % NXCD, xcd = wgid % NXCD, off = wgid / NXCD; wgid = (xcd < r ? xcd * (q + 1) : r * (q + 1) + (xcd - r) * q) + off; }
        const int nig = WGM * nN, gid = wgid / nig, fm = gid * WGM, gsz = (nM - fm) < WGM ? (nM - fm) : WGM;
        u.pm = fm + ((wgid % nig) % gsz); u.pn = (wgid % nig) / gsz; u.e = 0; u.bin = 0; u.rbase = 0; u.nvalid = 256; u.e2 = 0; return true;
    }
    __device__ __forceinline__ size_t a_off(const Unit& u) const { return (size_t)u.pm * (size_t)(BM * 2) * K; }
    __device__ __forceinline__ size_t b_off(const Unit& u) const { return (size_t)u.pn * (size_t)(BM * 2) * K; }
    __device__ __forceinline__ size_t b_off2(const Unit& u) const { return b_off(u); }
};

#ifdef TSEC
#define TS_DECL() unsigned long long ts0_ = 0
#define TS_BEGIN(id) do { if (TSEC == (id)) ts0_ = __builtin_amdgcn_s_memrealtime(); } while (0)
#define TS_END(id, ldsbase, wave) do { if (TSEC == (id)) { const unsigned long long d_ = __builtin_amdgcn_s_memrealtime() - ts0_; if (pg8::lane_id_v() == 0) ((volatile PG8_LAS unsigned*)((ldsbase) + 163840 - 256 + 64))[wave] += (unsigned)d_; } } while (0)
#else
#define TS_DECL() do { } while (0)
#define TS_BEGIN(id) do { } while (0)
#define TS_END(id, ldsbase, wave) do { } while (0)
#endif
__device__ __forceinline__ int lane_id_v() { int l; asm volatile("v_mbcnt_lo_u32_b32 %0, -1, 0\n\tv_mbcnt_hi_u32_b32 %0, -1, %0" : "=v"(l)); return l; }
__device__ __forceinline__ unsigned cvt_pk_bf16(float lo, float hi) { unsigned r; asm volatile("v_cvt_pk_bf16_f32 %0, %1, %2" : "=v"(r) : "v"(lo), "v"(hi)); return r; }

template <class Epi, class Sched, bool GATHER, bool DUALB = false>
__device__ __forceinline__ void gemm_phase(PG8_LAS unsigned char* lds, const Gemm g, const Sched& S, const Epi& E, const PG8_LAS unsigned short* tab, int wave_s) {
    const int lane = lane_id_v(), wid = wave_s, tid = wid * 64 + lane,
              wr = wid >> 2, wc = wid & 3, fr = lane & 15, fq = lane >> 4;
    const int K = g.K, nt = K / BK, Kb = DUALB ? K / 2 : K, nth = nt / 2;
    unsigned voffA[2], voffB[2]; int RA[2]; unsigned CA2[2];
#pragma unroll
    for (int i = 0; i < 2; ++i) { int R, C; stage_rc(tid * 16 + i * 8192, R, C); const int Rb = Epi::PERM ? ((R & ~31) + perm32(R & 31)) : R;
        voffA[i] = (unsigned)(R * K + C) * 2u; voffB[i] = (unsigned)(Rb * Kb + C) * 2u; RA[i] = R; CA2[i] = (unsigned)C * 2u; }
    const size_t kstep = (size_t)(BK * 2);
    const size_t hstep = (size_t)HALF * K * 2;
    const size_t hstepB = (size_t)HALF * Kb * 2;
    const unsigned ldsw = (unsigned)wid * 1024u;
    const int aoff = lds_byte(wr * 64 + fr, fq * 8), boff = lds_byte(wc * 32 + fr, fq * 8);
#define PG8_SA(b, h) (((b) * 2 + (h)) * HTB)
#define PG8_SB(b, h) ((4 + (b) * 2 + (h)) * HTB)
#define PG8_STAGE(bufoff, gbase, voff) do { _Pragma("unroll") for (int _i = 0; _i < 2; ++_i) \
        __builtin_amdgcn_global_load_lds((const unsigned*)((const char*)(gbase) + (voff)[_i]), (PG8_LAS unsigned*)(lds + (bufoff) + ldsw + _i * 8192), 16, 0, 0); } while (0)
#define PG8_LDA(dst, b, h) do { _Pragma("unroll") for (int m = 0; m < 4; ++m) _Pragma("unroll") for (int k = 0; k < 2; ++k) dst[m][k] = *(const PG8_LAS bf16x8*)(lds + PG8_SA(b, h) + aoff + m * 2048 + k * 1024); } while (0)
#define PG8_LDB(dst, b, h) do { _Pragma("unroll") for (int n = 0; n < 2; ++n) _Pragma("unroll") for (int k = 0; k < 2; ++k) dst[n][k] = *(const PG8_LAS bf16x8*)(lds + PG8_SB(b, h) + boff + n * 2048 + k * 1024); } while (0)
#define PG8_MMA(ai, bj, At, Bt) do { __builtin_amdgcn_s_setprio(1); _Pragma("unroll") for (int m = 0; m < 4; ++m) _Pragma("unroll") for (int n = 0; n < 2; ++n) _Pragma("unroll") for (int k = 0; k < 2; ++k) \
        acc[ai][bj][m][n] = __builtin_amdgcn_mfma_f32_16x16x32_bf16(Bt[n][k], At[m][k], acc[ai][bj][m][n], 0, 0, 0); __builtin_amdgcn_s_setprio(0); } while (0)
#define PG8_WAIT_V(n) asm volatile("s_waitcnt vmcnt(" #n ")" ::: "memory")
#define PG8_WAIT_L(n) asm volatile("s_waitcnt lgkmcnt(" #n ")" ::: "memory")
#define PG8_WAIT_V01(flag) do { if constexpr (Epi::NSTORE >= 16) { asm volatile("s_cmp_eq_u32 %0, 0\n\ts_cbranch_scc1 .Lw8_%=\n\ts_waitcnt vmcnt(24)\n\ts_branch .Lwd_%=\n.Lw8_%=:\n\ts_waitcnt vmcnt(8)\n.Lwd_%=:" :: "s"(__builtin_amdgcn_readfirstlane(flag)) : "memory", "scc"); } else { asm volatile("s_waitcnt vmcnt(8)" ::: "memory"); } } while (0)
#define PG8_BAR __builtin_amdgcn_s_barrier()
#define PG8_SCHED __builtin_amdgcn_sched_barrier(0)
    Unit cur, nxt; int ui = 0;
    if (!S.next(0, cur)) return;
    f32x4 acc[2][2][4][2];
#pragma unroll
    for (int a = 0; a < 2; ++a)
#pragma unroll
        for (int b = 0; b < 2; ++b)
#pragma unroll
            for (int m = 0; m < 4; ++m)
#pragma unroll
                for (int n = 0; n < 2; ++n) acc[a][b][m][n] = (f32x4){0.f, 0.f, 0.f, 0.f};
    bf16x8 At[4][2], B0[2][2], B1[2][2];
    [[maybe_unused]] u32x4 pq0 = (u32x4){0u, 0u, 0u, 0u};
    unsigned vc0[2], vc1[2], vn0[2], vn1[2];
#pragma unroll
    for (int i = 0; i < 2; ++i) {
        if constexpr (GATHER) { vc0[i] = (unsigned)tab[RA[i]] * (unsigned)(K * 2) + CA2[i]; vc1[i] = (unsigned)tab[128 + RA[i]] * (unsigned)(K * 2) + CA2[i]; }
        else { vc0[i] = voffA[i]; vc1[i] = voffA[i] + (unsigned)hstep; }
        vn0[i] = vc0[i]; vn1[i] = vc1[i];
    }
    const char* cA = (const char*)g.A + (GATHER ? (size_t)0 : S.a_off(cur)); const char* cB = (const char*)g.Bt + S.b_off(cur); const char* cB1 = (const char*)g.Bt + S.b_off2(cur);
    PG8_STAGE(PG8_SB(0, 0), cB, voffB); PG8_STAGE(PG8_SB(0, 1), cB + hstepB, voffB); PG8_STAGE(PG8_SA(0, 0), cA, vc0); PG8_STAGE(PG8_SA(0, 1), cA, vc1);
    if (wr == 1) PG8_BAR;
    PG8_WAIT_V(2); PG8_BAR;
    PG8_STAGE(PG8_SB(1, 0), cB + kstep, voffB); PG8_STAGE(PG8_SA(1, 0), cA + kstep, vc0); PG8_STAGE(PG8_SB(1, 1), cB + hstepB + kstep, voffB);
    PG8_WAIT_V(6); PG8_BAR;
    for (;;) {
        const bool has_next = S.next(ui + 1, nxt);
        const char* nA = has_next ? (const char*)g.A + (GATHER ? (size_t)0 : S.a_off(nxt)) : cA; const char* nB = has_next ? (const char*)g.Bt + S.b_off(nxt) : cB; const char* nB1 = has_next ? (const char*)g.Bt + S.b_off2(nxt) : cB1;
        if constexpr (GATHER) { if (has_next) {
#pragma unroll
            for (int i = 0; i < 2; ++i) { vn0[i] = (unsigned)tab[(ui + 1) * 256 + RA[i]] * (unsigned)(K * 2) + CA2[i]; vn1[i] = (unsigned)tab[(ui + 1) * 256 + 128 + RA[i]] * (unsigned)(K * 2) + CA2[i]; } } }
#define PG8_TRIP(t, W01) { \
            const int rlx_ = (Epi::NSTORE >= 16 && (t) == 0 && ui > 0) ? 1 : 0; \
            const bool last = (t == nt - 2); \
            const char* a1 = cA + (size_t)(t + 1) * kstep; \
            const char* a2 = last ? nA : cA + (size_t)(t + 2) * kstep; \
            const char* b2 = last ? nB : (DUALB ? ((t + 2 < nth) ? cB + (size_t)(t + 2) * kstep : cB1 + (size_t)(t + 2 - nth) * kstep) : cB + (size_t)(t + 2) * kstep); \
            const char* a3 = a2 + kstep; const char* b3 = b2 + kstep; \
            unsigned x0[2], x1[2]; \
            x0[0] = last ? vn0[0] : vc0[0]; x0[1] = last ? vn0[1] : vc0[1]; x1[0] = last ? vn1[0] : vc1[0]; x1[1] = last ? vn1[1] : vc1[1]; \
            PG8_LDB(B0, 0, 0); PG8_LDB(B1, 0, 1); PG8_SCHED; PG8_LDA(At, 0, 0); PG8_STAGE(PG8_SA(1, 1), a1, vc1); \
            PG8_WAIT_V01(rlx_); PG8_WAIT_L(0); PG8_BAR; PG8_MMA(0, 0, At, B0); PG8_MMA(0, 1, At, B1); PG8_BAR; PG8_SCHED; \
            PG8_LDA(At, 0, 1); PG8_STAGE(PG8_SB(0, 0), b2, voffB); PG8_STAGE(PG8_SB(0, 1), b2 + hstepB, voffB); PG8_STAGE(PG8_SA(0, 0), a2, x0); \
            PG8_WAIT_V01(rlx_); PG8_WAIT_L(0); PG8_BAR; PG8_MMA(1, 0, At, B0); PG8_MMA(1, 1, At, B1); PG8_BAR; PG8_SCHED; \
            if constexpr (Epi::HAS_PRE) { E.pre(acc, cur, t, pq0, wr, wc, fr, fq); PG8_SCHED; } \
            PG8_LDB(B0, 1, 0); PG8_LDB(B1, 1, 1); PG8_SCHED; PG8_LDA(At, 1, 0); PG8_STAGE(PG8_SA(0, 1), a2, x1); \
            PG8_WAIT_V(8); PG8_WAIT_L(0); PG8_BAR; PG8_MMA(0, 0, At, B0); PG8_MMA(0, 1, At, B1); PG8_BAR; PG8_SCHED; \
            PG8_LDA(At, 1, 1); PG8_STAGE(PG8_SB(1, 0), b3, voffB); PG8_STAGE(PG8_SB(1, 1), b3 + hstepB, voffB); PG8_STAGE(PG8_SA(1, 0), a3, x0); \
            PG8_WAIT_V(8); PG8_WAIT_L(0); PG8_BAR; PG8_MMA(1, 0, At, B0); PG8_MMA(1, 1, At, B1); PG8_BAR; PG8_SCHED; \
            if constexpr (Epi::HAS_PRE) { E.pre(acc, cur, t + 1, pq0, wr, wc, fr, fq); PG8_SCHED; } \
        }
        TS_DECL(); TS_BEGIN(120 + Epi::EPI_ID);
        if constexpr (Epi::HAS_PRE) {
            _Pragma("unroll") for (int t = 0; t < 16; t += 2) PG8_TRIP(t, 8)
        } else {
            for (int t = 0; t < nt; t += 2) PG8_TRIP(t, 8)
        }
#undef PG8_TRIP
        TS_END(120 + Epi::EPI_ID, lds, wid);
        if constexpr (Epi::HAS_PRE) E.pre(acc, cur, nt, pq0, wr, wc, fr, fq);
        if (wr == 0) PG8_BAR;
        { TS_BEGIN(100 + Epi::EPI_ID); E(acc, cur, wr, wc, fr, fq, tid); TS_END(100 + Epi::EPI_ID, lds, wid); }
#if defined(REP_EPI_ID)
        if constexpr (Epi::EPI_ID == REP_EPI_ID) E(acc, cur, wr, wc, fr, fq, tid);
#endif
        if (!has_next) break;
#pragma unroll
        for (int a = 0; a < 2; ++a)
#pragma unroll
            for (int b = 0; b < 2; ++b)
#pragma unroll
                for (int m = 0; m < 4; ++m)
#pragma unroll
                    for (int n = 0; n < 2; ++n) acc[a][b][m][n] = (f32x4){0.f, 0.f, 0.f, 0.f};
        cur = nxt; cA = nA; cB = nB; cB1 = nB1; ++ui;
#pragma unroll
        for (int i = 0; i < 2; ++i) { vc0[i] = vn0[i]; vc1[i] = vn1[i]; }
        if (wr == 1) PG8_BAR;
    }
    PG8_WAIT_V(0);
    PG8_BAR;
#undef PG8_SA
#undef PG8_SB
#undef PG8_STAGE
#undef PG8_LDA
#undef PG8_LDB
#undef PG8_MMA
#undef PG8_WAIT_V
#undef PG8_WAIT_L
#undef PG8_BAR
#undef PG8_SCHED
}
}
#define GAS __attribute__((address_space(1)))
#define LAS __attribute__((address_space(3)))
typedef unsigned short bf16;
typedef unsigned v4u __attribute__((ext_vector_type(4)));
typedef unsigned v2u __attribute__((ext_vector_type(2)));
typedef float f32x4 __attribute__((ext_vector_type(4)));
typedef float f32x2 __attribute__((ext_vector_type(2)));
typedef float f32x16 __attribute__((ext_vector_type(16)));
typedef short bf16x8 __attribute__((ext_vector_type(8)));
typedef short s16x4 __attribute__((ext_vector_type(4)));
typedef GAS unsigned gu32;
#define RLX_AGENT __ATOMIC_RELAXED, __HIP_MEMORY_SCOPE_AGENT
#define LDS_WAIT() asm volatile("s_waitcnt lgkmcnt(0)" ::: "memory")
#define VM_WAIT() asm volatile("s_waitcnt vmcnt(0)" ::: "memory")

constexpr int NWAVES = 8;
constexpr int NTOK = 65536, SEQ = 8192, DM = 1024, PW = 2816, NL = 4;
constexpr int OQ = 0, OKK = 512, OV = 1024, OU = 1536, OZ = 1792, OGB = 2048, OGC = 2304, OH = 2560;
constexpr float LN_EPS = 1e-5f, ALPHA = 1.6817928305074290f, LOG2E = 1.4426950408889634f, C2 = 0.125f * 1.4426950408889634f;
constexpr int NU_MAX = 10;
constexpr int NEB = 32, NPB = 112, NCNT = NEB + NPB;

constexpr size_t MiB = 1u << 20;
constexpr size_t WS_CTL = 0, CTL_ZERO_BYTES = 1 * MiB;
constexpr size_t WS_ROPE = 1 * MiB;
constexpr size_t WS_VEC = 3 * MiB;
constexpr size_t WS_WIN = 4 * MiB;
constexpr size_t WS_WOUT = 26 * MiB;
constexpr size_t WS_WRT = 34 * MiB;
constexpr size_t WS_WSGU = 35 * MiB;
constexpr size_t WS_WGU = 36 * MiB;
constexpr size_t WS_WD = 100 * MiB;
constexpr size_t WS_CGU = 132 * MiB;
constexpr size_t WS_S = 134 * MiB;
constexpr size_t WS_ST = 262 * MiB;
constexpr size_t WS_RS0 = 270 * MiB;
constexpr size_t WS_RS1 = 271 * MiB;
constexpr size_t WS_PROJ = 272 * MiB;
constexpr size_t WS_MIXED = 624 * MiB;
constexpr size_t WS_PART = 752 * MiB;
constexpr size_t WS_ML = 944 * MiB;
constexpr size_t WS_H = 272 * MiB;
constexpr size_t WS_ELIST = 456 * MiB;
constexpr size_t WS_EDEST = 464 * MiB;
constexpr size_t WS_EGATE = 472 * MiB;
constexpr size_t WS_PLIST = 480 * MiB;
constexpr size_t WS_END = 956 * MiB;
constexpr int V_ONES = 0, V_ZEROS = 1024, V_CIN = 2048  , V_DIN = V_CIN + 4 * PW, V_CR = V_DIN + 4 * PW  , V_DR = V_CR + 256;
constexpr int CW_TMO = 0, CW_CODE = 1, CW_BAR = 4096, CW_CNT = 16384;
constexpr int RING_OFF = 0, RING_BYTES = 131072;
constexpr int TAB_OFF = 131072;
constexpr int TAB2_OFF = TAB_OFF + NU_MAX * 1024;
constexpr int GTAB_OFF = TAB2_OFF + NU_MAX * 1024;
constexpr int UT_OFF = GTAB_OFF + NU_MAX * 512;
constexpr int TB_OFF = UT_OFF + 512;
constexpr int P6TAB_OFF = TB_OFF + 2560;
constexpr int P6UT_OFF = P6TAB_OFF + 3072;
constexpr int NU6_MAX = 6;
constexpr int TB_TBE = 0, TB_CLE = 33, TB_TBP = 65, TB_CLP = 178, TB_HIST = 290, TB_BASE = 434;
constexpr int LDS_BYTES = 163840;
constexpr int MISC_OFF = LDS_BYTES - 256;
static_assert(P6UT_OFF + 256 <= MISC_OFF && MISC_OFF + 256 <= LDS_BYTES, "LDS map");

__device__ __forceinline__ unsigned pkbf(float lo, float hi) { return pg8::cvt_pk_bf16(lo, hi); }
__device__ __forceinline__ float bflo(unsigned w) { return __uint_as_float(w << 16); }
__device__ __forceinline__ float bfhi(unsigned w) { return __uint_as_float(w & 0xffff0000u); }
__device__ __forceinline__ float bf2f(unsigned short b) { return __uint_as_float((unsigned)b << 16); }
__device__ __forceinline__ float rbf(float x) { return bflo(pkbf(x, 0.f)); }
__device__ __forceinline__ float fast_exp2(float x) { return __builtin_amdgcn_exp2f(x); }
__device__ __forceinline__ float fast_rcp(float x) { return __builtin_amdgcn_rcpf(x); }
__device__ __forceinline__ float fast_rsq(float x) { return __builtin_amdgcn_rsqf(x); }
__device__ __forceinline__ float gelu_t(float x) {
    const float u = 0.7978845608028654f * (x + 0.044715f * x * x * x);
    return x * fast_rcp(1.0f + fast_exp2(-2.0f * LOG2E * u));
}
__device__ __forceinline__ float silu_f(float x) { return x * fast_rcp(1.0f + fast_exp2(-LOG2E * x)); }
template <int CTRL> __device__ __forceinline__ float dppf(float v) { return __uint_as_float((unsigned)__builtin_amdgcn_update_dpp(0, (int)__float_as_uint(v), CTRL, 0xF, 0xF, true)); }
__device__ __forceinline__ float sum_x1(float v) { return v + dppf<0xB1>(v); }
__device__ __forceinline__ float sum_x2(float v) { return v + dppf<0x4E>(v); }
__device__ __forceinline__ float sum_q4(float v) { return v + dppf<0x141>(v); }
__device__ __forceinline__ float sum_q8(float v) { return v + dppf<0x140>(v); }
__device__ __forceinline__ float sum_x16(float v) { const auto r = __builtin_amdgcn_permlane16_swap(__float_as_uint(v), __float_as_uint(v), false, false); return __uint_as_float(r[0]) + __uint_as_float(r[1]); }
__device__ __forceinline__ float sum_x32(float v) { const auto r = __builtin_amdgcn_permlane32_swap(__float_as_uint(v), __float_as_uint(v), false, false); return __uint_as_float(r[0]) + __uint_as_float(r[1]); }
__device__ __forceinline__ float max_x32(float v) { const auto r = __builtin_amdgcn_permlane32_swap(__float_as_uint(v), __float_as_uint(v), false, false); return fmaxf(__uint_as_float(r[0]), __uint_as_float(r[1])); }
__device__ __forceinline__ float other_x32(float v, int hi) { const auto r = __builtin_amdgcn_permlane32_swap(__float_as_uint(v), __float_as_uint(v), false, false); return __uint_as_float(hi ? r[0] : r[1]); }
__device__ __forceinline__ float wave_sum(float v) { return sum_x32(sum_x16(sum_q8(sum_q4(sum_x2(sum_x1(v)))))); }

#define XB_TMO      128
#define XB_XCNT(j)  (256  + 64 * (j))
#define XB_XSUB(j)  (1280 + 64 * (j))
#define XB_XGEN(j)  (2304 + 64 * (j))
#define XB_TOP      3328
#define XB_TOPGEN   3392
#define XCD_BAR_WORDS 3456
#define XB_SPIN_CAP (1u << 18)
__device__ __forceinline__ unsigned xb_ld(unsigned* p)              { return __hip_atomic_load(p, __ATOMIC_RELAXED, __HIP_MEMORY_SCOPE_AGENT); }
__device__ __forceinline__ unsigned xb_add(unsigned* p, unsigned v) { return __hip_atomic_fetch_add(p, v, __ATOMIC_RELAXED, __HIP_MEMORY_SCOPE_AGENT); }
__device__ __forceinline__ unsigned xb_xcc_id() { return (unsigned)__builtin_amdgcn_s_getreg((3 << 11) | 20) & 0xFu; }
#define XB_SPIN(cond, bar) do { unsigned _sp = 0; while (cond) { __builtin_amdgcn_s_sleep(1); \
    if ((++_sp & 255u) == 0u) { if (xb_ld(&(bar)[XB_TMO])) break; if (_sp > XB_SPIN_CAP) { atomicAdd(&(bar)[XB_TMO], 1u); break; } } } } while (0)
struct XcdBarrier { unsigned* bar; unsigned x; volatile LAS unsigned* st; };
__device__ __forceinline__ XcdBarrier xcd_barrier_post(unsigned* bar, volatile LAS unsigned* st) {
    XcdBarrier b; b.bar = bar; b.x = xb_xcc_id(); b.st = st;
    if (threadIdx.x == 0) (void)xb_add(&bar[XB_XCNT(b.x)], 1u);
    return b;
}
__device__ __forceinline__ void xcd_barrier_complete(unsigned* bar, unsigned x, unsigned& nloc, unsigned& nx) {
    const unsigned G = gridDim.x * gridDim.y * gridDim.z;
    unsigned sum, cnt, mine, sp = 0u;
    for (;;) {
        sum = 0u; cnt = 0u; mine = 0u;
#pragma unroll
        for (unsigned j = 0; j < 16; ++j) { const unsigned c = xb_ld(&bar[XB_XCNT(j)]); sum += c; cnt += (c > 0u) ? 1u : 0u; mine = (j == x) ? c : mine; }
        if (sum == G) break;
        __builtin_amdgcn_s_sleep(1);
        if ((++sp & 255u) == 0u) { if (xb_ld(&bar[XB_TMO])) break; if (sp > XB_SPIN_CAP) { atomicAdd(&bar[XB_TMO], 1u); break; } }
    }
    nloc = mine > 0u ? mine : 1u; nx = cnt > 0u ? cnt : 1u;
}
__device__ __forceinline__ void xcd_barrier(const XcdBarrier& b) {
    asm volatile("s_waitcnt vmcnt(0)" ::: "memory");
    __syncthreads();
    if (threadIdx.x == 0) {
        unsigned* bar = b.bar;
        __builtin_amdgcn_s_waitcnt(0);
        unsigned nloc = b.st[0], nx = b.st[1];
        if (nloc == 0u) { xcd_barrier_complete(bar, b.x, nloc, nx); b.st[0] = nloc; b.st[1] = nx; }
        const unsigned old = xb_add(&bar[XB_XSUB(b.x)], 1u);
        const unsigned gen = old / nloc;
        if (old + 1u == (gen + 1u) * nloc) {
            __builtin_amdgcn_fence(__ATOMIC_RELEASE, "agent");
            asm volatile("s_waitcnt vmcnt(0)" ::: "memory");
            const unsigned og = xb_add(&bar[XB_TOP], 1u);
            const unsigned tg = og / nx;
            if (og + 1u == (tg + 1u) * nx) xb_add(&bar[XB_TOPGEN], 1u);
            else XB_SPIN(xb_ld(&bar[XB_TOPGEN]) == tg, bar);
            __builtin_amdgcn_fence(__ATOMIC_ACQUIRE, "agent");
            xb_add(&bar[XB_XGEN(b.x)], 1u);
            asm volatile("s_waitcnt vmcnt(0)" ::: "memory");
        } else {
            XB_SPIN(xb_ld(&bar[XB_XGEN(b.x)]) == gen, bar);
            __builtin_amdgcn_fence(__ATOMIC_ACQUIRE, "agent");
            asm volatile("s_waitcnt vmcnt(0)" ::: "memory");
        }
    }
    __syncthreads();
}

struct MoeOrder {
    const LAS int* ut; int K, Kb; size_t bstride; int numax;
    __device__ __forceinline__ bool next(int i, pg8::Unit& u) const {
        if (i >= numax) return false;
        const LAS int* p = ut + i * 8; const int nv = __builtin_amdgcn_readfirstlane(p[5]);
        if (nv < 0) return false;
        u.pm = __builtin_amdgcn_readfirstlane(p[0]); u.pn = __builtin_amdgcn_readfirstlane(p[1]); u.e = __builtin_amdgcn_readfirstlane(p[2]);
        u.bin = __builtin_amdgcn_readfirstlane(p[3]); u.rbase = __builtin_amdgcn_readfirstlane(p[4]); u.nvalid = nv; u.e2 = __builtin_amdgcn_readfirstlane(p[6]); return true;
    }
    __device__ __forceinline__ size_t a_off(const pg8::Unit& u) const { return (size_t)u.pm * (size_t)(512) * K; }
    __device__ __forceinline__ size_t b_off(const pg8::Unit& u) const { return (size_t)u.e * bstride + (size_t)u.pn * (size_t)(512) * Kb; }
    __device__ __forceinline__ size_t b_off2(const pg8::Unit& u) const { return (size_t)u.e2 * bstride + (size_t)u.pn * (size_t)(512) * Kb; }
};

template <class T> __device__ __forceinline__ T ldg(const void* base, unsigned byteoff) { return *(const T*)((const char*)base + byteoff); }
template <class T> __device__ __forceinline__ void stg_(void* base, unsigned byteoff, T v) { *(T*)((char*)base + byteoff) = v; }
#define EPI_FENCE() asm volatile("" ::: "memory")
constexpr int XT_C = 512, XT_D = XT_C + PW, XT_LASTPM = XT_D + PW;
struct EpiProj {
    static constexpr bool PERM = true, HAS_PRE = false; static constexpr int EPI_ID = 1, NSTORE = 16;
    bf16* O; const float* cvec; const float* dvec; const float* ST; float* RS; const float* CS; LAS float* xt;
    __device__ __forceinline__ void operator()(const f32x4 (&acc)[2][2][4][2], const pg8::Unit& u, int wr, int wc, int fr, int fq, int tid) const {
        const unsigned row0 = u.pm * 256 + wr * 64 + fr;
        const unsigned col0 = u.pn * 256 + wc * 32 + 8 * fq;
        const int seg = u.pn;
        LAS unsigned char* ldsb_ = (LAS unsigned char*)xt - TAB_OFF; (void)ldsb_;
        TS_DECL(); TS_BEGIN(201);
        f32x4 csA = (f32x4){1.f, 0.f, 1.f, 0.f}, csB = csA, wsA = csA, wsB = csA;
        if (seg < 4) { const unsigned t = row0 & (SEQ - 1), i0 = 16 * (wc & 1) + 4 * fq;
            csA = ldg<f32x4>(CS, (t * 32u + i0) * 8u); csB = ldg<f32x4>(CS, (t * 32u + i0) * 8u + 16u);
            wsA = ldg<f32x4>(CS, (16u * 32u + i0) * 8u); wsB = ldg<f32x4>(CS, (16u * 32u + i0) * 8u + 16u); }
        const int lastpm = ((const LAS int*)xt)[XT_LASTPM];
        if (lastpm != (int)u.pm) {
            if (tid < 256) {
                const unsigned row = u.pm * 256 + tid;
                f32x4 p[8];
#pragma unroll
                for (int j = 0; j < 8; ++j) p[j] = ldg<f32x4>(ST, row * 128u + 16u * j);
                float s = 0.f, q = 0.f;
#pragma unroll
                for (int j = 0; j < 8; ++j) { s += p[j][0] + p[j][2]; q += p[j][1] + p[j][3]; }
                const float mu = s * (1.f / 1024.f); const float var = q * (1.f / 1024.f) - mu * mu; const float rstd = fast_rsq(var + LN_EPS);
                stg_<f32x2>(RS, row * 8u, (f32x2){mu, rstd});
                *(LAS f32x2*)(xt + 2 * tid) = (f32x2){rstd, rstd * mu};
            }
            asm volatile("s_waitcnt lgkmcnt(0)" ::: "memory"); __builtin_amdgcn_s_barrier(); asm volatile("" ::: "memory");
            if (tid == 0) ((LAS int*)xt)[XT_LASTPM] = (int)u.pm;
        }
        TS_END(201, ldsb_, tid >> 6); TS_BEGIN(202);
        f32x4 cs0 = csA, cs1 = csB;
#pragma unroll
        for (int ai = 0; ai < 2; ++ai)
#pragma unroll
            for (int m = 0; m < 4; ++m) {
                const unsigned row = row0 + ai * 128 + m * 16;
                const f32x2 t2 = *(const LAS f32x2*)(xt + 2 * (wr * 64 + fr + ai * 128 + m * 16));
                const float rstd = t2.x, rsmu = t2.y;
#pragma unroll
                for (int bj = 0; bj < 2; ++bj) {
                    const int lc = col0 + bj * 128;
                    const f32x4 cv0 = *(const LAS f32x4*)(xt + XT_C + lc), cv1 = *(const LAS f32x4*)(xt + XT_C + lc + 4);
                    const f32x4 dv0 = *(const LAS f32x4*)(xt + XT_D + lc), dv1 = *(const LAS f32x4*)(xt + XT_D + lc + 4);
                    f32x4 v0 = acc[ai][bj][m][0] * rstd - cv0 * rsmu + dv0, v1 = acc[ai][bj][m][1] * rstd - cv1 * rsmu + dv1;
                    if (seg < 4) {
                        const float sc = (seg < 2) ? C2 : 1.0f;
                        f32x4 w0, w1;
                        w0[0] = (v0[0] * cs0[0] - v0[1] * cs0[1]) * sc; w0[1] = (v0[1] * cs0[0] + v0[0] * cs0[1]) * sc;
                        w0[2] = (v0[2] * cs0[2] - v0[3] * cs0[3]) * sc; w0[3] = (v0[3] * cs0[2] + v0[2] * cs0[3]) * sc;
                        w1[0] = (v1[0] * cs1[0] - v1[1] * cs1[1]) * sc; w1[1] = (v1[1] * cs1[0] + v1[0] * cs1[1]) * sc;
                        w1[2] = (v1[2] * cs1[2] - v1[3] * cs1[3]) * sc; w1[3] = (v1[3] * cs1[2] + v1[2] * cs1[3]) * sc;
                        v0 = w0; v1 = w1;
                    } else if (seg == 6 || seg == 7) {
#pragma unroll
                        for (int e = 0; e < 4; ++e) { v0[e] = gelu_t(v0[e]); v1[e] = gelu_t(v1[e]); }
                    }
                    if (seg >= 9) {
                        v2u w2; w2.x = pkbf(v0[0] * v0[1], v0[2] * v0[3]); w2.y = pkbf(v1[0] * v1[1], v1[2] * v1[3]);
                        stg_<v2u>(O, (row * (unsigned)PW + OGC + (seg - 9) * 128 + ((wc * 32 + 8 * fq + bj * 128) >> 1)) * 2u, w2);
                    } else {
                    v4u w; w.x = pkbf(v0[0], v0[1]); w.y = pkbf(v0[2], v0[3]); w.z = pkbf(v1[0], v1[1]); w.w = pkbf(v1[2], v1[3]);
                    stg_<v4u>(O, (row * (unsigned)PW + col0 + bj * 128) * 2u, w);
                    }
                }
                if (seg < 4) {
                    const int nstep = (ai == 0 && m == 3) ? 5 : 1;
#pragma unroll
                    for (int st = 0; st < nstep; ++st) {
                        f32x4 n0, n1;
                        n0[0] = cs0[0] * wsA[0] - cs0[1] * wsA[1]; n0[1] = cs0[1] * wsA[0] + cs0[0] * wsA[1]; n0[2] = cs0[2] * wsA[2] - cs0[3] * wsA[3]; n0[3] = cs0[3] * wsA[2] + cs0[2] * wsA[3];
                        n1[0] = cs1[0] * wsB[0] - cs1[1] * wsB[1]; n1[1] = cs1[1] * wsB[0] + cs1[0] * wsB[1]; n1[2] = cs1[2] * wsB[2] - cs1[3] * wsB[3]; n1[3] = cs1[3] * wsB[2] + cs1[2] * wsB[3];
                        cs0 = n0; cs1 = n1;
                    }
                }
                if (m == 3) EPI_FENCE();
            }
        TS_END(202, ldsb_, tid >> 6);
    }
};
struct EpiRes1 {
    static constexpr bool PERM = true, HAS_PRE = false; static constexpr int EPI_ID = 2, NSTORE = 16;
    bf16* S; const float* RS; const float* G; const float* Bv; bf16* Sout;
    __device__ __forceinline__ void operator()(const f32x4 (&acc)[2][2][4][2], const pg8::Unit& u, int wr, int wc, int fr, int fq, int tid) const {
        const unsigned row0 = u.pm * 256 + wr * 64 + fr;
        const unsigned col0 = u.pn * 256 + wc * 32 + 8 * fq;
        f32x2 st[2][4];
#pragma unroll
        for (int ai = 0; ai < 2; ++ai)
#pragma unroll
            for (int m = 0; m < 4; ++m) st[ai][m] = ldg<f32x2>(RS, (row0 + ai * 128 + m * 16) * 8u);
        f32x4 gv[2][2], bv[2][2];
#pragma unroll
        for (int bj = 0; bj < 2; ++bj) { gv[bj][0] = ldg<f32x4>(G, (col0 + bj * 128) * 4u); gv[bj][1] = ldg<f32x4>(G, (col0 + bj * 128) * 4u + 16u); bv[bj][0] = ldg<f32x4>(Bv, (col0 + bj * 128) * 4u); bv[bj][1] = ldg<f32x4>(Bv, (col0 + bj * 128) * 4u + 16u); }
        v4u o[2][4];
#pragma unroll
        for (int m = 0; m < 4; ++m) o[0][m] = ldg<v4u>(S, ((row0 + m * 16) * (unsigned)DM + col0) * 2u);
#pragma unroll
        for (int g = 0; g < 4; ++g) {
            const int bj = g >> 1, ai = g & 1;
            if (g < 3) { const int bjn = (g + 1) >> 1, ain = (g + 1) & 1;
#pragma unroll
                for (int m = 0; m < 4; ++m) o[(g + 1) & 1][m] = ldg<v4u>(S, ((row0 + ain * 128 + m * 16) * (unsigned)DM + col0 + bjn * 128) * 2u); }
            __builtin_amdgcn_sched_barrier(0);
#pragma unroll
            for (int m = 0; m < 4; ++m) {
                const unsigned off = ((row0 + ai * 128 + m * 16) * (unsigned)DM + col0 + bj * 128) * 2u;
                const v4u oo = o[g & 1][m];
                f32x4 x0 = (f32x4){bflo(oo.x), bfhi(oo.x), bflo(oo.y), bfhi(oo.y)}, x1 = (f32x4){bflo(oo.z), bfhi(oo.z), bflo(oo.w), bfhi(oo.w)};
                x0 = ((x0 - st[ai][m].x) * st[ai][m].y * gv[bj][0] + bv[bj][0]) * ALPHA + acc[ai][bj][m][0];
                x1 = ((x1 - st[ai][m].x) * st[ai][m].y * gv[bj][1] + bv[bj][1]) * ALPHA + acc[ai][bj][m][1];
                v4u w; w.x = pkbf(x0[0], x0[1]); w.y = pkbf(x0[2], x0[3]); w.z = pkbf(x1[0], x1[1]); w.w = pkbf(x1[2], x1[3]);
                stg_<v4u>(Sout, off, w);
            }
            __builtin_amdgcn_sched_barrier(0);
        }
    }
};
struct EpiSwiglu {
    static constexpr bool PERM = true, HAS_PRE = false; static constexpr int EPI_ID = 3, NSTORE = 0;
    bf16* H; const LAS int* dtab; const LAS float* gtab; const LAS int* tbP;
    __device__ __forceinline__ void operator()(const f32x4 (&acc)[2][2][4][2], const pg8::Unit& u, int wr, int wc, int fr, int fq, int tid) const {
        const unsigned lr0 = wr * 64 + fr;
        const unsigned col0 = u.pn * 256 + wc * 32 + 8 * fq;
#pragma unroll
        for (int ai = 0; ai < 2; ++ai)
#pragma unroll
            for (int m = 0; m < 4; ++m) {
                const unsigned lr = lr0 + ai * 128 + m * 16;
                const unsigned d = (unsigned)dtab[u.e2 * 256 + lr]; const float gate = gtab[u.e2 * 256 + lr];
                const bool valid = d != 0xffffffffu;
                const unsigned pb = valid ? (d >> 18) : 0u, pslot = (d >> 1) & 0x1ffffu, half = d & 1u;
                const unsigned prow = (unsigned)tbP[pb] * 256u + pslot;
#pragma unroll
                for (int bj = 0; bj < 2; ++bj) {
                    const f32x4 v0 = acc[ai][bj][m][0], v1 = acc[ai][bj][m][1];
                    v2u w; w.x = pkbf(gate * silu_f(v0[0]) * v0[1], gate * silu_f(v0[2]) * v0[3]); w.y = pkbf(gate * silu_f(v1[0]) * v1[1], gate * silu_f(v1[2]) * v1[3]);
                    if (valid) stg_<v2u>(H, (prow * 1024u + half * 512u + ((col0 + bj * 128) >> 1)) * 2u, w);
                }
            }
    }
};
struct EpiDown {
    static constexpr bool PERM = true, HAS_PRE = false; static constexpr int EPI_ID = 4, NSTORE = 0;
    bf16* S; const bf16* XN; const LAS unsigned short* ttab; float* ST;
    __device__ __forceinline__ void pre(f32x4 (&)[2][2][4][2], const pg8::Unit&, int, pg8::u32x4&, int, int, int, int) const {}
    __device__ __forceinline__ void operator()(const f32x4 (&acc)[2][2][4][2], const pg8::Unit& u, int wr, int wc, int fr, int fq, int tid) const {
        const unsigned lr0 = wr * 64 + fr;
        const unsigned col0 = u.pn * 256 + wc * 32 + 8 * fq;
        TS_DECL(); TS_BEGIN(211);
        unsigned tk[2][4]; v4u o[2][4][2];
#pragma unroll
        for (int ai = 0; ai < 2; ++ai)
#pragma unroll
            for (int m = 0; m < 4; ++m) { const unsigned lr = lr0 + ai * 128 + m * 16; const unsigned t16 = ttab[u.rbase * 256 + lr]; tk[ai][m] = ((int)lr < u.nvalid) ? t16 : 0xffffffffu; }
#pragma unroll
        for (int ai = 0; ai < 2; ++ai)
#pragma unroll
            for (int m = 0; m < 4; ++m) { const unsigned tok = (tk[ai][m] != 0xffffffffu) ? tk[ai][m] : 0u;
#pragma unroll
                for (int bj = 0; bj < 2; ++bj) o[ai][m][bj] = ldg<v4u>(XN, (tok * (unsigned)DM + col0 + bj * 128) * 2u); }
        TS_END(211, (LAS unsigned char*)ttab - TAB_OFF, tid >> 6); TS_BEGIN(212);
#pragma unroll
        for (int ai = 0; ai < 2; ++ai) {
#pragma unroll
            for (int m = 0; m < 4; ++m) {
                const bool valid = tk[ai][m] != 0xffffffffu;
                const unsigned tok = valid ? tk[ai][m] : 0u;
                float ssum = 0.f, ssq = 0.f;
#pragma unroll
                for (int bj = 0; bj < 2; ++bj) {
                    const v4u oo = o[ai][m][bj];
                    f32x4 x0 = (f32x4){bflo(oo.x), bfhi(oo.x), bflo(oo.y), bfhi(oo.y)}, x1 = (f32x4){bflo(oo.z), bfhi(oo.z), bflo(oo.w), bfhi(oo.w)};
                    x0 = x0 * ALPHA + acc[ai][bj][m][0]; x1 = x1 * ALPHA + acc[ai][bj][m][1];
                    v4u w; w.x = pkbf(x0[0], x0[1]); w.y = pkbf(x0[2], x0[3]); w.z = pkbf(x1[0], x1[1]); w.w = pkbf(x1[2], x1[3]);
                    if (valid) stg_<v4u>(S, (tok * (unsigned)DM + col0 + bj * 128) * 2u, w);
                    const f32x4 r0 = (f32x4){bflo(w.x), bfhi(w.x), bflo(w.y), bfhi(w.y)}, r1 = (f32x4){bflo(w.z), bfhi(w.z), bflo(w.w), bfhi(w.w)};
                    ssum += (r0[0] + r0[1]) + (r0[2] + r0[3]) + (r1[0] + r1[1]) + (r1[2] + r1[3]);
                    ssq += (r0[0] * r0[0] + r0[1] * r0[1]) + (r0[2] * r0[2] + r0[3] * r0[3]) + (r1[0] * r1[0] + r1[1] * r1[1]) + (r1[2] * r1[2] + r1[3] * r1[3]);
                }
                ssum = sum_x32(sum_x16(ssum)); ssq = sum_x32(sum_x16(ssq));
                if (valid && fq == 0) stg_<f32x2>(ST, ((tok * 16u + u.pn * 4 + wc) * 2u) * 4u, (f32x2){ssum, ssq});
            }
        }
        TS_END(212, (LAS unsigned char*)ttab - TAB_OFF, tid >> 6);
    }
};

struct ColId { __device__ __forceinline__ int operator()(int n) const { return n; } };
struct ColConv { __device__ __forceinline__ int operator()(int n) const { const int q = n - OGC; return ((q & 1) ? OH : OGC) + (q >> 1); } };
struct ColRope { __device__ __forceinline__ int operator()(int n) const { const int p = n & 63; return (n & ~63) + (p >> 1) + ((p & 1) << 5); } };
template <class CM>
__device__ __forceinline__ void conv_item(const float* W, int K, int ldw, CM cm, int n0, bf16* WT, int rstride, const float* scale, const float* biask, float* csum, float* dsum, LAS float* scr, int lane_, int kst = 0) {
    if (kst == 0) kst = K;
    int lane = lane_; asm volatile("" : "+v"(lane));
    const int col = cm(n0 + (lane & 31));
    float cs = 0.f, ds = 0.f;
    const float* wp = W + (size_t)(lane >> 5) * ldw + col;
    float w[32], wn[32];
#pragma unroll
    for (int i = 0; i < 32; ++i) w[i] = wp[(size_t)(2 * i) * ldw];
    for (int k0 = 0; k0 < K; k0 += 64) {
        if (k0 + 64 < K) {
#pragma unroll
            for (int i = 0; i < 32; ++i) wn[i] = wp[(size_t)(k0 + 64 + 2 * i) * ldw];
        }
#pragma unroll
        for (int i = 0; i < 32; ++i) { const int kk = k0 + 2 * i + (lane >> 5); const float sc = scale ? scale[kk] : 1.0f; const float bk = biask ? biask[kk] : 0.0f;
            const float v = rbf(w[i] * sc); cs += v; ds += bk * w[i]; scr[(2 * i + (lane >> 5)) * 33 + (lane & 31)] = v; }
        LDS_WAIT(); asm volatile("" ::: "memory");
        const int c = lane & 7;
#pragma unroll
        for (int j = 0; j < 4; ++j) { const int n = (lane >> 3) + 8 * j; const LAS float* s = scr + (8 * c) * 33 + n;
            v4u o; o.x = pkbf(s[0 * 33], s[1 * 33]); o.y = pkbf(s[2 * 33], s[3 * 33]); o.z = pkbf(s[4 * 33], s[5 * 33]); o.w = pkbf(s[6 * 33], s[7 * 33]);
            *(GAS v4u*)(WT + (size_t)(n * rstride) * kst + k0 + 8 * c) = o; }
        LDS_WAIT(); asm volatile("" ::: "memory");
#pragma unroll
        for (int i = 0; i < 32; ++i) w[i] = wn[i];
    }
    cs = sum_x32(cs); ds = sum_x32(ds);
    if (lane < 32) { if (csum) csum[lane * rstride] = cs; if (dsum) dsum[lane * rstride] = ds; }
}

constexpr int AT_KA = 0, AT_KB = 49152, AT_V = 98304, AT_WS = 147456, AT_END = AT_WS + 8 * 256;
__device__ __forceinline__ void glds16(const void* gsrc, unsigned lds_dst) { unsigned keep;
    asm volatile("s_mov_b32 %0, m0\n\ts_mov_b32 m0, %2\n\ts_nop 0\n\tglobal_load_lds_dwordx4 %1, off\n\ts_mov_b32 m0, %0" : "=&s"(keep) : "v"(gsrc), "s"(lds_dst) : "memory"); }
__device__ __forceinline__ int crow(int r, int hi) { return (r & 3) + 8 * (r >> 2) + 4 * hi; }
typedef short v4i16_t __attribute__((ext_vector_type(4)));
__device__ __forceinline__ s16x4 vtr(const LAS char* p) { return __builtin_bit_cast(s16x4, __builtin_amdgcn_ds_read_tr16_b64_v4i16((LAS v4i16_t*)p)); }
struct AUnit { int b, h, br, r, m0, d; };
__device__ __forceinline__ AUnit attn_decode(int U) { AUnit a; const int bh = U / 96, rem = U % 96; a.b = bh >> 3; a.h = bh & 7; a.br = rem >> 5; const int uidx = rem & 31; const int dsh = 2 * a.br; a.d = 1 << dsh; a.r = uidx & (a.d - 1); a.m0 = (uidx >> dsh) * 256; return a; }
__device__ __forceinline__ void glds16s(const void* sbase, unsigned voff, unsigned lds_dst) { unsigned keep;
    asm volatile("s_mov_b32 %0, m0\n\ts_mov_b32 m0, %3\n\ts_nop 0\n\tglobal_load_lds_dwordx4 %1, %2\n\ts_mov_b32 m0, %0" : "=&s"(keep) : "v"(voff), "s"(sbase), "s"(lds_dst) : "memory"); }
__device__ __forceinline__ void attn_issue_k(const bf16* proj, const AUnit& a, unsigned ldsK, int wid, int lane) {
    const int kk = lane >> 3, pc = lane & 7;
    const unsigned ubase = (((unsigned)a.b * SEQ + a.r) * PW + OKK + 64 * a.h) * 2u, rstep = (unsigned)a.d * PW * 2u;
#pragma unroll
    for (int i = 0; i < 6; ++i) {
        const int x = wid * 6 + i, T = x >> 2, q = x & 3;
        const int k = 8 * q + kk;
        int sidx = a.m0 - 128 + 32 * T + k; sidx = sidx < 0 ? 0 : sidx;
        const unsigned c = (unsigned)(pc ^ ((k >> 1) & 7));
        glds16s(proj, ubase + (unsigned)sidx * rstep + c * 16u, (unsigned)__builtin_amdgcn_readfirstlane(ldsK + T * 4096 + q * 1024));
    }
}
__device__ __forceinline__ void attn_issue_v(const bf16* proj, const AUnit& a, unsigned ldsV, int wid, int lane) {
    const unsigned ubase = (((unsigned)a.b * SEQ + a.r) * PW + OV + 64 * a.h + (lane & 3) * 8) * 2u, rstep = (unsigned)a.d * PW * 2u;
#pragma unroll
    for (int i = 0; i < 6; ++i) {
        const int x = wid * 6 + i, dh = x / 24, kg = x % 24;
        int sidx = a.m0 - 128 + 16 * kg + (lane >> 2); sidx = sidx < 0 ? 0 : sidx;
        glds16s(proj, ubase + (unsigned)sidx * rstep + dh * 64u, (unsigned)__builtin_amdgcn_readfirstlane(ldsV + dh * 24576 + kg * 1024));
    }
}
__device__ __forceinline__ void attn_load_q(const bf16* proj, const AUnit& a, bf16x8 (&qr)[4], int wid, int r32, int hi) {
    const unsigned off = ((((unsigned)a.b * SEQ + (unsigned)(a.m0 + 32 * wid + r32) * a.d + a.r) * PW) + OQ + 64 * a.h + 8 * hi) * 2u;
    asm volatile("global_load_dwordx4 %0, %4, %5\n\tglobal_load_dwordx4 %1, %4, %5 offset:32\n\tglobal_load_dwordx4 %2, %4, %5 offset:64\n\tglobal_load_dwordx4 %3, %4, %5 offset:96"
                 : "=&v"(qr[0]), "=&v"(qr[1]), "=&v"(qr[2]), "=&v"(qr[3]) : "v"(off), "s"(proj) : "memory");
}

__device__ __forceinline__ void attn_phase(const bf16* proj, bf16* part, float* ML, int vcu, int G, LAS unsigned char* lds, int wave_s) {
    int lane = pg8::lane_id_v(); const int wid = wave_s; int r32 = lane & 31, hi = lane >> 5;
    const unsigned lds0 = (unsigned)(uintptr_t)lds;
    constexpr int NUNITS = 8 * 8 * 96;
    int U = vcu;
    if (U >= NUNITS) return;
    AUnit cur = attn_decode(U);
    bf16x8 qr[4];
    attn_issue_k(proj, cur, lds0 + AT_KA, wid, lane);
    attn_load_q(proj, cur, qr, wid, r32, hi);
    attn_issue_v(proj, cur, lds0 + AT_V, wid, lane);
    f32x16 bias0, bias4;
#pragma unroll
    for (int rg = 0; rg < 16; ++rg) { const int c = crow(rg, hi); bias0[rg] = (c < r32) ? -1e30f : 0.f; bias4[rg] = (c > r32) ? -1e30f : 0.f; }
    int kb = 0; bool first = true;
    for (;;) {
        const int Un = U + G; const bool has_next = Un < NUNITS;
        AUnit nxt = cur; if (has_next) nxt = attn_decode(Un);
        const int koff = kb ? AT_KB : AT_KA, koff_n = kb ? AT_KA : AT_KB;
        asm volatile("" : "+v"(lane)); r32 = lane & 31; hi = lane >> 5;
        TS_DECL();
        TS_BEGIN(1);
        if (first) asm volatile("s_waitcnt vmcnt(6)\n\ts_barrier" ::: "memory"); else asm volatile("s_waitcnt vmcnt(11)\n\ts_barrier" ::: "memory");
        TS_END(1, lds, wid);
        asm volatile("" : "+v"(qr[0]), "+v"(qr[1]), "+v"(qr[2]), "+v"(qr[3]));
        TS_BEGIN(2); if (has_next) attn_issue_k(proj, nxt, lds0 + koff_n, wid, lane); TS_END(2, lds, wid);
        f32x16 p[5];
        TS_BEGIN(3);
#if defined(REP_MASK) && ((REP_MASK >> 12) & 1)
        for (int rr_ = 0; rr_ < 2; ++rr_)
#endif
        {
            const LAS unsigned char* kb0 = lds + koff + wid * 4096 + r32 * 128;
            const int sw = (r32 >> 1) & 7;
            int ko[4];
#pragma unroll
            for (int d0 = 0; d0 < 4; ++d0) ko[d0] = ((2 * d0 + hi) ^ sw) * 16;
            bf16x8 kf[2][4];
#pragma unroll
            for (int d0 = 0; d0 < 4; ++d0) kf[0][d0] = *(const LAS bf16x8*)(kb0 + ko[d0]);
#pragma unroll
            for (int j = 0; j < 5; ++j) {
                if (j < 4) {
#pragma unroll
                    for (int d0 = 0; d0 < 4; ++d0) kf[(j + 1) & 1][d0] = *(const LAS bf16x8*)(kb0 + (j + 1) * 4096 + ko[d0]);
                }
                f32x16 a = (j == 0) ? bias0 : ((j == 4) ? bias4 : f32x16{});
#pragma unroll
                for (int d0 = 0; d0 < 4; ++d0) a = __builtin_amdgcn_mfma_f32_32x32x16_bf16(kf[j & 1][d0], qr[d0], a, 0, 0, 0);
                p[j] = a;
                __builtin_amdgcn_sched_barrier(0);
            }
        }
        asm volatile("" : "+v"(p[4]));
        TS_END(3, lds, wid);
        asm volatile("" ::: "memory");
        if (has_next) attn_load_q(proj, nxt, qr, wid, r32, hi);
        TS_BEGIN(4);
        if (cur.m0 == 0) {
            asm volatile("; first-block mask" ::: "memory");
            const int kfirst = 128 - 32 * wid;
#pragma unroll
            for (int j = 0; j < 5; ++j)
#pragma unroll
                for (int rg = 0; rg < 16; ++rg) if (32 * j + crow(rg, hi) < kfirst) p[j][rg] = -1e30f;
        }
        float mx = p[0][0];
#pragma unroll
        for (int j = 0; j < 5; ++j)
#pragma unroll
            for (int rg = 0; rg < 16; ++rg) mx = fmaxf(mx, p[j][rg]);
        mx = max_x32(mx);
        f32x2 l2 = (f32x2){0.f, 0.f};
#pragma unroll
        for (int j = 0; j < 5; ++j)
#pragma unroll
            for (int rg = 0; rg < 16; rg += 2) { const f32x2 dd = (f32x2){p[j][rg], p[j][rg + 1]} - mx; const f32x2 ee = (f32x2){fast_exp2(dd.x), fast_exp2(dd.y)}; p[j][rg] = ee.x; p[j][rg + 1] = ee.y; l2 += ee; }
        float l = l2.x + l2.y;
        l = sum_x32(l);
        asm volatile("" : "+v"(l)); TS_END(4, lds, wid); TS_BEGIN(5);
        if (has_next) asm volatile("s_waitcnt vmcnt(10) lgkmcnt(0)\n\ts_barrier" ::: "memory"); else asm volatile("s_waitcnt vmcnt(0) lgkmcnt(0)\n\ts_barrier" ::: "memory");
        first = false;
        TS_END(5, lds, wid); TS_BEGIN(6);
        f32x16 o[2];
        const LAS char* vp0 = (const LAS char*)lds + AT_V + ((lane >> 4) & 1) * 32 + (lane & 3) * 8 + (4 * hi + ((lane & 15) >> 2)) * 64;
#if defined(REP_MASK) && ((REP_MASK >> 13) & 1)
        for (int rr_ = 0; rr_ < 2; ++rr_)
#endif
        {
            o[0] = f32x16{}; o[1] = f32x16{};
            s16x4 vl[2][2], vh[2][2];
            const LAS char* vpw = vp0 + (32 * wid) * 64;
#pragma unroll
            for (int dh = 0; dh < 2; ++dh) { vl[0][dh] = vtr(vpw + dh * 24576); vh[0][dh] = vtr(vpw + dh * 24576 + 512); }
#pragma unroll
            for (int st = 0; st < 10; ++st) {
                const int j = st >> 1, s = st & 1;
                if (st < 9) {
#pragma unroll
                    for (int dh = 0; dh < 2; ++dh) { vl[(st + 1) & 1][dh] = vtr(vpw + dh * 24576 + (st + 1) * 1024); vh[(st + 1) & 1][dh] = vtr(vpw + dh * 24576 + (st + 1) * 1024 + 512); }
                }
                v4u pw; pw.x = pkbf(p[j][8 * s + 0], p[j][8 * s + 1]); pw.y = pkbf(p[j][8 * s + 2], p[j][8 * s + 3]); pw.z = pkbf(p[j][8 * s + 4], p[j][8 * s + 5]); pw.w = pkbf(p[j][8 * s + 6], p[j][8 * s + 7]);
                const bf16x8 pa = __builtin_bit_cast(bf16x8, pw);
#pragma unroll
                for (int dh = 0; dh < 2; ++dh) {
                    const s16x4 lo = vl[st & 1][dh], hv = vh[st & 1][dh];
                    const bf16x8 vf = (bf16x8){lo[0], lo[1], lo[2], lo[3], hv[0], hv[1], hv[2], hv[3]};
                    o[dh] = __builtin_amdgcn_mfma_f32_32x32x16_bf16(vf, pa, o[dh], 0, 0, 0);
                }
                __builtin_amdgcn_sched_barrier(0);
            }
        }
        asm volatile("" : "+v"(o[0]), "+v"(o[1])); TS_END(6, lds, wid); TS_BEGIN(7);
        asm volatile("s_waitcnt lgkmcnt(0)\n\ts_barrier" ::: "memory");
        TS_END(7, lds, wid); TS_BEGIN(8);
        const size_t rowbase = (size_t)cur.b * SEQ;
        const size_t qtok = rowbase + (size_t)(cur.m0 + 32 * wid + r32) * cur.d + cur.r;
        if (hi == 0) *(GAS f32x2*)((GAS char*)ML + ((((size_t)cur.br * NTOK + qtok) * 8 + cur.h) * 2) * 4) = (f32x2){mx, l};
        const float rl = fast_rcp(l);
        LAS unsigned char* stg = lds + koff + wid * 4608;
#if defined(REP_MASK) && ((REP_MASK >> 14) & 1)
        for (int rr_ = 0; rr_ < 2; ++rr_) {
#else
        {
#endif
#pragma unroll
        for (int dh = 0; dh < 2; ++dh)
#pragma unroll
            for (int g4 = 0; g4 < 4; ++g4) { v2u w; w.x = pkbf(o[dh][4 * g4 + 0] * rl, o[dh][4 * g4 + 1] * rl); w.y = pkbf(o[dh][4 * g4 + 2] * rl, o[dh][4 * g4 + 3] * rl);
                *(LAS v2u*)(stg + r32 * 144 + (32 * dh + 8 * g4 + 4 * hi) * 2) = w; }
        LDS_WAIT();
#pragma unroll
        for (int i = 0; i < 4; ++i) { const int row = i * 8 + (lane >> 3), ch = lane & 7; const v4u v = *(const LAS v4u*)(stg + row * 144 + ch * 16);
            const size_t ot = rowbase + (size_t)(cur.m0 + 32 * wid + row) * cur.d + cur.r;
            *(GAS v4u*)((GAS char*)part + (((size_t)cur.br * NTOK + ot) * 512 + 64 * cur.h + ch * 8) * 2) = v; }
        }
        if (has_next) attn_issue_v(proj, nxt, lds0 + AT_V, wid, lane);
        TS_END(8, lds, wid); TS_BEGIN(9);
        asm volatile("s_waitcnt lgkmcnt(0)\n\ts_barrier" ::: "memory");
        TS_END(9, lds, wid);
        if (!has_next) break;
        cur = nxt; U = Un; kb ^= 1;
    }
}

constexpr int SG_ZT = 0, SG_ZT_STRIDE = 136  , SG_YT = 4 * 64 * SG_ZT_STRIDE * 2  , SG_END = SG_YT + 128 * 256 * 2;
static_assert(SG_END <= MISC_OFF, "sgu LDS");
static_assert(AT_END <= MISC_OFF, "attention LDS");
__device__ __forceinline__ void sgu_unit(const bf16* proj, bf16* mixed, const bf16* WS, const float* sgain, const float* sbias, int chunk, LAS unsigned char* lds, int wave_s) {
    const int lane = pg8::lane_id_v(), wid = wave_s, tid = wid * 64 + lane, r32 = lane & 31, hi = lane >> 5;
    const size_t tok0 = (size_t)chunk * 128;
    LAS bf16* znT = (LAS bf16*)(lds + SG_ZT);
    LAS bf16* yt = (LAS bf16*)(lds + SG_YT);
    TS_DECL(); TS_BEGIN(311);
    const int pce = tid & 31, g1 = pce >> 3, c1 = (pce & 7) * 8;
    f32x4 ga0 = *(const f32x4*)(sgain + g1 * 64 + c1), ga1 = *(const f32x4*)(sgain + g1 * 64 + c1 + 4);
    {
        v4u uvb[8], zvb[8];
#pragma unroll
        for (int it = 0; it < 8; ++it) { const bf16* rowp = proj + (tok0 + it * 16 + (tid >> 5)) * PW; uvb[it] = *(const v4u*)(rowp + OU + 8 * pce); zvb[it] = *(const v4u*)(rowp + OZ + 8 * pce); }
#pragma unroll
        for (int it = 0; it < 8; ++it) {
            const int t = it * 16 + (tid >> 5);
            *(LAS v4u*)(yt + t * 256 + 8 * pce) = uvb[it];
            const v4u zv = zvb[it];
            float z[8] = {bflo(zv.x), bfhi(zv.x), bflo(zv.y), bfhi(zv.y), bflo(zv.z), bfhi(zv.z), bflo(zv.w), bfhi(zv.w)};
            float s = 0.f;
#pragma unroll
            for (int e = 0; e < 8; ++e) s += z[e];
            s = sum_q4(sum_x2(sum_x1(s)));
            const float mean = s * (1.f / 64.f);
            float q = 0.f;
#pragma unroll
            for (int e = 0; e < 8; ++e) { z[e] -= mean; q += z[e] * z[e]; }
            q = sum_q4(sum_x2(sum_x1(q)));
            const float rstd = fast_rsq(q * (1.f / 64.f) + LN_EPS);
            v4u zw; zw.x = pkbf(z[0] * rstd * ga0[0], z[1] * rstd * ga0[1]); zw.y = pkbf(z[2] * rstd * ga0[2], z[3] * rstd * ga0[3]); zw.z = pkbf(z[4] * rstd * ga1[0], z[5] * rstd * ga1[1]); zw.w = pkbf(z[6] * rstd * ga1[2], z[7] * rstd * ga1[3]);
            *(LAS v4u*)((LAS unsigned char*)znT + ((g1 * 2 + (c1 >> 5)) * 128 + t) * 64 + (c1 & 31) * 2) = zw;
        }
    }
    __syncthreads();
    TS_END(311, lds, wid); TS_BEGIN(312);
    {
        const int g = wid >> 1, ct = wid & 1;
        const bf16* wg_ = WS + (size_t)g * 128 * 128;
        const LAS char* zb = (const LAS char*)znT + ((g * 2 + ct) * 128 + 4 * hi + ((lane & 15) >> 2)) * 64 + ((lane >> 4) & 1) * 32 + (lane & 3) * 8;
#pragma unroll
        for (int tt = 0; tt < 4; ++tt) {
            f32x16 a = {};
            bf16x8 af[8];
#pragma unroll
            for (int ks = 0; ks < 2 * (tt + 1); ++ks) af[ks] = *(const bf16x8*)(wg_ + (size_t)(32 * tt + r32) * 128 + 16 * ks + 8 * hi);
            f32x4 bb[4];
#pragma unroll
            for (int q4 = 0; q4 < 4; ++q4) bb[q4] = *(const f32x4*)(sbias + g * 128 + 32 * tt + 8 * q4 + 4 * hi);
#pragma unroll
            for (int ks = 0; ks < 2 * (tt + 1); ++ks) {
                const s16x4 lo = vtr(zb + ks * 1024), hv = vtr(zb + ks * 1024 + 512);
                const bf16x8 bfr = (bf16x8){lo[0], lo[1], lo[2], lo[3], hv[0], hv[1], hv[2], hv[3]};
                a = __builtin_amdgcn_mfma_f32_32x32x16_bf16(af[ks], bfr, a, 0, 0, 0);
            }
#pragma unroll
            for (int rg = 0; rg < 16; ++rg) { const int t = 32 * tt + crow(rg, hi); LAS bf16* yp = yt + t * 256 + 64 * g + 32 * ct + r32;
                const float uval = bf2f(*yp); const float y = uval * (a[rg] + bb[rg >> 2][rg & 3]); *yp = (bf16)(pkbf(y, 0.f) & 0xffffu); }
        }
    }
    __syncthreads();
    TS_END(312, lds, wid); TS_BEGIN(313);
#pragma unroll 1
    for (int i = 0; i < 16; i += 4) {
        float y[4][4], ss[4];
#pragma unroll
        for (int b = 0; b < 4; ++b) { const int t = wid * 16 + i + b; const v2u yv = *(const LAS v2u*)(yt + t * 256 + 4 * lane);
            y[b][0] = bflo(yv.x); y[b][1] = bfhi(yv.x); y[b][2] = bflo(yv.y); y[b][3] = bfhi(yv.y);
            ss[b] = (y[b][0] * y[b][0] + y[b][1] * y[b][1]) + (y[b][2] * y[b][2] + y[b][3] * y[b][3]); }
#pragma unroll
        for (int b = 0; b < 4; ++b) ss[b] = wave_sum(ss[b]);
#pragma unroll
        for (int b = 0; b < 4; ++b) { const int t = wid * 16 + i + b; const float rs = fast_rsq(ss[b] * (1.f / 256.f) + LN_EPS);
            v2u w; w.x = pkbf(y[b][0] * rs, y[b][1] * rs); w.y = pkbf(y[b][2] * rs, y[b][3] * rs);
            *(v2u*)(mixed + (tok0 + t) * DM + 512 + 4 * lane) = w; }
    }
    __syncthreads();
    TS_END(313, lds, wid);
}
struct Args { const float* in[17]; float* out; unsigned char* ws; int ph_lo, ph_hi, nlayers, pad; };

template <int NB>
__device__ __forceinline__ void combine_tokens(const bf16* part, const float* ML, bf16* mixed, size_t tok0, size_t tstride, int lane) {
    const int head = lane >> 3;
    f32x2 ml[NB][3]; v4u pv[NB][3];
#pragma unroll
    for (int b = 0; b < NB; ++b) { const size_t tok = tok0 + b * tstride;
#pragma unroll
        for (int br = 0; br < 3; ++br) { ml[b][br] = *(const f32x2*)(ML + (((size_t)br * NTOK + tok) * 8 + head) * 2); pv[b][br] = *(const v4u*)(part + ((size_t)br * NTOK + tok) * 512 + 8 * lane); } }
    float o[NB][8], ss[NB];
#pragma unroll
    for (int b = 0; b < NB; ++b) {
        const float M = fmaxf(ml[b][0].x, fmaxf(ml[b][1].x, ml[b][2].x));
        float w[3], W = 0.f;
#pragma unroll
        for (int br = 0; br < 3; ++br) { w[br] = ml[b][br].y * fast_exp2(ml[b][br].x - M); W += w[br]; }
        const float rW = 1.0f / W;
#pragma unroll
        for (int e = 0; e < 8; ++e) o[b][e] = 0.f;
#pragma unroll
        for (int br = 0; br < 3; ++br) { const float ww = w[br] * rW; const v4u p = pv[b][br];
            o[b][0] += ww * bflo(p.x); o[b][1] += ww * bfhi(p.x); o[b][2] += ww * bflo(p.y); o[b][3] += ww * bfhi(p.y);
            o[b][4] += ww * bflo(p.z); o[b][5] += ww * bfhi(p.z); o[b][6] += ww * bflo(p.w); o[b][7] += ww * bfhi(p.w); }
        float s = 0.f;
#pragma unroll
        for (int e = 0; e < 8; ++e) s += o[b][e] * o[b][e];
        ss[b] = s;
    }
#pragma unroll
    for (int b = 0; b < NB; ++b) ss[b] = wave_sum(ss[b]);
#pragma unroll
    for (int b = 0; b < NB; ++b) {
        const float rs = fast_rsq(ss[b] * (1.f / 512.f) + LN_EPS);
        v4u ov; ov.x = pkbf(o[b][0] * rs, o[b][1] * rs); ov.y = pkbf(o[b][2] * rs, o[b][3] * rs); ov.z = pkbf(o[b][4] * rs, o[b][5] * rs); ov.w = pkbf(o[b][6] * rs, o[b][7] * rs);
        *(v4u*)(mixed + (tok0 + b * tstride) * DM + 8 * lane) = ov;
    }
}
template <int NB>
__device__ __forceinline__ void conv_tokens(const bf16* proj, const float* cw, bf16* mixed, size_t tok0, size_t tstride, int lane) {
    const f32x4 w0 = *(const f32x4*)(cw + 4 * lane), w1 = *(const f32x4*)(cw + 256 + 4 * lane), w2 = *(const f32x4*)(cw + 512 + 4 * lane);
    v2u zz[NB][3], gb[NB];
#pragma unroll
    for (int b = 0; b < NB; ++b) { const size_t tok = tok0 + b * tstride; const int t = (int)(tok & (SEQ - 1));
#pragma unroll
        for (int j = 0; j < 3; ++j) { zz[b][j] = (v2u){0u, 0u};
            if (t - 2 + j >= 0) zz[b][j] = *(const v2u*)(proj + (tok - 2 + j) * PW + OGC + 4 * lane); }
        gb[b] = *(const v2u*)(proj + tok * PW + OGB + 4 * lane); }
    f32x4 y[NB]; float ss[NB];
#pragma unroll
    for (int b = 0; b < NB; ++b) {
        f32x4 acc = (f32x4){0.f, 0.f, 0.f, 0.f};
#pragma unroll
        for (int j = 0; j < 3; ++j) { const v2u g = zz[b][j];
            const f32x4 z = (f32x4){bflo(g.x), bfhi(g.x), bflo(g.y), bfhi(g.y)};
            acc += z * (j == 0 ? w0 : (j == 1 ? w1 : w2)); }
        y[b] = (f32x4){bflo(gb[b].x), bfhi(gb[b].x), bflo(gb[b].y), bfhi(gb[b].y)} * acc;
        ss[b] = (y[b][0] * y[b][0] + y[b][1] * y[b][1]) + (y[b][2] * y[b][2] + y[b][3] * y[b][3]);
    }
#pragma unroll
    for (int b = 0; b < NB; ++b) ss[b] = wave_sum(ss[b]);
#pragma unroll
    for (int b = 0; b < NB; ++b) {
        const float rs = fast_rsq(ss[b] * (1.f / 256.f) + LN_EPS);
        v2u w; w.x = pkbf(y[b][0] * rs, y[b][1] * rs); w.y = pkbf(y[b][2] * rs, y[b][3] * rs);
        *(v2u*)(mixed + (tok0 + b * tstride) * DM + 768 + 4 * lane) = w;
    }
}

struct RSel { int e0, e1, pbin; unsigned half0, r0, r1, rp; float g0, g1; bool own; };
__device__ __forceinline__ void route_block(const bf16* S, const bf16* Wrt  , const float* cr, const float* dr, const float* g1v, const float* b1v, bf16* XN, int* ELIST, int* EDEST, float* EGATE, int* PLIST, gu32* cnt  ,
                                            int blk, LAS unsigned char* lds, int wave_s) {
    const int lane = pg8::lane_id_v(), wid = wave_s, tid = wid * 64 + lane, t16 = lane & 15, q4 = lane >> 4;
    LAS unsigned* hist = (LAS unsigned*)(lds + TB_OFF) + TB_HIST;
    LAS unsigned* base = (LAS unsigned*)(lds + TB_OFF) + TB_BASE;
    if (tid < NCNT) hist[tid] = 0u;
    const unsigned tokA = (unsigned)blk * 256u + 32u * wid + t16, tokB = tokA + 16u;
    const bf16* srA = S + (size_t)tokA * DM + 8 * q4; const bf16* srB = S + (size_t)tokB * DM + 8 * q4;
    v4u ra[32], rb[32];
#pragma unroll
    for (int s = 0; s < 32; ++s) ra[s] = *(const v4u*)(srA + 32 * s);
    LAS float* gbl = (LAS float*)(lds + RING_OFF);
    { const f32x4 gq = *(const f32x4*)(((tid < 256) ? g1v : b1v) + 4 * (tid & 255)); *(LAS f32x4*)(gbl + 4 * tid) = gq; }
    LAS unsigned char* wl = lds + RING_OFF + 8192;
#pragma unroll
    for (int i = 0; i < 9; ++i) { const int pc = tid + 512 * i, p = pc >> 7, c16 = pc & 127;
        const int src = (p < 16) ? (8 * (p >> 2) + (p & 3)) : ((p < 32) ? (8 * ((p - 16) >> 2) + 4 + (p & 3)) : p);
        *(LAS v4u*)(wl + p * 2064 + c16 * 16) = *(const v4u*)(Wrt + (size_t)src * DM + c16 * 8); }
    __syncthreads();
    const LAS unsigned char* wa0 = wl + t16 * 2064 + 16 * q4; const LAS unsigned char* wa1 = wa0 + 16 * 2064; const LAS unsigned char* wa2 = wl + (32 + (t16 & 3)) * 2064 + 16 * q4;

#define RT_MM(r_, c0_, c1_, c2_, mu_, rstd_)                                                                                                                   \
    f32x4 c0_ = (f32x4){0.f, 0.f, 0.f, 0.f}, c1_ = c0_, c2_ = c0_; float mu_, rstd_;                                                                            \
    {   float ssum = 0.f, ssq = 0.f;                                                                                                                            \
        _Pragma("unroll") for (int s4 = 0; s4 < 32; s4 += 4) {                                                                                                  \
            bf16x8 A0[4], A1[4], A2[4];                                                                                                                         \
            _Pragma("unroll") for (int q = 0; q < 4; ++q) { A0[q] = *(const LAS bf16x8*)(wa0 + 64 * (s4 + q)); A1[q] = *(const LAS bf16x8*)(wa1 + 64 * (s4 + q)); A2[q] = *(const LAS bf16x8*)(wa2 + 64 * (s4 + q)); } \
            _Pragma("unroll") for (int q = 0; q < 4; ++q) { const v4u x = r_[s4 + q]; const bf16x8 bfr = __builtin_bit_cast(bf16x8, x);                        \
                c0_ = __builtin_amdgcn_mfma_f32_16x16x32_bf16(A0[q], bfr, c0_, 0, 0, 0);                                                                        \
                c1_ = __builtin_amdgcn_mfma_f32_16x16x32_bf16(A1[q], bfr, c1_, 0, 0, 0);                                                                        \
                c2_ = __builtin_amdgcn_mfma_f32_16x16x32_bf16(A2[q], bfr, c2_, 0, 0, 0);                                                                        \
                const float x0 = bflo(x.x), x1 = bfhi(x.x), x2 = bflo(x.y), x3 = bfhi(x.y), x4 = bflo(x.z), x5 = bfhi(x.z), x6 = bflo(x.w), x7 = bfhi(x.w);     \
                ssum += ((x0 + x1) + (x2 + x3)) + ((x4 + x5) + (x6 + x7));                                                                                      \
                ssq += ((x0 * x0 + x1 * x1) + (x2 * x2 + x3 * x3)) + ((x4 * x4 + x5 * x5) + (x6 * x6 + x7 * x7)); }                                             \
        }                                                                                                                                                       \
        ssum = sum_x32(sum_x16(ssum)); ssq = sum_x32(sum_x16(ssq));                                                                                             \
        mu_ = ssum * (1.f / 1024.f); const float var = ssq * (1.f / 1024.f) - mu_ * mu_; rstd_ = fast_rsq(var + LN_EPS); }

#define RT_SEL(sel_, c0_, c1_, c2_, mu_, rstd_)                                                                                                                 \
    RSel sel_;                                                                                                                                                  \
    {   const float rsmu = rstd_ * mu_;                                                                                                                         \
        const f32x4 crA = *(const f32x4*)(cr + 8 * q4), crB = *(const f32x4*)(cr + 8 * q4 + 4), drA = *(const f32x4*)(dr + 8 * q4), drB = *(const f32x4*)(dr + 8 * q4 + 4); \
        const f32x4 crG = *(const f32x4*)(cr + 32), drG = *(const f32x4*)(dr + 32);                                                                             \
        const f32x4 gl = rstd_ * c2_ - rsmu * crG + drG;                                                                                                        \
        float gmax = gl[0]; int gi = 0;                                                                                                                         \
        if (gl[1] > gmax) { gmax = gl[1]; gi = 1; }                                                                                                             \
        if (gl[2] > gmax) { gmax = gl[2]; gi = 2; }                                                                                                             \
        if (gl[3] > gmax) { gmax = gl[3]; gi = 3; }                                                                                                             \
        const float gp = 1.0f / (expf(gl[0] - gmax) + expf(gl[1] - gmax) + expf(gl[2] - gmax) + expf(gl[3] - gmax));                                            \
        const f32x4 ea = rstd_ * c0_ - rsmu * crA + drA, eb = rstd_ * c1_ - rsmu * crB + drB;                                                                   \
        float v0 = -INFINITY, v1 = -INFINITY; int i0 = 0, i1 = 0;                                                                                               \
        _Pragma("unroll") for (int j = 0; j < 8; ++j) { const float v = (j < 4) ? ea[j & 3] : eb[j & 3];                                                        \
            if (v > v0) { v1 = v0; i1 = i0; v0 = v; i0 = j; } else if (v > v1) { v1 = v; i1 = j; } }                                                            \
        const float e1 = expf(v1 - v0);                                                                                                                         \
        sel_.g0 = gp / (1.0f + e1); sel_.g1 = gp * e1 / (1.0f + e1);                                                                                            \
        sel_.e0 = gi * 8 + i0; sel_.e1 = gi * 8 + i1;                                                                                                           \
        const int ia = i0 < i1 ? i0 : i1, ib = i0 < i1 ? i1 : i0;                                                                                               \
        sel_.pbin = gi * 28 + ((ia * (15 - ia)) >> 1) + (ib - ia - 1);                                                                                          \
        sel_.half0 = (i0 < i1) ? 0u : 1u;                                                                                                                       \
        sel_.own = (q4 == gi); sel_.r0 = 0u; sel_.r1 = 0u; sel_.rp = 0u;                                                                                        \
        if (sel_.own) { sel_.r0 = __hip_atomic_fetch_add(hist + sel_.e0, 1u, __ATOMIC_RELAXED, __HIP_MEMORY_SCOPE_WORKGROUP); sel_.r1 = __hip_atomic_fetch_add(hist + sel_.e1, 1u, __ATOMIC_RELAXED, __HIP_MEMORY_SCOPE_WORKGROUP); \
                        sel_.rp = __hip_atomic_fetch_add(hist + NEB + sel_.pbin, 1u, __ATOMIC_RELAXED, __HIP_MEMORY_SCOPE_WORKGROUP); } }

#define RT_NORM(r_, xrow_, mu_, rstd_, PREF_)                                                                                                                   \
    _Pragma("unroll") for (int s = 0; s < 32; ++s) { v4u x = r_[s]; asm volatile("" : "+v"(x));        \
        const f32x4 ga = *(const LAS f32x4*)(gbl + 32 * s + 8 * q4), gb = *(const LAS f32x4*)(gbl + 32 * s + 8 * q4 + 4), ba = *(const LAS f32x4*)(gbl + 1024 + 32 * s + 8 * q4), bb = *(const LAS f32x4*)(gbl + 1024 + 32 * s + 8 * q4 + 4); \
        f32x4 x0 = (f32x4){bflo(x.x), bfhi(x.x), bflo(x.y), bfhi(x.y)}, x1 = (f32x4){bflo(x.z), bfhi(x.z), bflo(x.w), bfhi(x.w)};                               \
        x0 = (x0 - mu_) * rstd_ * ga + ba; x1 = (x1 - mu_) * rstd_ * gb + bb;                                                                                   \
        v4u w; w.x = pkbf(x0[0], x0[1]); w.y = pkbf(x0[2], x0[3]); w.z = pkbf(x1[0], x1[1]); w.w = pkbf(x1[2], x1[3]);                                          \
        *(v4u*)(xrow_ + 32 * s) = w;                                                                                                                            \
        PREF_                                                                                                                                                   \
        if ((s & 3) == 3) __builtin_amdgcn_sched_barrier(0); }

    RT_MM(ra, a0, a1, a2, muA, rstdA)
    { bf16* xrA = XN + (size_t)tokA * DM + 8 * q4;
      RT_NORM(ra, xrA, muA, rstdA, rb[s] = *(const v4u*)(srB + 32 * s);) }
    RT_SEL(selA, a0, a1, a2, muA, rstdA)
    RT_MM(rb, b0, b1, b2, muB, rstdB)
    RT_SEL(selB, b0, b1, b2, muB, rstdB)
    __syncthreads();
    unsigned gbase = 0u;
    if (tid < NCNT) gbase = __hip_atomic_fetch_add(cnt + tid, hist[tid], RLX_AGENT);
    { bf16* xrB = XN + (size_t)tokB * DM + 8 * q4;
      RT_NORM(rb, xrB, muB, rstdB, ;) }
#undef RT_MM
#undef RT_SEL
#undef RT_NORM
    if (tid < NCNT) base[tid] = gbase;
    __syncthreads();
#pragma unroll
    for (int g = 0; g < 2; ++g) { const RSel& sl = g ? selB : selA; const unsigned tok = g ? tokB : tokA;
        if (sl.own) {
            const unsigned ps = base[NEB + sl.pbin] + sl.rp;
            PLIST[(size_t)sl.pbin * NTOK + ps] = (int)tok;
            const size_t s0 = (size_t)sl.e0 * NTOK + base[sl.e0] + sl.r0, s1 = (size_t)sl.e1 * NTOK + base[sl.e1] + sl.r1;
            ELIST[s0] = (int)tok; EGATE[s0] = sl.g0; EDEST[s0] = (int)(((unsigned)sl.pbin << 18) | (ps << 1) | sl.half0);
            ELIST[s1] = (int)tok; EGATE[s1] = sl.g1; EDEST[s1] = (int)(((unsigned)sl.pbin << 18) | (ps << 1) | (sl.half0 ^ 1u));
        } }
    __syncthreads();
}

__device__ __forceinline__ void moe_setup(const gu32* cnt, const int* ELIST, const int* EDEST, const float* EGATE, const int* PLIST, int G, int vcu, LAS unsigned char* lds, int wave_s) {
    const int tid = wave_s * 64 + pg8::lane_id_v();
    LAS int* tb = (LAS int*)(lds + TB_OFF);
    LAS int* tbE = tb + TB_TBE; LAS int* clE = tb + TB_CLE; LAS int* tbP = tb + TB_TBP; LAS int* clP = tb + TB_CLP;
    LAS int* ut = (LAS int*)(lds + UT_OFF);
    LAS int* tab = (LAS int*)(lds + TAB_OFF); LAS float* tab2 = (LAS float*)(lds + TAB2_OFF); LAS unsigned short* gtab = (LAS unsigned short*)(lds + GTAB_OFF);
    if (tid < NEB) clE[tid] = (int)__hip_atomic_load(cnt + tid, RLX_AGENT);
    else if (tid < NCNT) clP[tid - NEB] = (int)__hip_atomic_load(cnt + tid, RLX_AGENT);
    __syncthreads();
    if (tid < NEB) { int a = 0; for (int j = 0; j < NEB; ++j) { const int tj = (clE[j] + 255) >> 8; a += (j < tid) ? tj : 0; if (tid == NEB - 1 && j == NEB - 1) tbE[NEB] = a + tj; } tbE[tid] = a; }
    else if (tid < NCNT) { const int me = tid - NEB; int a = 0; for (int j = 0; j < NPB; ++j) { const int tj = (clP[j] + 255) >> 8; a += (j < me) ? tj : 0; if (me == NPB - 1 && j == NPB - 1) tbP[NPB] = a + tj; } tbP[me] = a; }
    __syncthreads();
    LAS int* ut6 = (LAS int*)(lds + P6UT_OFF); LAS unsigned short* tab6 = (LAS unsigned short*)(lds + P6TAB_OFF);
    if (tid < NU_MAX) {
        const int L = tid * G + vcu;
        int nv = -1, tile = 0, pn = 0, bin = 0, rb = 0;
        if (L < tbE[NEB] * 4) { tile = L >> 2; pn = L & 3;
            for (int b = 0; b < NEB; ++b) if (tile >= tbE[b] && tile < tbE[b + 1]) bin = b;
            rb = (tile - tbE[bin]) * 256; nv = clE[bin] - rb; nv = nv > 256 ? 256 : nv; }
        ut[tid * 8 + 0] = tile; ut[tid * 8 + 1] = pn; ut[tid * 8 + 2] = bin; ut[tid * 8 + 3] = bin; ut[tid * 8 + 4] = rb; ut[tid * 8 + 5] = nv; ut[tid * 8 + 6] = tid;
    } else if (tid >= 64 && tid < 64 + NU6_MAX) {
        const int i6 = tid - 64, L = i6 * G + vcu;
        int nv = -1, tile = 0, pn = 0, bin = 0, rb = 0, e = 0, e2 = 0;
        if (L < tbP[NPB] * 4) { tile = L >> 2; pn = L & 3;
            for (int b = 0; b < NPB; ++b) if (tile >= tbP[b] && tile < tbP[b + 1]) bin = b;
            rb = (tile - tbP[bin]) * 256; nv = clP[bin] - rb; nv = nv > 256 ? 256 : nv;
            const int gi = bin / 28; int idx = bin % 28, ia = 0; while (idx >= 7 - ia) { idx -= 7 - ia; ++ia; }
            e = gi * 8 + ia; e2 = gi * 8 + ia + 1 + idx; }
        ut6[i6 * 8 + 0] = tile; ut6[i6 * 8 + 1] = pn; ut6[i6 * 8 + 2] = e; ut6[i6 * 8 + 3] = bin; ut6[i6 * 8 + 4] = rb; ut6[i6 * 8 + 5] = nv; ut6[i6 * 8 + 6] = e2;
    }
    __syncthreads();
    {
        constexpr int NE = NU_MAX * 256 / (NWAVES * 64), NE6 = NU6_MAX * 256 / (NWAVES * 64);
        int tokv[NE], dv[NE]; float gv[NE]; int tok6[NE6];
#pragma unroll
        for (int q = 0; q < NE; ++q) { const int en = tid + q * (NWAVES * 64), i = en >> 8, r = en & 255; const int nv = ut[i * 8 + 5];
            tokv[q] = 0; dv[q] = -1; gv[q] = 0.f;
            if (r < nv) { const size_t idx = (size_t)ut[i * 8 + 3] * NTOK + ut[i * 8 + 4] + r; tokv[q] = ELIST[idx]; dv[q] = EDEST[idx]; gv[q] = EGATE[idx]; } }
#pragma unroll
        for (int q = 0; q < NE6; ++q) { const int en = tid + q * (NWAVES * 64), i = en >> 8, r = en & 255; const int nv = ut6[i * 8 + 5];
            tok6[q] = 0xffff;
            if (r < nv) tok6[q] = PLIST[(size_t)ut6[i * 8 + 3] * NTOK + ut6[i * 8 + 4] + r]; }
#pragma unroll
        for (int q = 0; q < NE; ++q) { const int en = tid + q * (NWAVES * 64); gtab[en] = (unsigned short)tokv[q]; tab[en] = dv[q]; tab2[en] = gv[q]; }
#pragma unroll
        for (int q = 0; q < NE6; ++q) tab6[tid + q * (NWAVES * 64)] = (unsigned short)tok6[q];
    }
    __syncthreads();
    if (tid < NU6_MAX) ut6[tid * 8 + 4] = tid;
    __syncthreads();
}

__global__ void __launch_bounds__(NWAVES * 64, 2) mega_fwd(Args args) {
    extern __shared__ __attribute__((aligned(16))) unsigned char lds_raw[];
    LAS unsigned char* lds = (LAS unsigned char*)lds_raw;
    volatile LAS unsigned* MISC = (volatile LAS unsigned*)(lds + MISC_OFF);
    const int wave = __builtin_amdgcn_readfirstlane((int)threadIdx.x >> 6);
#define LANE_TID() const int lane = pg8::lane_id_v(); const int tid = wave * 64 + lane; (void)tid
    const int G = gridDim.x; const int bx = blockIdx.x; const int vcu = (G % 8 == 0) ? (bx % 8) * (G / 8) + bx / 8 : bx;
    unsigned char* ws_top = args.ws;
    gu32* ctl = (gu32*)(ws_top + WS_CTL);
#define WS_PTRS() GAS unsigned char* wsg_ = (GAS unsigned char*)ws_top; asm volatile("" : "+s"(wsg_)); unsigned char* ws = (unsigned char*)wsg_;     \
    float* VEC = (float*)(ws + WS_VEC); float* CS = (float*)(ws + WS_ROPE); \
    bf16* WIN = (bf16*)(ws + WS_WIN); bf16* WOUT = (bf16*)(ws + WS_WOUT); bf16* WRT = (bf16*)(ws + WS_WRT); bf16* WSGU = (bf16*)(ws + WS_WSGU); \
    bf16* WGU = (bf16*)(ws + WS_WGU); bf16* WD = (bf16*)(ws + WS_WD); \
    bf16* Sb = (bf16*)(ws + WS_S); float* ST = (float*)(ws + WS_ST); float* RS0 = (float*)(ws + WS_RS0); bf16* XN1 = (bf16*)(ws + WS_MIXED); \
    bf16* PROJ = (bf16*)(ws + WS_PROJ); bf16* MIXED = (bf16*)(ws + WS_MIXED); bf16* PART = (bf16*)(ws + WS_PART); float* ML = (float*)(ws + WS_ML); \
    bf16* Hb = (bf16*)(ws + WS_H); int* ELIST = (int*)(ws + WS_ELIST); int* EDEST = (int*)(ws + WS_EDEST); float* EGATE = (float*)(ws + WS_EGATE); int* PLIST = (int*)(ws + WS_PLIST); \
    (void)VEC; (void)CS; (void)WIN; (void)WOUT; (void)WRT; (void)WSGU; (void)WGU; (void)WD; (void)Sb; (void)ST; (void)RS0; (void)XN1; (void)PROJ; (void)MIXED; (void)PART; (void)ML; (void)Hb; (void)ELIST; (void)EDEST; (void)EGATE; (void)PLIST
    const float* x_in = args.in[0]; const float* w_in = args.in[1]; const float* w_out = args.in[2]; const float* branch_gain = args.in[3]; const float* sgu_gain = args.in[4];
    const float* sgu_w = args.in[5]; const float* sgu_b = args.in[6]; const float* conv_w = args.in[7]; const float* ln_gain = args.in[8]; const float* ln_bias = args.in[9];
    const float* rgw = args.in[10]; const float* rgb = args.in[11]; const float* rew = args.in[12]; const float* reb = args.in[13];
    const float* ewg = args.in[14]; const float* ewu = args.in[15]; const float* ewd = args.in[16];

    { LANE_TID(); for (int u = tid; u < (LDS_BYTES - TAB_OFF) / 4; u += NWAVES * 64) ((LAS unsigned*)(lds + TAB_OFF))[u] = 0u; }
    __syncthreads();
    XcdBarrier bar = xcd_barrier_post((unsigned*)(ctl + CW_BAR), MISC + 8);
    const int gw = vcu * NWAVES + wave, NGW = G * NWAVES;
#ifndef REP_MASK
#define REP_MASK 0
#endif
#define REPS(idx) for (int rep_ = 0; rep_ < 1 + ((REP_MASK >> (idx)) & 1); ++rep_)
#ifdef STAMP_A
    volatile LAS unsigned* tacc = (volatile LAS unsigned*)(lds + MISC_OFF + 64);
    unsigned long long t_last = __builtin_amdgcn_s_memrealtime();
#define STAMP(ty) do { const unsigned long long _n = __builtin_amdgcn_s_memrealtime(); if (wave == 0 && pg8::lane_id_v() == 0) tacc[ty] += (unsigned)(_n - t_last); t_last = _n; } while (0)
#else
#define STAMP(ty) do { } while (0)
#endif
    LAS float* scr = (LAS float*)(lds + RING_OFF + wave * 16384);
    const int lo = args.ph_lo, hi_ph = args.ph_hi;
#ifndef PHASE_MASK
#define PHASE_MASK 0xFFFFu
#endif
#define IN(k) (((PHASE_MASK >> ((k) == 0 ? 0 : ((k) == 99 ? 9 : 1 + (((k) - 1) & 15)))) & 1u) && lo <= (k) && (k) < hi_ph)

    if (IN(0)) REPS(0) {
        WS_PTRS(); LANE_TID();
        for (int i = gw * 64 + lane; i < 1024; i += NGW * 64) { VEC[V_ONES + i] = 1.0f; VEC[V_ZEROS + i] = 0.0f; }
        const int NRW = NGW - 512, rw = gw - 512;
        if (rw >= 0)
        for (int m0 = rw; m0 < NTOK; m0 += 8 * NRW) {
            f32x4 v[8][4];
#pragma unroll
            for (int b = 0; b < 8; ++b) { const int m = m0 + b * NRW; const GAS f32x4* xr = (const GAS f32x4*)(x_in + (size_t)(m < NTOK ? m : 0) * DM) + lane;
#pragma unroll
                for (int j = 0; j < 4; ++j) v[b][j] = xr[64 * j]; }
#pragma unroll
            for (int b = 0; b < 8; ++b) { const int m = m0 + b * NRW; if (m < NTOK) { GAS v2u* o8 = (GAS v2u*)(Sb + (size_t)m * DM) + lane;
#pragma unroll
                for (int j = 0; j < 4; ++j) { v2u w; w.x = pkbf(v[b][j][0], v[b][j][1]); w.y = pkbf(v[b][j][2], v[b][j][3]); o8[64 * j] = w; }
                if (lane < 32) ST[(size_t)m * 32 + lane] = (lane == 1) ? 1024.0f * (1.0f - LN_EPS) : 0.0f; } }
        }
        for (int i = gw * 64 + lane; i < SEQ * 32; i += NGW * 64) { const int t = i >> 5, f = i & 31; const float inv_freq = powf(10000.0f, -(float)f / 32.0f); const float ang = (float)t * inv_freq;
            float sn, cn; sincosf(ang, &sn, &cn); CS[2 * i] = cn; CS[2 * i + 1] = sn; }
        constexpr int I_IN = 4 * 88, I_OUT = 4 * 32;
        for (int it = gw; it < I_IN + I_OUT; it += NGW) {
            if (it < I_IN) { const int l = it / 88, nb = it % 88, n0 = nb * 32;
                const float* sc = (l == 0) ? nullptr : ln_gain + (size_t)(l - 1) * 2048 + 1024; const float* bk = (l == 0) ? nullptr : ln_bias + (size_t)(l - 1) * 2048 + 1024;
                bf16* wt = WIN + ((size_t)l * PW + n0) * DM; float* cs = VEC + V_CIN + l * PW + n0; float* ds = VEC + V_DIN + l * PW + n0;
                if (n0 < 1024) conv_item(w_in + (size_t)l * DM * PW, DM, PW, ColRope(), n0, wt, 1, sc, bk, cs, ds, scr, lane);
                else if (n0 >= OGC) conv_item(w_in + (size_t)l * DM * PW, DM, PW, ColConv(), n0, wt, 1, sc, bk, cs, ds, scr, lane);
                else conv_item(w_in + (size_t)l * DM * PW, DM, PW, ColId(), n0, wt, 1, sc, bk, cs, ds, scr, lane);
            } else { const int r = it - I_IN, l = r / 32, n0 = (r % 32) * 32;
                conv_item(w_out + (size_t)l * DM * DM, DM, DM, ColId(), n0, WOUT + ((size_t)l * DM + n0) * DM, 1, branch_gain + (size_t)l * 1024, nullptr, nullptr, nullptr, scr, lane); }
        }
        for (int i = gw * 64 + lane; i < 4 * 4 * 128 * 128; i += NGW * 64) {
            const int p = i & 15, s = (i & 112) + 8 * ((p & 7) >> 2) + 4 * (p >> 3) + (p & 3), t = (i >> 7) & 127; WSGU[i] = (bf16)(pkbf((s <= t) ? sgu_w[(i & ~127) + s] : 0.0f, 0.f) & 0xffffu); }
        for (int it = gw; it < 4 * 64; it += NGW) {
            const int l = it >> 6, n = it & 63; const float* g1 = ln_gain + (size_t)l * 2048; const float* b1 = ln_bias + (size_t)l * 2048;
            float cs = 0.f, ds = 0.f;
            for (int k = lane; k < DM; k += 64) { float w = 0.f; if (n < 32) w = rew[((size_t)l * DM + k) * 32 + n]; else if (n < 36) w = rgw[((size_t)l * DM + k) * 4 + (n - 32)];
                const float v = rbf(w * g1[k]); cs += v; ds += b1[k] * w; WRT[((size_t)l * 64 + n) * DM + k] = (bf16)(pkbf(v, 0.f) & 0xffffu); }
            cs = wave_sum(cs); ds = wave_sum(ds);
            if (lane == 0) { float bias = 0.f; if (n < 32) bias = reb[l * 32 + n]; else if (n < 36) bias = rgb[l * 4 + n - 32]; VEC[V_CR + l * 64 + n] = cs; VEC[V_DR + l * 64 + n] = ds + bias; }
        }
        xcd_barrier(bar);
        STAMP(0);
    }

    for (int l = 0; l < args.nlayers; ++l) {
        const int pb = 1 + l * 16;
        const float* G1 = ln_gain + (size_t)l * 2048; const float* B1 = ln_bias + (size_t)l * 2048;
        gu32* cnt = ctl + CW_CNT + l * 256;

        if (IN(pb + 0)) REPS(1) {
            WS_PTRS();
#ifdef STAGGER_P1
            if (vcu & 1) { const unsigned long long s0_ = __builtin_amdgcn_s_memrealtime(); while (__builtin_amdgcn_s_memrealtime() - s0_ < (unsigned long long)(STAGGER_P1)) __builtin_amdgcn_s_sleep(8); }
#endif
            pg8::Gemm g{Sb, WIN + (size_t)l * PW * DM, DM}; pg8::DenseOrder S; S.init(NTOK, PW, DM, G, bx);
            { LAS float* xt = (LAS float*)(lds + TAB_OFF); const int tid_ = wave * 64 + pg8::lane_id_v();
              for (int i = tid_; i < PW; i += NWAVES * 64) { xt[XT_C + i] = VEC[V_CIN + l * PW + i]; xt[XT_D + i] = VEC[V_DIN + l * PW + i]; }
              if (tid_ == 0) ((LAS int*)xt)[XT_LASTPM] = -1;
              __syncthreads(); }
            EpiProj E{PROJ, VEC + V_CIN + l * PW, VEC + V_DIN + l * PW, ST, RS0, CS, (LAS float*)(lds + TAB_OFF)};
            pg8::gemm_phase<EpiProj, pg8::DenseOrder, false>(lds + RING_OFF, g, S, E, nullptr, wave);
            xcd_barrier(bar);
            STAMP(1);
        }
        if (IN(pb + 1)) REPS(2) {
            WS_PTRS();
            attn_phase(PROJ, PART, ML, vcu, G, lds, wave);
            xcd_barrier(bar);
            STAMP(2);
        }
        if (IN(pb + 2)) REPS(3) {
            WS_PTRS(); LANE_TID();
            TS_DECL(); TS_BEGIN(301);
            for (int c = vcu; c < NTOK / 128; c += G) sgu_unit(PROJ, MIXED, WSGU + (size_t)l * 4 * 128 * 128, sgu_gain + (size_t)l * 256, sgu_b + (size_t)l * 512, c, lds, wave);
            TS_END(301, lds, wave); TS_BEGIN(302);
            for (int m = gw; m < NTOK; m += 4 * NGW) { combine_tokens<4>(PART, ML, MIXED, (size_t)m, (size_t)NGW, lane); conv_tokens<4>(PROJ, conv_w + (size_t)l * 768, MIXED, (size_t)m, (size_t)NGW, lane); }
            TS_END(302, lds, wave);
            xcd_barrier(bar);
            STAMP(3);
        }
        if (IN(pb + 3)) REPS(4) {
            WS_PTRS();
            pg8::Gemm g{MIXED, WOUT + (size_t)l * DM * DM, DM}; pg8::DenseOrder S; S.init(NTOK, DM, DM, G, bx);
            const float* Gp = (l == 0) ? VEC + V_ONES : ln_gain + (size_t)(l - 1) * 2048 + 1024;
            const float* Bp = (l == 0) ? VEC + V_ZEROS : ln_bias + (size_t)(l - 1) * 2048 + 1024;
            EpiRes1 E{Sb, RS0, Gp, Bp, (rep_ == ((REP_MASK >> 4) & 1)) ? Sb : PROJ};
            pg8::gemm_phase<EpiRes1, pg8::DenseOrder, false>(lds + RING_OFF, g, S, E, nullptr, wave);
            xcd_barrier(bar);
            STAMP(4);
        }
        if (IN(pb + 4)) REPS(5) {
            WS_PTRS(); LANE_TID();
            for (int blk = vcu; blk < NTOK / 256; blk += G) route_block(Sb, WRT + (size_t)l * 64 * DM, VEC + V_CR + l * 64, VEC + V_DR + l * 64, G1, B1, XN1, ELIST, EDEST, EGATE, PLIST, cnt, blk, lds, wave);
            TS_DECL(); TS_BEGIN(404);
            for (int rc_ = 0; rc_ < 1 + ((REP_MASK >> 10) & 1); ++rc_)
            for (int it0 = gw; it0 < 2048; it0 += NGW) {
                const int it = it0 >> 1, e = it >> 5, mat = (it >> 4) & 1, n0 = (it & 15) * 32;
                const float* W = (mat ? ewu : ewg) + ((size_t)l * 32 + e) * DM * 512;
                bf16* wt = WGU + ((size_t)e * 1024 + 2 * n0 + mat) * DM;
                if (!(it0 & 1)) conv_item(W, 768, 512, ColId(), n0, wt, 2, nullptr, nullptr, nullptr, nullptr, scr, lane, DM);
                else { const int e2 = it >> 5, m0 = (it & 31) * 32;
                    conv_item(ewd + ((size_t)l * 32 + e2) * 512 * DM, 512, DM, ColId(), m0, WD + ((size_t)e2 * 1024 + m0) * 512, 1, nullptr, nullptr, nullptr, nullptr, scr, lane);
                    conv_item(W + (size_t)768 * 512, 256, 512, ColId(), n0, wt + 768, 2, nullptr, nullptr, nullptr, nullptr, scr, lane, DM); }
            }
            TS_END(404, lds, wave);
            xcd_barrier(bar);
            STAMP(5);
        }
        if (IN(pb + 5)) REPS(6) {
            WS_PTRS();
            { TS_DECL(); TS_BEGIN(501); moe_setup(cnt, ELIST, EDEST, EGATE, PLIST, G, vcu, lds, wave); TS_END(501, lds, wave); }
            pg8::Gemm g{XN1, WGU, DM}; MoeOrder S{(const LAS int*)(lds + UT_OFF), DM, DM, (size_t)1024 * DM * 2, NU_MAX};
            EpiSwiglu E{Hb, (const LAS int*)(lds + TAB_OFF), (const LAS float*)(lds + TAB2_OFF), (const LAS int*)(lds + TB_OFF) + TB_TBP};
            pg8::gemm_phase<EpiSwiglu, MoeOrder, true, false>(lds + RING_OFF, g, S, E, (const LAS unsigned short*)(lds + GTAB_OFF), wave);
            xcd_barrier(bar);
            STAMP(6);
        }
        if (IN(pb + 6)) REPS(7) {
            WS_PTRS();
            pg8::Gemm g{Hb, WD, DM}; MoeOrder S{(const LAS int*)(lds + P6UT_OFF), DM, 512, (size_t)1024 * 512 * 2, NU6_MAX};
            EpiDown E{Sb, XN1, (const LAS unsigned short*)(lds + P6TAB_OFF), ST};
            pg8::gemm_phase<EpiDown, MoeOrder, false, true>(lds + RING_OFF, g, S, E, nullptr, wave);
            xcd_barrier(bar);
            STAMP(7);
        }
    }
    if (IN(99)) REPS(9) {
        WS_PTRS(); LANE_TID();
        const int l = args.nlayers - 1;
        const float* G2 = ln_gain + (size_t)l * 2048 + 1024; const float* B2 = ln_bias + (size_t)l * 2048 + 1024;
        const unsigned poison = (__hip_atomic_load(ctl + CW_BAR + XB_TMO, RLX_AGENT) != 0u);
        for (int m0 = gw; m0 < NTOK; m0 += 4 * NGW) {
            float s[4], q[4]; v4u o[4][2];
#pragma unroll
            for (int b = 0; b < 4; ++b) { const int m = m0 + b * NGW; s[b] = 0.f; q[b] = 0.f;
                if (lane < 16) { const f32x2 p = *(const f32x2*)(ST + (size_t)m * 32 + 2 * lane); s[b] = p.x; q[b] = p.y; }
#pragma unroll
                for (int j = 0; j < 2; ++j) o[b][j] = *(const v4u*)(Sb + (size_t)m * DM + 512 * j + 8 * lane); }
#pragma unroll
            for (int b = 0; b < 4; ++b) { s[b] = wave_sum(s[b]); q[b] = wave_sum(q[b]); }
#pragma unroll
            for (int b = 0; b < 4; ++b) { const int m = m0 + b * NGW;
                const float mu = s[b] * (1.f / 1024.f); const float var = q[b] * (1.f / 1024.f) - mu * mu; float rstd = fast_rsq(var + LN_EPS);
                if (poison) rstd = __builtin_nanf("");
#pragma unroll
                for (int j = 0; j < 2; ++j) {
                    const int c = 512 * j + 8 * lane;
                    const f32x4 g0 = *(const f32x4*)(G2 + c), g1 = *(const f32x4*)(G2 + c + 4), b0 = *(const f32x4*)(B2 + c), b1 = *(const f32x4*)(B2 + c + 4);
                    f32x4 x0 = (f32x4){bflo(o[b][j].x), bfhi(o[b][j].x), bflo(o[b][j].y), bfhi(o[b][j].y)}, x1 = (f32x4){bflo(o[b][j].z), bfhi(o[b][j].z), bflo(o[b][j].w), bfhi(o[b][j].w)};
                    x0 = (x0 - mu) * rstd * g0 + b0; x1 = (x1 - mu) * rstd * g1 + b1;
                    *(f32x4*)(args.out + (size_t)m * DM + c) = x0; *(f32x4*)(args.out + (size_t)m * DM + c + 4) = x1;
                } }
        }
    }
#undef IN
#ifdef TSEC
    { __syncthreads(); const unsigned tot = ((volatile LAS unsigned*)(lds + MISC_OFF + 64))[wave]; const unsigned long long s0 = __builtin_amdgcn_s_memrealtime();
      while (__builtin_amdgcn_s_memrealtime() - s0 < (unsigned long long)tot) __builtin_amdgcn_s_sleep(8); }
#endif
}

static int g_grid = 0;
static int mega_prepare() {
    if (g_grid != 0) return g_grid;
    int dev = 0, cus = 0, per_cu = 0;
    if (hipGetDevice(&dev) != hipSuccess || hipDeviceGetAttribute(&cus, hipDeviceAttributeMultiprocessorCount, dev) != hipSuccess) { g_grid = -1; return g_grid; }
    if (hipFuncSetAttribute((const void*)mega_fwd, hipFuncAttributeMaxDynamicSharedMemorySize, LDS_BYTES) != hipSuccess) { fprintf(stderr, "hipFuncSetAttribute failed\n"); g_grid = -1; return g_grid; }
    if (hipOccupancyMaxActiveBlocksPerMultiprocessor(&per_cu, (const void*)mega_fwd, NWAVES * 64, LDS_BYTES) != hipSuccess || per_cu < 1) { fprintf(stderr, "occupancy query: %d blocks per CU\n", per_cu); }
    (void)hipGetLastError();
    g_grid = cus;
    return g_grid;
}
static void mega_launch(void* const* d_in, float* out, unsigned char* ws, hipStream_t stream, int ph_lo, int ph_hi, int nlayers) {
    const int grid = mega_prepare(); if (grid <= 0) return;
    (void)hipMemsetAsync(ws + WS_CTL, 0, CTL_ZERO_BYTES, stream);
    Args a{};
    for (int i = 0; i < 17; ++i) a.in[i] = (const float*)d_in[i];
    a.out = out; a.ws = ws; a.ph_lo = ph_lo; a.ph_hi = ph_hi; a.nlayers = nlayers; a.pad = 0;
    hipLaunchKernelGGL(mega_fwd, dim3(grid), dim3(NWAVES * 64), LDS_BYTES, stream, a);
}
extern "C" void kernel_launch(void* const* d_in, const int* in_sizes, int n_in, void* d_out, int out_size, void* d_ws, size_t ws_size, hipStream_t stream) {
    if (n_in != 17 || ws_size < WS_END) { fprintf(stderr, "kernel_launch: unexpected n_in %d / ws_size %zu\n", n_in, ws_size); return; }
    mega_launch(d_in, (float*)d_out, (unsigned char*)d_ws, stream, 0, 100, NL);
}
```

```cpp
#include <hip/hip_runtime.h>
#include <cstdio>
#include <cstdint>
#include <cmath>
namespace pg8 {
#define PG8_LAS __attribute__((address_space(3)))
typedef unsigned short bf16_t;
typedef short bf16x8 __attribute__((ext_vector_type(8)));
typedef float f32x4 __attribute__((ext_vector_type(4)));
typedef float f32x2 __attribute__((ext_vector_type(2)));
typedef unsigned u32x4 __attribute__((ext_vector_type(4)));
typedef unsigned u32x2 __attribute__((ext_vector_type(2)));
constexpr int BM = 256, BK = 64, HALF = 128, HTB = HALF * BK * 2  , STAGE_BYTES = 8 * HTB, NXCD = 8, WGM = 8;

__host__ __device__ __forceinline__ int lds_byte(int r, int c) { const int st = (r >> 4) * 2 + (c >> 5), rr = r & 15, cc = c & 31, ob = rr * 64 + cc * 2; return st * 1024 + (ob ^ (((ob >> 9) & 1) << 5)); }
__host__ __device__ __forceinline__ void stage_rc(int b, int& R, int& C) { const int st = b / 1024, sb = b % 1024, swz = sb ^ (((sb >> 9) & 1) << 5); R = (st >> 1) * 16 + swz / 64; C = (st & 1) * 32 + (swz % 64) / 2; }
__host__ __device__ __forceinline__ int perm32(int rho) { const int n = rho >> 4, i = rho & 15; return 8 * (i >> 2) + 4 * n + (i & 3); }

struct Unit { int pm, pn, e, bin, rbase, nvalid, e2; };
struct Gemm { const bf16_t* A; const bf16_t* Bt; int K; };

struct DenseOrder {
    int nM, nN, nwg, G, c, K;
    __device__ __forceinline__ void init(int M, int N, int K_, int G_, int c_) { nM = M / BM; nN = N / BM; nwg = nM * nN; G = G_; c = c_; K = K_; }
    __device__ __forceinline__ bool next(int i, Unit& u) const {
        const long L = (long)i * G + c; if (L >= nwg) return false;
        int wgid = (int)L; { const int q = nwg / NXCD, r = nwg % NXCD, xcd = wgid % NXCD, off = wgid / NXCD; wgid = (xcd < r ? xcd * (q + 1) : r * (q + 1) + (xcd - r) * q) + off; }
        const int nig = WGM * nN, gid = wgid / nig, fm = gid * WGM, gsz = (nM - fm) < WGM ? (nM - fm) : WGM;
        u.pm = fm + ((wgid % nig) % gsz); u.pn = (wgid % nig) / gsz; u.e = 0; u.bin = 0; u.rbase = 0; u.nvalid = 256; u.e2 = 0; return true;
    }
    __device__ __forceinline__ size_t a_off(const Unit& u) const { return (size_t)u.pm * (size_t)(BM * 2) * K; }
    __device__ __forceinline__ size_t b_off(const Unit& u) const { return (size_t)u.pn * (size_t)(BM * 2) * K; }
    __device__ __forceinline__ size_t b_off2(const Unit& u) const { return b_off(u); }
};

#ifdef TSEC
#define TS_DECL() unsigned long long ts0_ = 0
#define TS_BEGIN(id) do { if (TSEC == (id)) ts0_ = __builtin_amdgcn_s_memrealtime(); } while (0)
#define TS_END(id, ldsbase, wave) do { if (TSEC == (id)) { const unsigned long long d_ = __builtin_amdgcn_s_memrealtime() - ts0_; if (pg8::lane_id_v() == 0) ((volatile PG8_LAS unsigned*)((ldsbase) + 163840 - 256 + 64))[wave] += (unsigned)d_; } } while (0)
#else
#define TS_DECL() do { } while (0)
#define TS_BEGIN(id) do { } while (0)
#define TS_END(id, ldsbase, wave) do { } while (0)
#endif
__device__ __forceinline__ int lane_id_v() { int l; asm volatile("v_mbcnt_lo_u32_b32 %0, -1, 0\n\tv_mbcnt_hi_u32_b32 %0, -1, %0" : "=v"(l)); return l; }
__device__ __forceinline__ unsigned cvt_pk_bf16(float lo, float hi) { unsigned r; asm volatile("v_cvt_pk_bf16_f32 %0, %1, %2" : "=v"(r) : "v"(lo), "v"(hi)); return r; }

template <class Epi, class Sched, bool GATHER, bool DUALB = false>
__device__ __forceinline__ void gemm_phase(PG8_LAS unsigned char* lds, const Gemm g, const Sched& S, const Epi& E, const PG8_LAS unsigned short* tab, int wave_s) {
    const int lane = lane_id_v(), wid = wave_s, tid = wid * 64 + lane,
              wr = wid >> 2, wc = wid & 3, fr = lane & 15, fq = lane >> 4;
    const int K = g.K, nt = K / BK, Kb = DUALB ? K / 2 : K, nth = nt / 2;
    unsigned voffA[2], voffB[2]; int RA[2]; unsigned CA2[2];
#pragma unroll
    for (int i = 0; i < 2; ++i) { int R, C; stage_rc(tid * 16 + i * 8192, R, C); const int Rb = Epi::PERM ? ((R & ~31) + perm32(R & 31)) : R;
        voffA[i] = (unsigned)(R * K + C) * 2u; voffB[i] = (unsigned)(Rb * Kb + C) * 2u; RA[i] = R; CA2[i] = (unsigned)C * 2u; }
    const size_t kstep = (size_t)(BK * 2);
    const size_t hstep = (size_t)HALF * K * 2;
    const size_t hstepB = (size_t)HALF * Kb * 2;
    const unsigned ldsw = (unsigned)wid * 1024u;
    const int aoff = lds_byte(wr * 64 + fr, fq * 8), boff = lds_byte(wc * 32 + fr, fq * 8);
#define PG8_SA(b, h) (((b) * 2 + (h)) * HTB)
#define PG8_SB(b, h) ((4 + (b) * 2 + (h)) * HTB)
#define PG8_STAGE(bufoff, gbase, voff) do { _Pragma("unroll") for (int _i = 0; _i < 2; ++_i) \
        __builtin_amdgcn_global_load_lds((const unsigned*)((const char*)(gbase) + (voff)[_i]), (PG8_LAS unsigned*)(lds + (bufoff) + ldsw + _i * 8192), 16, 0, 0); } while (0)
#define PG8_LDA(dst, b, h) do { _Pragma("unroll") for (int m = 0; m < 4; ++m) _Pragma("unroll") for (int k = 0; k < 2; ++k) dst[m][k] = *(const PG8_LAS bf16x8*)(lds + PG8_SA(b, h) + aoff + m * 2048 + k * 1024); } while (0)
#define PG8_LDB(dst, b, h) do { _Pragma("unroll") for (int n = 0; n < 2; ++n) _Pragma("unroll") for (int k = 0; k < 2; ++k) dst[n][k] = *(const PG8_LAS bf16x8*)(lds + PG8_SB(b, h) + boff + n * 2048 + k * 1024); } while (0)
#define PG8_MMA(ai, bj, At, Bt) do { __builtin_amdgcn_s_setprio(1); _Pragma("unroll") for (int m = 0; m < 4; ++m) _Pragma("unroll") for (int n = 0; n < 2; ++n) _Pragma("unroll") for (int k = 0; k < 2; ++k) \
        acc[ai][bj][m][n] = __builtin_amdgcn_mfma_f32_16x16x32_bf16(Bt[n][k], At[m][k], acc[ai][bj][m][n], 0, 0, 0); __builtin_amdgcn_s_setprio(0); } while (0)
#define PG8_WAIT_V(n) asm volatile("s_waitcnt vmcnt(" #n ")" ::: "memory")
#define PG8_WAIT_L(n) asm volatile("s_waitcnt lgkmcnt(" #n ")" ::: "memory")
#define PG8_WAIT_V01(flag) do { if constexpr (Epi::NSTORE >= 16) { asm volatile("s_cmp_eq_u32 %0, 0\n\ts_cbranch_scc1 .Lw8_%=\n\ts_waitcnt vmcnt(24)\n\ts_branch .Lwd_%=\n.Lw8_%=:\n\ts_waitcnt vmcnt(8)\n.Lwd_%=:" :: "s"(__builtin_amdgcn_readfirstlane(flag)) : "memory", "scc"); } else { asm volatile("s_waitcnt vmcnt(8)" ::: "memory"); } } while (0)
#define PG8_BAR __builtin_amdgcn_s_barrier()
#define PG8_SCHED __builtin_amdgcn_sched_barrier(0)
    Unit cur, nxt; int ui = 0;
    if (!S.next(0, cur)) return;
    f32x4 acc[2][2][4][2];
#pragma unroll
    for (int a = 0; a < 2; ++a)
#pragma unroll
        for (int b = 0; b < 2; ++b)
#pragma unroll
            for (int m = 0; m < 4; ++m)
#pragma unroll
                for (int n = 0; n < 2; ++n) acc[a][b][m][n] = (f32x4){0.f, 0.f, 0.f, 0.f};
    bf16x8 At[4][2], B0[2][2], B1[2][2];
    [[maybe_unused]] u32x4 pq0 = (u32x4){0u, 0u, 0u, 0u};
    unsigned vc0[2], vc1[2], vn0[2], vn1[2];
#pragma unroll
    for (int i = 0; i < 2; ++i) {
        if constexpr (GATHER) { vc0[i] = (unsigned)tab[RA[i]] * (unsigned)(K * 2) + CA2[i]; vc1[i] = (unsigned)tab[128 + RA[i]] * (unsigned)(K * 2) + CA2[i]; }
        else { vc0[i] = voffA[i]; vc1[i] = voffA[i] + (unsigned)hstep; }
        vn0[i] = vc0[i]; vn1[i] = vc1[i];
    }
    const char* cA = (const char*)g.A + (GATHER ? (size_t)0 : S.a_off(cur)); const char* cB = (const char*)g.Bt + S.b_off(cur); const char* cB1 = (const char*)g.Bt + S.b_off2(cur);
    PG8_STAGE(PG8_SB(0, 0), cB, voffB); PG8_STAGE(PG8_SB(0, 1), cB + hstepB, voffB); PG8_STAGE(PG8_SA(0, 0), cA, vc0); PG8_STAGE(PG8_SA(0, 1), cA, vc1);
    if (wr == 1) PG8_BAR;
    PG8_WAIT_V(2); PG8_BAR;
    PG8_STAGE(PG8_SB(1, 0), cB + kstep, voffB); PG8_STAGE(PG8_SA(1, 0), cA + kstep, vc0); PG8_STAGE(PG8_SB(1, 1), cB + hstepB + kstep, voffB);
    PG8_WAIT_V(6); PG8_BAR;
    for (;;) {
        const bool has_next = S.next(ui + 1, nxt);
        const char* nA = has_next ? (const char*)g.A + (GATHER ? (size_t)0 : S.a_off(nxt)) : cA; const char* nB = has_next ? (const char*)g.Bt + S.b_off(nxt) : cB; const char* nB1 = has_next ? (const char*)g.Bt + S.b_off2(nxt) : cB1;
        if constexpr (GATHER) { if (has_next) {
#pragma unroll
            for (int i = 0; i < 2; ++i) { vn0[i] = (unsigned)tab[(ui + 1) * 256 + RA[i]] * (unsigned)(K * 2) + CA2[i]; vn1[i] = (unsigned)tab[(ui + 1) * 256 + 128 + RA[i]] * (unsigned)(K * 2) + CA2[i]; } } }
#define PG8_TRIP(t, W01) { \
            const int rlx_ = (Epi::NSTORE >= 16 && (t) == 0 && ui > 0) ? 1 : 0; \
            const bool last = (t == nt - 2); \
            const char* a1 = cA + (size_t)(t + 1) * kstep; \
            const char* a2 = last ? nA : cA + (size_t)(t + 2) * kstep; \
            const char* b2 = last ? nB : (DUALB ? ((t + 2 < nth) ? cB + (size_t)(t + 2) * kstep : cB1 + (size_t)(t + 2 - nth) * kstep) : cB + (size_t)(t + 2) * kstep); \
            const char* a3 = a2 + kstep; const char* b3 = b2 + kstep; \
            unsigned x0[2], x1[2]; \
            x0[0] = last ? vn0[0] : vc0[0]; x0[1] = last ? vn0[1] : vc0[1]; x1[0] = last ? vn1[0] : vc1[0]; x1[1] = last ? vn1[1] : vc1[1]; \
            PG8_LDB(B0, 0, 0); PG8_LDB(B1, 0, 1); PG8_SCHED; PG8_LDA(At, 0, 0); PG8_STAGE(PG8_SA(1, 1), a1, vc1); \
            PG8_WAIT_V01(rlx_); PG8_WAIT_L(0); PG8_BAR; PG8_MMA(0, 0, At, B0); PG8_MMA(0, 1, At, B1); PG8_BAR; PG8_SCHED; \
            PG8_LDA(At, 0, 1); PG8_STAGE(PG8_SB(0, 0), b2, voffB); PG8_STAGE(PG8_SB(0, 1), b2 + hstepB, voffB); PG8_STAGE(PG8_SA(0, 0), a2, x0); \
            PG8_WAIT_V01(rlx_); PG8_WAIT_L(0); PG8_BAR; PG8_MMA(1, 0, At, B0); PG8_MMA(1, 1, At, B1); PG8_BAR; PG8_SCHED; \
            if constexpr (Epi::HAS_PRE) { E.pre(acc, cur, t, pq0, wr, wc, fr, fq); PG8_SCHED; } \
            PG8_LDB(B0, 1, 0); PG8_LDB(B1, 1, 1); PG8_SCHED; PG8_LDA(At, 1, 0); PG8_STAGE(PG8_SA(0, 1), a2, x1); \
            PG8_WAIT_V(8); PG8_WAIT_L(0); PG8_BAR; PG8_MMA(0, 0, At, B0); PG8_MMA(0, 1, At, B1); PG8_BAR; PG8_SCHED; \
            PG8_LDA(At, 1, 1); PG8_STAGE(PG8_SB(1, 0), b3, voffB); PG8_STAGE(PG8_SB(1, 1), b3 + hstepB, voffB); PG8_STAGE(PG8_SA(1, 0), a3, x0); \
            PG8_WAIT_V(8); PG8_WAIT_L(0); PG8_BAR; PG8_MMA(1, 0, At, B0); PG8_MMA(1, 1, At, B1); PG8_BAR; PG8_SCHED; \
            if constexpr (Epi::HAS_PRE) { E.pre(acc, cur, t + 1, pq0, wr, wc, fr, fq); PG8_SCHED; } \
        }
        TS_DECL(); TS_BEGIN(120 + Epi::EPI_ID);
        if constexpr (Epi::HAS_PRE) {
            _Pragma("unroll") for (int t = 0; t < 16; t += 2) PG8_TRIP(t, 8)
        } else {
            for (int t = 0; t < nt; t += 2) PG8_TRIP(t, 8)
        }
#undef PG8_TRIP
        TS_END(120 + Epi::EPI_ID, lds, wid);
        if constexpr (Epi::HAS_PRE) E.pre(acc, cur, nt, pq0, wr, wc, fr, fq);
        if (wr == 0) PG8_BAR;
        { TS_BEGIN(100 + Epi::EPI_ID); E(acc, cur, wr, wc, fr, fq, tid); TS_END(100 + Epi::EPI_ID, lds, wid); }
#if defined(REP_EPI_ID)
        if constexpr (Epi::EPI_ID == REP_EPI_ID) E(acc, cur, wr, wc, fr, fq, tid);
#endif
        if (!has_next) break;
#pragma unroll
        for (int a = 0; a < 2; ++a)
#pragma unroll
            for (int b = 0; b < 2; ++b)
#pragma unroll
                for (int m = 0; m < 4; ++m)
#pragma unroll
                    for (int n = 0; n < 2; ++n) acc[a][b][m][n] = (f32x4){0.f, 0.f, 0.f, 0.f};
        cur = nxt; cA = nA; cB = nB; cB1 = nB1; ++ui;
#pragma unroll
        for (int i = 0; i < 2; ++i) { vc0[i] = vn0[i]; vc1[i] = vn1[i]; }
        if (wr == 1) PG8_BAR;
    }
    PG8_WAIT_V(0);
    PG8_BAR;
#undef PG8_SA
#undef PG8_SB
#undef PG8_STAGE
#undef PG8_LDA
#undef PG8_LDB
#undef PG8_MMA
#undef PG8_WAIT_V
#undef PG8_WAIT_L
#undef PG8_BAR
#undef PG8_SCHED
}
}
#define GAS __attribute__((address_space(1)))
#define LAS __attribute__((address_space(3)))
typedef unsigned short bf16;
typedef unsigned v4u __attribute__((ext_vector_type(4)));
typedef unsigned v2u __attribute__((ext_vector_type(2)));
typedef float f32x4 __attribute__((ext_vector_type(4)));
typedef float f32x2 __attribute__((ext_vector_type(2)));
typedef float f32x16 __attribute__((ext_vector_type(16)));
typedef short bf16x8 __attribute__((ext_vector_type(8)));
typedef short s16x4 __attribute__((ext_vector_type(4)));
typedef GAS unsigned gu32;
#define RLX_AGENT __ATOMIC_RELAXED, __HIP_MEMORY_SCOPE_AGENT
#define LDS_WAIT() asm volatile("s_waitcnt lgkmcnt(0)" ::: "memory")
#define VM_WAIT() asm volatile("s_waitcnt vmcnt(0)" ::: "memory")

constexpr int NWAVES = 8;
constexpr int NTOK = 65536, SEQ = 8192, DM = 1024, PW = 2816, NL = 4;
constexpr int OQ = 0, OKK = 512, OV = 1024, OU = 1536, OZ = 1792, OGB = 2048, OGC = 2304, OH = 2560;
constexpr float LN_EPS = 1e-5f, ALPHA = 1.6817928305074290f, LOG2E = 1.4426950408889634f, C2 = 0.125f * 1.4426950408889634f;
constexpr int NU_MAX = 10;
constexpr int NEB = 32, NPB = 112, NCNT = NEB + NPB;

constexpr size_t MiB = 1u << 20;
constexpr size_t WS_CTL = 0, CTL_ZERO_BYTES = 1 * MiB;
constexpr size_t WS_ROPE = 1 * MiB;
constexpr size_t WS_VEC = 3 * MiB;
constexpr size_t WS_WIN = 4 * MiB;
constexpr size_t WS_WOUT = 26 * MiB;
constexpr size_t WS_WRT = 34 * MiB;
constexpr size_t WS_WSGU = 35 * MiB;
constexpr size_t WS_WGU = 36 * MiB;
constexpr size_t WS_WD = 100 * MiB;
constexpr size_t WS_CGU = 132 * MiB;
constexpr size_t WS_S = 134 * MiB;
constexpr size_t WS_ST = 262 * MiB;
constexpr size_t WS_RS0 = 270 * MiB;
constexpr size_t WS_RS1 = 271 * MiB;
constexpr size_t WS_PROJ = 272 * MiB;
constexpr size_t WS_MIXED = 624 * MiB;
constexpr size_t WS_PART = 752 * MiB;
constexpr size_t WS_ML = 944 * MiB;
constexpr size_t WS_H = 272 * MiB;
constexpr size_t WS_ELIST = 456 * MiB;
constexpr size_t WS_EDEST = 464 * MiB;
constexpr size_t WS_EGATE = 472 * MiB;
constexpr size_t WS_PLIST = 480 * MiB;
constexpr size_t WS_END = 956 * MiB;
constexpr int V_ONES = 0, V_ZEROS = 1024, V_CIN = 2048  , V_DIN = V_CIN + 4 * PW, V_CR = V_DIN + 4 * PW  , V_DR = V_CR + 256;
constexpr int CW_TMO = 0, CW_CODE = 1, CW_BAR = 4096, CW_CNT = 16384;
constexpr int RING_OFF = 0, RING_BYTES = 131072;
constexpr int TAB_OFF = 131072;
constexpr int TAB2_OFF = TAB_OFF + NU_MAX * 1024;
constexpr int GTAB_OFF = TAB2_OFF + NU_MAX * 1024;
constexpr int UT_OFF = GTAB_OFF + NU_MAX * 512;
constexpr int TB_OFF = UT_OFF + 512;
constexpr int P6TAB_OFF = TB_OFF + 2560;
constexpr int P6UT_OFF = P6TAB_OFF + 3072;
constexpr int NU6_MAX = 6;
constexpr int TB_TBE = 0, TB_CLE = 33, TB_TBP = 65, TB_CLP = 178, TB_HIST = 290, TB_BASE = 434;
constexpr int LDS_BYTES = 163840;
constexpr int MISC_OFF = LDS_BYTES - 256;
static_assert(P6UT_OFF + 256 <= MISC_OFF && MISC_OFF + 256 <= LDS_BYTES, "LDS map");

__device__ __forceinline__ unsigned pkbf(float lo, float hi) { return pg8::cvt_pk_bf16(lo, hi); }
__device__ __forceinline__ float bflo(unsigned w) { return __uint_as_float(w << 16); }
__device__ __forceinline__ float bfhi(unsigned w) { return __uint_as_float(w & 0xffff0000u); }
__device__ __forceinline__ float bf2f(unsigned short b) { return __uint_as_float((unsigned)b << 16); }
__device__ __forceinline__ float rbf(float x) { return bflo(pkbf(x, 0.f)); }
__device__ __forceinline__ float fast_exp2(float x) { return __builtin_amdgcn_exp2f(x); }
__device__ __forceinline__ float fast_rcp(float x) { return __builtin_amdgcn_rcpf(x); }
__device__ __forceinline__ float fast_rsq(float x) { return __builtin_amdgcn_rsqf(x); }
__device__ __forceinline__ float gelu_t(float x) {
    const float u = 0.7978845608028654f * (x + 0.044715f * x * x * x);
    return x * fast_rcp(1.0f + fast_exp2(-2.0f * LOG2E * u));
}
__device__ __forceinline__ float silu_f(float x) { return x * fast_rcp(1.0f + fast_exp2(-LOG2E * x)); }
template <int CTRL> __device__ __forceinline__ float dppf(float v) { return __uint_as_float((unsigned)__builtin_amdgcn_update_dpp(0, (int)__float_as_uint(v), CTRL, 0xF, 0xF, true)); }
__device__ __forceinline__ float sum_x1(float v) { return v + dppf<0xB1>(v); }
__device__ __forceinline__ float sum_x2(float v) { return v + dppf<0x4E>(v); }
__device__ __forceinline__ float sum_q4(float v) { return v + dppf<0x141>(v); }
__device__ __forceinline__ float sum_q8(float v) { return v + dppf<0x140>(v); }
__device__ __forceinline__ float sum_x16(float v) { const auto r = __builtin_amdgcn_permlane16_swap(__float_as_uint(v), __float_as_uint(v), false, false); return __uint_as_float(r[0]) + __uint_as_float(r[1]); }
__device__ __forceinline__ float sum_x32(float v) { const auto r = __builtin_amdgcn_permlane32_swap(__float_as_uint(v), __float_as_uint(v), false, false); return __uint_as_float(r[0]) + __uint_as_float(r[1]); }
__device__ __forceinline__ float max_x32(float v) { const auto r = __builtin_amdgcn_permlane32_swap(__float_as_uint(v), __float_as_uint(v), false, false); return fmaxf(__uint_as_float(r[0]), __uint_as_float(r[1])); }
__device__ __forceinline__ float other_x32(float v, int hi) { const auto r = __builtin_amdgcn_permlane32_swap(__float_as_uint(v), __float_as_uint(v), false, false); return __uint_as_float(hi ? r[0] : r[1]); }
__device__ __forceinline__ float wave_sum(float v) { return sum_x32(sum_x16(sum_q8(sum_q4(sum_x2(sum_x1(v)))))); }

#define XB_TMO      128
#define XB_XCNT(j)  (256  + 64 * (j))
#define XB_XSUB(j)  (1280 + 64 * (j))
#define XB_XGEN(j)  (2304 + 64 * (j))
#define XB_TOP      3328
#define XB_TOPGEN   3392
#define XCD_BAR_WORDS 3456
#define XB_SPIN_CAP (1u << 18)
__device__ __forceinline__ unsigned xb_ld(unsigned* p)              { return __hip_atomic_load(p, __ATOMIC_RELAXED, __HIP_MEMORY_SCOPE_AGENT); }
__device__ __forceinline__ unsigned xb_add(unsigned* p, unsigned v) { return __hip_atomic_fetch_add(p, v, __ATOMIC_RELAXED, __HIP_MEMORY_SCOPE_AGENT); }
__device__ __forceinline__ unsigned xb_xcc_id() { return (unsigned)__builtin_amdgcn_s_getreg((3 << 11) | 20) & 0xFu; }
#define XB_SPIN(cond, bar) do { unsigned _sp = 0; while (cond) { __builtin_amdgcn_s_sleep(1); \
    if ((++_sp & 255u) == 0u) { if (xb_ld(&(bar)[XB_TMO])) break; if (_sp > XB_SPIN_CAP) { atomicAdd(&(bar)[XB_TMO], 1u); break; } } } } while (0)
struct XcdBarrier { unsigned* bar; unsigned x; volatile LAS unsigned* st; };
__device__ __forceinline__ XcdBarrier xcd_barrier_post(unsigned* bar, volatile LAS unsigned* st) {
    XcdBarrier b; b.bar = bar; b.x = xb_xcc_id(); b.st = st;
    if (threadIdx.x == 0) (void)xb_add(&bar[XB_XCNT(b.x)], 1u);
    return b;
}
__device__ __forceinline__ void xcd_barrier_complete(unsigned* bar, unsigned x, unsigned& nloc, unsigned& nx) {
    const unsigned G = gridDim.x * gridDim.y * gridDim.z;
    unsigned sum, cnt, mine, sp = 0u;
    for (;;) {
        sum = 0u; cnt = 0u; mine = 0u;
#pragma unroll
        for (unsigned j = 0; j < 16; ++j) { const unsigned c = xb_ld(&bar[XB_XCNT(j)]); sum += c; cnt += (c > 0u) ? 1u : 0u; mine = (j == x) ? c : mine; }
        if (sum == G) break;
        __builtin_amdgcn_s_sleep(1);
        if ((++sp & 255u) == 0u) { if (xb_ld(&bar[XB_TMO])) break; if (sp > XB_SPIN_CAP) { atomicAdd(&bar[XB_TMO], 1u); break; } }
    }
    nloc = mine > 0u ? mine : 1u; nx = cnt > 0u ? cnt : 1u;
}
__device__ __forceinline__ void xcd_barrier(const XcdBarrier& b) {
    asm volatile("s_waitcnt vmcnt(0)" ::: "memory");
    __syncthreads();
    if (threadIdx.x == 0) {
        unsigned* bar = b.bar;
        __builtin_amdgcn_s_waitcnt(0);
        unsigned nloc = b.st[0], nx = b.st[1];
        if (nloc == 0u) { xcd_barrier_complete(bar, b.x, nloc, nx); b.st[0] = nloc; b.st[1] = nx; }
        const unsigned old = xb_add(&bar[XB_XSUB(b.x)], 1u);
        const unsigned gen = old / nloc;
        if (old + 1u == (gen + 1u) * nloc) {
            __builtin_amdgcn_fence(__ATOMIC_RELEASE, "agent");
            asm volatile("s_waitcnt vmcnt(0)" ::: "memory");
            const unsigned og = xb_add(&bar[XB_TOP], 1u);
            const unsigned tg = og / nx;
            if (og + 1u == (tg + 1u) * nx) xb_add(&bar[XB_TOPGEN], 1u);
            else XB_SPIN(xb_ld(&bar[XB_TOPGEN]) == tg, bar);
            __builtin_amdgcn_fence(__ATOMIC_ACQUIRE, "agent");
            xb_add(&bar[XB_XGEN(b.x)], 1u);
            asm volatile("s_waitcnt vmcnt(0)" ::: "memory");
        } else {
            XB_SPIN(xb_ld(&bar[XB_XGEN(b.x)]) == gen, bar);
            __builtin_amdgcn_fence(__ATOMIC_ACQUIRE, "agent");
            asm volatile("s_waitcnt vmcnt(0)" ::: "memory");
        }
    }
    __syncthreads();
}

struct MoeOrder {
    const LAS int* ut; int K, Kb; size_t bstride; int numax;
    __device__ __forceinline__ bool next(int i, pg8::Unit& u) const {
        if (i >= numax) return false;
        const LAS int* p = ut + i * 8; const int nv = __builtin_amdgcn_readfirstlane(p[5]);
        if (nv < 0) return false;
        u.pm = __builtin_amdgcn_readfirstlane(p[0]); u.pn = __builtin_amdgcn_readfirstlane(p[1]); u.e = __builtin_amdgcn_readfirstlane(p[2]);
        u.bin = __builtin_amdgcn_readfirstlane(p[3]); u.rbase = __builtin_amdgcn_readfirstlane(p[4]); u.nvalid = nv; u.e2 = __builtin_amdgcn_readfirstlane(p[6]); return true;
    }
    __device__ __forceinline__ size_t a_off(const pg8::Unit& u) const { return (size_t)u.pm * (size_t)(512) * K; }
    __device__ __forceinline__ size_t b_off(const pg8::Unit& u) const { return (size_t)u.e * bstride + (size_t)u.pn * (size_t)(512) * Kb; }
    __device__ __forceinline__ size_t b_off2(const pg8::Unit& u) const { return (size_t)u.e2 * bstride + (size_t)u.pn * (size_t)(512) * Kb; }
};

template <class T> __device__ __forceinline__ T ldg(const void* base, unsigned byteoff) { return *(const T*)((const char*)base + byteoff); }
template <class T> __device__ __forceinline__ void stg_(void* base, unsigned byteoff, T v) { *(T*)((char*)base + byteoff) = v; }
#define EPI_FENCE() asm volatile("" ::: "memory")
constexpr int XT_C = 512, XT_D = XT_C + PW, XT_LASTPM = XT_D + PW;
struct EpiProj {
    static constexpr bool PERM = true, HAS_PRE = false; static constexpr int EPI_ID = 1, NSTORE = 16;
    bf16* O; const float* cvec; const float* dvec; const float* ST; float* RS; const float* CS; LAS float* xt;
    __device__ __forceinline__ void operator()(const f32x4 (&acc)[2][2][4][2], const pg8::Unit& u, int wr, int wc, int fr, int fq, int tid) const {
        const unsigned row0 = u.pm * 256 + wr * 64 + fr;
        const unsigned col0 = u.pn * 256 + wc * 32 + 8 * fq;
        const int seg = u.pn;
        LAS unsigned char* ldsb_ = (LAS unsigned char*)xt - TAB_OFF; (void)ldsb_;
        TS_DECL(); TS_BEGIN(201);
        f32x4 csA = (f32x4){1.f, 0.f, 1.f, 0.f}, csB = csA, wsA = csA, wsB = csA;
        if (seg < 4) { const unsigned t = row0 & (SEQ - 1), i0 = 16 * (wc & 1) + 4 * fq;
            csA = ldg<f32x4>(CS, (t * 32u + i0) * 8u); csB = ldg<f32x4>(CS, (t * 32u + i0) * 8u + 16u);
            wsA = ldg<f32x4>(CS, (16u * 32u + i0) * 8u); wsB = ldg<f32x4>(CS, (16u * 32u + i0) * 8u + 16u); }
        const int lastpm = ((const LAS int*)xt)[XT_LASTPM];
        if (lastpm != (int)u.pm) {
            if (tid < 256) {
                const unsigned row = u.pm * 256 + tid;
                f32x4 p[8];
#pragma unroll
                for (int j = 0; j < 8; ++j) p[j] = ldg<f32x4>(ST, row * 128u + 16u * j);
                float s = 0.f, q = 0.f;
#pragma unroll
                for (int j = 0; j < 8; ++j) { s += p[j][0] + p[j][2]; q += p[j][1] + p[j][3]; }
                const float mu = s * (1.f / 1024.f); const float var = q * (1.f / 1024.f) - mu * mu; const float rstd = fast_rsq(var + LN_EPS);
                stg_<f32x2>(RS, row * 8u, (f32x2){mu, rstd});
                *(LAS f32x2*)(xt + 2 * tid) = (f32x2){rstd, rstd * mu};
            }
            asm volatile("s_waitcnt lgkmcnt(0)" ::: "memory"); __builtin_amdgcn_s_barrier(); asm volatile("" ::: "memory");
            if (tid == 0) ((LAS int*)xt)[XT_LASTPM] = (int)u.pm;
        }
        TS_END(201, ldsb_, tid >> 6); TS_BEGIN(202);
        f32x4 cs0 = csA, cs1 = csB;
#pragma unroll
        for (int ai = 0; ai < 2; ++ai)
#pragma unroll
            for (int m = 0; m < 4; ++m) {
                const unsigned row = row0 + ai * 128 + m * 16;
                const f32x2 t2 = *(const LAS f32x2*)(xt + 2 * (wr * 64 + fr + ai * 128 + m * 16));
                const float rstd = t2.x, rsmu = t2.y;
#pragma unroll
                for (int bj = 0; bj < 2; ++bj) {
                    const int lc = col0 + bj * 128;
                    const f32x4 cv0 = *(const LAS f32x4*)(xt + XT_C + lc), cv1 = *(const LAS f32x4*)(xt + XT_C + lc + 4);
                    const f32x4 dv0 = *(const LAS f32x4*)(xt + XT_D + lc), dv1 = *(const LAS f32x4*)(xt + XT_D + lc + 4);
                    f32x4 v0 = acc[ai][bj][m][0] * rstd - cv0 * rsmu + dv0, v1 = acc[ai][bj][m][1] * rstd - cv1 * rsmu + dv1;
                    if (seg < 4) {
                        const float sc = (seg < 2) ? C2 : 1.0f;
                        f32x4 w0, w1;
                        w0[0] = (v0[0] * cs0[0] - v0[1] * cs0[1]) * sc; w0[1] = (v0[1] * cs0[0] + v0[0] * cs0[1]) * sc;
                        w0[2] = (v0[2] * cs0[2] - v0[3] * cs0[3]) * sc; w0[3] = (v0[3] * cs0[2] + v0[2] * cs0[3]) * sc;
                        w1[0] = (v1[0] * cs1[0] - v1[1] * cs1[1]) * sc; w1[1] = (v1[1] * cs1[0] + v1[0] * cs1[1]) * sc;
                        w1[2] = (v1[2] * cs1[2] - v1[3] * cs1[3]) * sc; w1[3] = (v1[3] * cs1[2] + v1[2] * cs1[3]) * sc;
                        v0 = w0; v1 = w1;
                    } else if (seg == 6 || seg == 7) {
#pragma unroll
                        for (int e = 0; e < 4; ++e) { v0[e] = gelu_t(v0[e]); v1[e] = gelu_t(v1[e]); }
                    }
                    if (seg >= 9) {
                        v2u w2; w2.x = pkbf(v0[0] * v0[1], v0[2] * v0[3]); w2.y = pkbf(v1[0] * v1[1], v1[2] * v1[3]);
                        stg_<v2u>(O, (row * (unsigned)PW + OGC + (seg - 9) * 128 + ((wc * 32 + 8 * fq + bj * 128) >> 1)) * 2u, w2);
                    } else {
                    v4u w; w.x = pkbf(v0[0], v0[1]); w.y = pkbf(v0[2], v0[3]); w.z = pkbf(v1[0], v1[1]); w.w = pkbf(v1[2], v1[3]);
                    stg_<v4u>(O, (row * (unsigned)PW + col0 + bj * 128) * 2u, w);
                    }
                }
                if (seg < 4) {
                    const int nstep = (ai == 0 && m == 3) ? 5 : 1;
#pragma unroll
                    for (int st = 0; st < nstep; ++st) {
                        f32x4 n0, n1;
                        n0[0] = cs0[0] * wsA[0] - cs0[1] * wsA[1]; n0[1] = cs0[1] * wsA[0] + cs0[0] * wsA[1]; n0[2] = cs0[2] * wsA[2] - cs0[3] * wsA[3]; n0[3] = cs0[3] * wsA[2] + cs0[2] * wsA[3];
                        n1[0] = cs1[0] * wsB[0] - cs1[1] * wsB[1]; n1[1] = cs1[1] * wsB[0] + cs1[0] * wsB[1]; n1[2] = cs1[2] * wsB[2] - cs1[3] * wsB[3]; n1[3] = cs1[3] * wsB[2] + cs1[2] * wsB[3];
                        cs0 = n0; cs1 = n1;
                    }
                }
                if (m == 3) EPI_FENCE();
            }
        TS_END(202, ldsb_, tid >> 6);
    }
};
struct EpiRes1 {
    static constexpr bool PERM = true, HAS_PRE = false; static constexpr int EPI_ID = 2, NSTORE = 16;
    bf16* S; const float* RS; const float* G; const float* Bv; bf16* Sout;
    __device__ __forceinline__ void operator()(const f32x4 (&acc)[2][2][4][2], const pg8::Unit& u, int wr, int wc, int fr, int fq, int tid) const {
        const unsigned row0 = u.pm * 256 + wr * 64 + fr;
        const unsigned col0 = u.pn * 256 + wc * 32 + 8 * fq;
        f32x2 st[2][4];
#pragma unroll
        for (int ai = 0; ai < 2; ++ai)
#pragma unroll
            for (int m = 0; m < 4; ++m) st[ai][m] = ldg<f32x2>(RS, (row0 + ai * 128 + m * 16) * 8u);
        f32x4 gv[2][2], bv[2][2];
#pragma unroll
        for (int bj = 0; bj < 2; ++bj) { gv[bj][0] = ldg<f32x4>(G, (col0 + bj * 128) * 4u); gv[bj][1] = ldg<f32x4>(G, (col0 + bj * 128) * 4u + 16u); bv[bj][0] = ldg<f32x4>(Bv, (col0 + bj * 128) * 4u); bv[bj][1] = ldg<f32x4>(Bv, (col0 + bj * 128) * 4u + 16u); }
        v4u o[2][4];
#pragma unroll
        for (int m = 0; m < 4; ++m) o[0][m] = ldg<v4u>(S, ((row0 + m * 16) * (unsigned)DM + col0) * 2u);
#pragma unroll
        for (int g = 0; g < 4; ++g) {
            const int bj = g >> 1, ai = g & 1;
            if (g < 3) { const int bjn = (g + 1) >> 1, ain = (g + 1) & 1;
#pragma unroll
                for (int m = 0; m < 4; ++m) o[(g + 1) & 1][m] = ldg<v4u>(S, ((row0 + ain * 128 + m * 16) * (unsigned)DM + col0 + bjn * 128) * 2u); }
            __builtin_amdgcn_sched_barrier(0);
#pragma unroll
            for (int m = 0; m < 4; ++m) {
                const unsigned off = ((row0 + ai * 128 + m * 16) * (unsigned)DM + col0 + bj * 128) * 2u;
                const v4u oo = o[g & 1][m];
                f32x4 x0 = (f32x4){bflo(oo.x), bfhi(oo.x), bflo(oo.y), bfhi(oo.y)}, x1 = (f32x4){bflo(oo.z), bfhi(oo.z), bflo(oo.w), bfhi(oo.w)};
                x0 = ((x0 - st[ai][m].x) * st[ai][m].y * gv[bj][0] + bv[bj][0]) * ALPHA + acc[ai][bj][m][0];
                x1 = ((x1 - st[ai][m].x) * st[ai][m].y * gv[bj][1] + bv[bj][1]) * ALPHA + acc[ai][bj][m][1];
                v4u w; w.x = pkbf(x0[0], x0[1]); w.y = pkbf(x0[2], x0[3]); w.z = pkbf(x1[0], x1[1]); w.w = pkbf(x1[2], x1[3]);
                stg_<v4u>(Sout, off, w);
            }
            __builtin_amdgcn_sched_barrier(0);
        }
    }
};
struct EpiSwiglu {
    static constexpr bool PERM = true, HAS_PRE = false; static constexpr int EPI_ID = 3, NSTORE = 0;
    bf16* H; const LAS int* dtab; const LAS float* gtab; const LAS int* tbP;
    __device__ __forceinline__ void operator()(const f32x4 (&acc)[2][2][4][2], const pg8::Unit& u, int wr, int wc, int fr, int fq, int tid) const {
        const unsigned lr0 = wr * 64 + fr;
        const unsigned col0 = u.pn * 256 + wc * 32 + 8 * fq;
#pragma unroll
        for (int ai = 0; ai < 2; ++ai)
#pragma unroll
            for (int m = 0; m < 4; ++m) {
                const unsigned lr = lr0 + ai * 128 + m * 16;
                const unsigned d = (unsigned)dtab[u.e2 * 256 + lr]; const float gate = gtab[u.e2 * 256 + lr];
                const bool valid = d != 0xffffffffu;
                const unsigned pb = valid ? (d >> 18) : 0u, pslot = (d >> 1) & 0x1ffffu, half = d & 1u;
                const unsigned prow = (unsigned)tbP[pb] * 256u + pslot;
#pragma unroll
                for (int bj = 0; bj < 2; ++bj) {
                    const f32x4 v0 = acc[ai][bj][m][0], v1 = acc[ai][bj][m][1];
                    v2u w; w.x = pkbf(gate * silu_f(v0[0]) * v0[1], gate * silu_f(v0[2]) * v0[3]); w.y = pkbf(gate * silu_f(v1[0]) * v1[1], gate * silu_f(v1[2]) * v1[3]);
                    if (valid) stg_<v2u>(H, (prow * 1024u + half * 512u + ((col0 + bj * 128) >> 1)) * 2u, w);
                }
            }
    }
};
struct EpiDown {
    static constexpr bool PERM = true, HAS_PRE = false; static constexpr int EPI_ID = 4, NSTORE = 0;
    bf16* S; const bf16* XN; const LAS unsigned short* ttab; float* ST;
    __device__ __forceinline__ void pre(f32x4 (&)[2][2][4][2], const pg8::Unit&, int, pg8::u32x4&, int, int, int, int) const {}
    __device__ __forceinline__ void operator()(const f32x4 (&acc)[2][2][4][2], const pg8::Unit& u, int wr, int wc, int fr, int fq, int tid) const {
        const unsigned lr0 = wr * 64 + fr;
        const unsigned col0 = u.pn * 256 + wc * 32 + 8 * fq;
        TS_DECL(); TS_BEGIN(211);
        unsigned tk[2][4]; v4u o[2][4][2];
#pragma unroll
        for (int ai = 0; ai < 2; ++ai)
#pragma unroll
            for (int m = 0; m < 4; ++m) { const unsigned lr = lr0 + ai * 128 + m * 16; const unsigned t16 = ttab[u.rbase * 256 + lr]; tk[ai][m] = ((int)lr < u.nvalid) ? t16 : 0xffffffffu; }
#pragma unroll
        for (int ai = 0; ai < 2; ++ai)
#pragma unroll
            for (int m = 0; m < 4; ++m) { const unsigned tok = (tk[ai][m] != 0xffffffffu) ? tk[ai][m] : 0u;
#pragma unroll
                for (int bj = 0; bj < 2; ++bj) o[ai][m][bj] = ldg<v4u>(XN, (tok * (unsigned)DM + col0 + bj * 128) * 2u); }
        TS_END(211, (LAS unsigned char*)ttab - TAB_OFF, tid >> 6); TS_BEGIN(212);
#pragma unroll
        for (int ai = 0; ai < 2; ++ai) {
#pragma unroll
            for (int m = 0; m < 4; ++m) {
                const bool valid = tk[ai][m] != 0xffffffffu;
                const unsigned tok = valid ? tk[ai][m] : 0u;
                float ssum = 0.f, ssq = 0.f;
#pragma unroll
                for (int bj = 0; bj < 2; ++bj) {
                    const v4u oo = o[ai][m][bj];
                    f32x4 x0 = (f32x4){bflo(oo.x), bfhi(oo.x), bflo(oo.y), bfhi(oo.y)}, x1 = (f32x4){bflo(oo.z), bfhi(oo.z), bflo(oo.w), bfhi(oo.w)};
                    x0 = x0 * ALPHA + acc[ai][bj][m][0]; x1 = x1 * ALPHA + acc[ai][bj][m][1];
                    v4u w; w.x = pkbf(x0[0], x0[1]); w.y = pkbf(x0[2], x0[3]); w.z = pkbf(x1[0], x1[1]); w.w = pkbf(x1[2], x1[3]);
                    if (valid) stg_<v4u>(S, (tok * (unsigned)DM + col0 + bj * 128) * 2u, w);
                    const f32x4 r0 = (f32x4){bflo(w.x), bfhi(w.x), bflo(w.y), bfhi(w.y)}, r1 = (f32x4){bflo(w.z), bfhi(w.z), bflo(w.w), bfhi(w.w)};
                    ssum += (r0[0] + r0[1]) + (r0[2] + r0[3]) + (r1[0] + r1[1]) + (r1[2] + r1[3]);
                    ssq += (r0[0] * r0[0] + r0[1] * r0[1]) + (r0[2] * r0[2] + r0[3] * r0[3]) + (r1[0] * r1[0] + r1[1] * r1[1]) + (r1[2] * r1[2] + r1[3] * r1[3]);
                }
                ssum = sum_x32(sum_x16(ssum)); ssq = sum_x32(sum_x16(ssq));
                if (valid && fq == 0) stg_<f32x2>(ST, ((tok * 16u + u.pn * 4 + wc) * 2u) * 4u, (f32x2){ssum, ssq});
            }
        }
        TS_END(212, (LAS unsigned char*)ttab - TAB_OFF, tid >> 6);
    }
};

struct ColId { __device__ __forceinline__ int operator()(int n) const { return n; } };
struct ColConv { __device__ __forceinline__ int operator()(int n) const { const int q = n - OGC; return ((q & 1) ? OH : OGC) + (q >> 1); } };
struct ColRope { __device__ __forceinline__ int operator()(int n) const { const int p = n & 63; return (n & ~63) + (p >> 1) + ((p & 1) << 5); } };
template <class CM>
__device__ __forceinline__ void conv_item(const float* W, int K, int ldw, CM cm, int n0, bf16* WT, int rstride, const float* scale, const float* biask, float* csum, float* dsum, LAS float* scr, int lane_, int kst = 0) {
    if (kst == 0) kst = K;
    int lane = lane_; asm volatile("" : "+v"(lane));
    const int col = cm(n0 + (lane & 31));
    float cs = 0.f, ds = 0.f;
    const float* wp = W + (size_t)(lane >> 5) * ldw + col;
    float w[32], wn[32];
#pragma unroll
    for (int i = 0; i < 32; ++i) w[i] = wp[(size_t)(2 * i) * ldw];
    for (int k0 = 0; k0 < K; k0 += 64) {
        if (k0 + 64 < K) {
#pragma unroll
            for (int i = 0; i < 32; ++i) wn[i] = wp[(size_t)(k0 + 64 + 2 * i) * ldw];
        }
#pragma unroll
        for (int i = 0; i < 32; ++i) { const int kk = k0 + 2 * i + (lane >> 5); const float sc = scale ? scale[kk] : 1.0f; const float bk = biask ? biask[kk] : 0.0f;
            const float v = rbf(w[i] * sc); cs += v; ds += bk * w[i]; scr[(2 * i + (lane >> 5)) * 33 + (lane & 31)] = v; }
        LDS_WAIT(); asm volatile("" ::: "memory");
        const int c = lane & 7;
#pragma unroll
        for (int j = 0; j < 4; ++j) { const int n = (lane >> 3) + 8 * j; const LAS float* s = scr + (8 * c) * 33 + n;
            v4u o; o.x = pkbf(s[0 * 33], s[1 * 33]); o.y = pkbf(s[2 * 33], s[3 * 33]); o.z = pkbf(s[4 * 33], s[5 * 33]); o.w = pkbf(s[6 * 33], s[7 * 33]);
            *(GAS v4u*)(WT + (size_t)(n * rstride) * kst + k0 + 8 * c) = o; }
        LDS_WAIT(); asm volatile("" ::: "memory");
#pragma unroll
        for (int i = 0; i < 32; ++i) w[i] = wn[i];
    }
    cs = sum_x32(cs); ds = sum_x32(ds);
    if (lane < 32) { if (csum) csum[lane * rstride] = cs; if (dsum) dsum[lane * rstride] = ds; }
}

constexpr int AT_KA = 0, AT_KB = 49152, AT_V = 98304, AT_WS = 147456, AT_END = AT_WS + 8 * 256;
__device__ __forceinline__ void glds16(const void* gsrc, unsigned lds_dst) { unsigned keep;
    asm volatile("s_mov_b32 %0, m0\n\ts_mov_b32 m0, %2\n\ts_nop 0\n\tglobal_load_lds_dwordx4 %1, off\n\ts_mov_b32 m0, %0" : "=&s"(keep) : "v"(gsrc), "s"(lds_dst) : "memory"); }
__device__ __forceinline__ int crow(int r, int hi) { return (r & 3) + 8 * (r >> 2) + 4 * hi; }
typedef short v4i16_t __attribute__((ext_vector_type(4)));
__device__ __forceinline__ s16x4 vtr(const LAS char* p) { return __builtin_bit_cast(s16x4, __builtin_amdgcn_ds_read_tr16_b64_v4i16((LAS v4i16_t*)p)); }
struct AUnit { int b, h, br, r, m0, d; };
__device__ __forceinline__ AUnit attn_decode(int U) { AUnit a; const int bh = U / 96, rem = U % 96; a.b = bh >> 3; a.h = bh & 7; a.br = rem >> 5; const int uidx = rem & 31; const int dsh = 2 * a.br; a.d = 1 << dsh; a.r = uidx & (a.d - 1); a.m0 = (uidx >> dsh) * 256; return a; }
__device__ __forceinline__ void glds16s(const void* sbase, unsigned voff, unsigned lds_dst) { unsigned keep;
    asm volatile("s_mov_b32 %0, m0\n\ts_mov_b32 m0, %3\n\ts_nop 0\n\tglobal_load_lds_dwordx4 %1, %2\n\ts_mov_b32 m0, %0" : "=&s"(keep) : "v"(voff), "s"(sbase), "s"(lds_dst) : "memory"); }
__device__ __forceinline__ void attn_issue_k(const bf16* proj, const AUnit& a, unsigned ldsK, int wid, int lane) {
    const int kk = lane >> 3, pc = lane & 7;
    const unsigned ubase = (((unsigned)a.b * SEQ + a.r) * PW + OKK + 64 * a.h) * 2u, rstep = (unsigned)a.d * PW * 2u;
#pragma unroll
    for (int i = 0; i < 6; ++i) {
        const int x = wid * 6 + i, T = x >> 2, q = x & 3;
        const int k = 8 * q + kk;
        int sidx = a.m0 - 128 + 32 * T + k; sidx = sidx < 0 ? 0 : sidx;
        const unsigned c = (unsigned)(pc ^ ((k >> 1) & 7));
        glds16s(proj, ubase + (unsigned)sidx * rstep + c * 16u, (unsigned)__builtin_amdgcn_readfirstlane(ldsK + T * 4096 + q * 1024));
    }
}
__device__ __forceinline__ void attn_issue_v(const bf16* proj, const AUnit& a, unsigned ldsV, int wid, int lane) {
    const unsigned ubase = (((unsigned)a.b * SEQ + a.r) * PW + OV + 64 * a.h + (lane & 3) * 8) * 2u, rstep = (unsigned)a.d * PW * 2u;
#pragma unroll
    for (int i = 0; i < 6; ++i) {
        const int x = wid * 6 + i, dh = x / 24, kg = x % 24;
        int sidx = a.m0 - 128 + 16 * kg + (lane >> 2); sidx = sidx < 0 ? 0 : sidx;
        glds16s(proj, ubase + (unsigned)sidx * rstep + dh * 64u, (unsigned)__builtin_amdgcn_readfirstlane(ldsV + dh * 24576 + kg * 1024));
    }
}
__device__ __forceinline__ void attn_load_q(const bf16* proj, const AUnit& a, bf16x8 (&qr)[4], int wid, int r32, int hi) {
    const unsigned off = ((((unsigned)a.b * SEQ + (unsigned)(a.m0 + 32 * wid + r32) * a.d + a.r) * PW) + OQ + 64 * a.h + 8 * hi) * 2u;
    asm volatile("global_load_dwordx4 %0, %4, %5\n\tglobal_load_dwordx4 %1, %4, %5 offset:32\n\tglobal_load_dwordx4 %2, %4, %5 offset:64\n\tglobal_load_dwordx4 %3, %4, %5 offset:96"
                 : "=&v"(qr[0]), "=&v"(qr[1]), "=&v"(qr[2]), "=&v"(qr[3]) : "v"(off), "s"(proj) : "memory");
}

__device__ __forceinline__ void attn_phase(const bf16* proj, bf16* part, float* ML, int vcu, int G, LAS unsigned char* lds, int wave_s) {
    int lane = pg8::lane_id_v(); const int wid = wave_s; int r32 = lane & 31, hi = lane >> 5;
    const unsigned lds0 = (unsigned)(uintptr_t)lds;
    constexpr int NUNITS = 8 * 8 * 96;
    int U = vcu;
    if (U >= NUNITS) return;
    AUnit cur = attn_decode(U);
    bf16x8 qr[4];
    attn_issue_k(proj, cur, lds0 + AT_KA, wid, lane);
    attn_load_q(proj, cur, qr, wid, r32, hi);
    attn_issue_v(proj, cur, lds0 + AT_V, wid, lane);
    f32x16 bias0, bias4;
#pragma unroll
    for (int rg = 0; rg < 16; ++rg) { const int c = crow(rg, hi); bias0[rg] = (c < r32) ? -1e30f : 0.f; bias4[rg] = (c > r32) ? -1e30f : 0.f; }
    int kb = 0; bool first = true;
    for (;;) {
        const int Un = U + G; const bool has_next = Un < NUNITS;
        AUnit nxt = cur; if (has_next) nxt = attn_decode(Un);
        const int koff = kb ? AT_KB : AT_KA, koff_n = kb ? AT_KA : AT_KB;
        asm volatile("" : "+v"(lane)); r32 = lane & 31; hi = lane >> 5;
        TS_DECL();
        TS_BEGIN(1);
        if (first) asm volatile("s_waitcnt vmcnt(6)\n\ts_barrier" ::: "memory"); else asm volatile("s_waitcnt vmcnt(11)\n\ts_barrier" ::: "memory");
        TS_END(1, lds, wid);
        asm volatile("" : "+v"(qr[0]), "+v"(qr[1]), "+v"(qr[2]), "+v"(qr[3]));
        TS_BEGIN(2); if (has_next) attn_issue_k(proj, nxt, lds0 + koff_n, wid, lane); TS_END(2, lds, wid);
        f32x16 p[5];
        TS_BEGIN(3);
#if defined(REP_MASK) && ((REP_MASK >> 12) & 1)
        for (int rr_ = 0; rr_ < 2; ++rr_)
#endif
        {
            const LAS unsigned char* kb0 = lds + koff + wid * 4096 + r32 * 128;
            const int sw = (r32 >> 1) & 7;
            int ko[4];
#pragma unroll
            for (int d0 = 0; d0 < 4; ++d0) ko[d0] = ((2 * d0 + hi) ^ sw) * 16;
            bf16x8 kf[2][4];
#pragma unroll
            for (int d0 = 0; d0 < 4; ++d0) kf[0][d0] = *(const LAS bf16x8*)(kb0 + ko[d0]);
#pragma unroll
            for (int j = 0; j < 5; ++j) {
                if (j < 4) {
#pragma unroll
                    for (int d0 = 0; d0 < 4; ++d0) kf[(j + 1) & 1][d0] = *(const LAS bf16x8*)(kb0 + (j + 1) * 4096 + ko[d0]);
                }
                f32x16 a = (j == 0) ? bias0 : ((j == 4) ? bias4 : f32x16{});
#pragma unroll
                for (int d0 = 0; d0 < 4; ++d0) a = __builtin_amdgcn_mfma_f32_32x32x16_bf16(kf[j & 1][d0], qr[d0], a, 0, 0, 0);
                p[j] = a;
                __builtin_amdgcn_sched_barrier(0);
            }
        }
        asm volatile("" : "+v"(p[4]));
        TS_END(3, lds, wid);
        asm volatile("" ::: "memory");
        if (has_next) attn_load_q(proj, nxt, qr, wid, r32, hi);
        TS_BEGIN(4);
        if (cur.m0 == 0) {
            asm volatile("; first-block mask" ::: "memory");
            const int kfirst = 128 - 32 * wid;
#pragma unroll
            for (int j = 0; j < 5; ++j)
#pragma unroll
                for (int rg = 0; rg < 16; ++rg) if (32 * j + crow(rg, hi) < kfirst) p[j][rg] = -1e30f;
        }
        float mx = p[0][0];
#pragma unroll
        for (int j = 0; j < 5; ++j)
#pragma unroll
            for (int rg = 0; rg < 16; ++rg) mx = fmaxf(mx, p[j][rg]);
        mx = max_x32(mx);
        f32x2 l2 = (f32x2){0.f, 0.f};
#pragma unroll
        for (int j = 0; j < 5; ++j)
#pragma unroll
            for (int rg = 0; rg < 16; rg += 2) { const f32x2 dd = (f32x2){p[j][rg], p[j][rg + 1]} - mx; const f32x2 ee = (f32x2){fast_exp2(dd.x), fast_exp2(dd.y)}; p[j][rg] = ee.x; p[j][rg + 1] = ee.y; l2 += ee; }
        float l = l2.x + l2.y;
        l = sum_x32(l);
        asm volatile("" : "+v"(l)); TS_END(4, lds, wid); TS_BEGIN(5);
        if (has_next) asm volatile("s_waitcnt vmcnt(10) lgkmcnt(0)\n\ts_barrier" ::: "memory"); else asm volatile("s_waitcnt vmcnt(0) lgkmcnt(0)\n\ts_barrier" ::: "memory");
        first = false;
        TS_END(5, lds, wid); TS_BEGIN(6);
        f32x16 o[2];
        const LAS char* vp0 = (const LAS char*)lds + AT_V + ((lane >> 4) & 1) * 32 + (lane & 3) * 8 + (4 * hi + ((lane & 15) >> 2)) * 64;
#if defined(REP_MASK) && ((REP_MASK >> 13) & 1)
        for (int rr_ = 0; rr_ < 2; ++rr_)
#endif
        {
            o[0] = f32x16{}; o[1] = f32x16{};
            s16x4 vl[2][2], vh[2][2];
            const LAS char* vpw = vp0 + (32 * wid) * 64;
#pragma unroll
            for (int dh = 0; dh < 2; ++dh) { vl[0][dh] = vtr(vpw + dh * 24576); vh[0][dh] = vtr(vpw + dh * 24576 + 512); }
#pragma unroll
            for (int st = 0; st < 10; ++st) {
                const int j = st >> 1, s = st & 1;
                if (st < 9) {
#pragma unroll
                    for (int dh = 0; dh < 2; ++dh) { vl[(st + 1) & 1][dh] = vtr(vpw + dh * 24576 + (st + 1) * 1024); vh[(st + 1) & 1][dh] = vtr(vpw + dh * 24576 + (st + 1) * 1024 + 512); }
                }
                v4u pw; pw.x = pkbf(p[j][8 * s + 0], p[j][8 * s + 1]); pw.y = pkbf(p[j][8 * s + 2], p[j][8 * s + 3]); pw.z = pkbf(p[j][8 * s + 4], p[j][8 * s + 5]); pw.w = pkbf(p[j][8 * s + 6], p[j][8 * s + 7]);
                const bf16x8 pa = __builtin_bit_cast(bf16x8, pw);
#pragma unroll
                for (int dh = 0; dh < 2; ++dh) {
                    const s16x4 lo = vl[st & 1][dh], hv = vh[st & 1][dh];
                    const bf16x8 vf = (bf16x8){lo[0], lo[1], lo[2], lo[3], hv[0], hv[1], hv[2], hv[3]};
                    o[dh] = __builtin_amdgcn_mfma_f32_32x32x16_bf16(vf, pa, o[dh], 0, 0, 0);
                }
                __builtin_amdgcn_sched_barrier(0);
            }
        }
        asm volatile("" : "+v"(o[0]), "+v"(o[1])); TS_END(6, lds, wid); TS_BEGIN(7);
        asm volatile("s_waitcnt lgkmcnt(0)\n\ts_barrier" ::: "memory");
        TS_END(7, lds, wid); TS_BEGIN(8);
        const size_t rowbase = (size_t)cur.b * SEQ;
        const size_t qtok = rowbase + (size_t)(cur.m0 + 32 * wid + r32) * cur.d + cur.r;
        if (hi == 0) *(GAS f32x2*)((GAS char*)ML + ((((size_t)cur.br * NTOK + qtok) * 8 + cur.h) * 2) * 4) = (f32x2){mx, l};
        const float rl = fast_rcp(l);
        LAS unsigned char* stg = lds + koff + wid * 4608;
#if defined(REP_MASK) && ((REP_MASK >> 14) & 1)
        for (int rr_ = 0; rr_ < 2; ++rr_) {
#else
        {
#endif
#pragma unroll
        for (int dh = 0; dh < 2; ++dh)
#pragma unroll
            for (int g4 = 0; g4 < 4; ++g4) { v2u w; w.x = pkbf(o[dh][4 * g4 + 0] * rl, o[dh][4 * g4 + 1] * rl); w.y = pkbf(o[dh][4 * g4 + 2] * rl, o[dh][4 * g4 + 3] * rl);
                *(LAS v2u*)(stg + r32 * 144 + (32 * dh + 8 * g4 + 4 * hi) * 2) = w; }
        LDS_WAIT();
#pragma unroll
        for (int i = 0; i < 4; ++i) { const int row = i * 8 + (lane >> 3), ch = lane & 7; const v4u v = *(const LAS v4u*)(stg + row * 144 + ch * 16);
            const size_t ot = rowbase + (size_t)(cur.m0 + 32 * wid + row) * cur.d + cur.r;
            *(GAS v4u*)((GAS char*)part + (((size_t)cur.br * NTOK + ot) * 512 + 64 * cur.h + ch * 8) * 2) = v; }
        }
        if (has_next) attn_issue_v(proj, nxt, lds0 + AT_V, wid, lane);
        TS_END(8, lds, wid); TS_BEGIN(9);
        asm volatile("s_waitcnt lgkmcnt(0)\n\ts_barrier" ::: "memory");
        TS_END(9, lds, wid);
        if (!has_next) break;
        cur = nxt; U = Un; kb ^= 1;
    }
}

constexpr int SG_ZT = 0, SG_ZT_STRIDE = 136  , SG_YT = 4 * 64 * SG_ZT_STRIDE * 2  , SG_END = SG_YT + 128 * 256 * 2;
static_assert(SG_END <= MISC_OFF, "sgu LDS");
static_assert(AT_END <= MISC_OFF, "attention LDS");
__device__ __forceinline__ void sgu_unit(const bf16* proj, bf16* mixed, const bf16* WS, const float* sgain, const float* sbias, int chunk, LAS unsigned char* lds, int wave_s) {
    const int lane = pg8::lane_id_v(), wid = wave_s, tid = wid * 64 + lane, r32 = lane & 31, hi = lane >> 5;
    const size_t tok0 = (size_t)chunk * 128;
    LAS bf16* znT = (LAS bf16*)(lds + SG_ZT);
    LAS bf16* yt = (LAS bf16*)(lds + SG_YT);
    TS_DECL(); TS_BEGIN(311);
    const int pce = tid & 31, g1 = pce >> 3, c1 = (pce & 7) * 8;
    f32x4 ga0 = *(const f32x4*)(sgain + g1 * 64 + c1), ga1 = *(const f32x4*)(sgain + g1 * 64 + c1 + 4);
    {
        v4u uvb[8], zvb[8];
#pragma unroll
        for (int it = 0; it < 8; ++it) { const bf16* rowp = proj + (tok0 + it * 16 + (tid >> 5)) * PW; uvb[it] = *(const v4u*)(rowp + OU + 8 * pce); zvb[it] = *(const v4u*)(rowp + OZ + 8 * pce); }
#pragma unroll
        for (int it = 0; it < 8; ++it) {
            const int t = it * 16 + (tid >> 5);
            *(LAS v4u*)(yt + t * 256 + 8 * pce) = uvb[it];
            const v4u zv = zvb[it];
            float z[8] = {bflo(zv.x), bfhi(zv.x), bflo(zv.y), bfhi(zv.y), bflo(zv.z), bfhi(zv.z), bflo(zv.w), bfhi(zv.w)};
            float s = 0.f;
#pragma unroll
            for (int e = 0; e < 8; ++e) s += z[e];
            s = sum_q4(sum_x2(sum_x1(s)));
            const float mean = s * (1.f / 64.f);
            float q = 0.f;
#pragma unroll
            for (int e = 0; e < 8; ++e) { z[e] -= mean; q += z[e] * z[e]; }
            q = sum_q4(sum_x2(sum_x1(q)));
            const float rstd = fast_rsq(q * (1.f / 64.f) + LN_EPS);
            v4u zw; zw.x = pkbf(z[0] * rstd * ga0[0], z[1] * rstd * ga0[1]); zw.y = pkbf(z[2] * rstd * ga0[2], z[3] * rstd * ga0[3]); zw.z = pkbf(z[4] * rstd * ga1[0], z[5] * rstd * ga1[1]); zw.w = pkbf(z[6] * rstd * ga1[2], z[7] * rstd * ga1[3]);
            *(LAS v4u*)((LAS unsigned char*)znT + ((g1 * 2 + (c1 >> 5)) * 128 + t) * 64 + (c1 & 31) * 2) = zw;
        }
    }
    __syncthreads();
    TS_END(311, lds, wid); TS_BEGIN(312);
    {
        const int g = wid >> 1, ct = wid & 1;
        const bf16* wg_ = WS + (size_t)g * 128 * 128;
        const LAS char* zb = (const LAS char*)znT + ((g * 2 + ct) * 128 + 4 * hi + ((lane & 15) >> 2)) * 64 + ((lane >> 4) & 1) * 32 + (lane & 3) * 8;
#pragma unroll
        for (int tt = 0; tt < 4; ++tt) {
            f32x16 a = {};
            bf16x8 af[8];
#pragma unroll
            for (int ks = 0; ks < 2 * (tt + 1); ++ks) af[ks] = *(const bf16x8*)(wg_ + (size_t)(32 * tt + r32) * 128 + 16 * ks + 8 * hi);
            f32x4 bb[4];
#pragma unroll
            for (int q4 = 0; q4 < 4; ++q4) bb[q4] = *(const f32x4*)(sbias + g * 128 + 32 * tt + 8 * q4 + 4 * hi);
#pragma unroll
            for (int ks = 0; ks < 2 * (tt + 1); ++ks) {
                const s16x4 lo = vtr(zb + ks * 1024), hv = vtr(zb + ks * 1024 + 512);
                const bf16x8 bfr = (bf16x8){lo[0], lo[1], lo[2], lo[3], hv[0], hv[1], hv[2], hv[3]};
                a = __builtin_amdgcn_mfma_f32_32x32x16_bf16(af[ks], bfr, a, 0, 0, 0);
            }
#pragma unroll
            for (int rg = 0; rg < 16; ++rg) { const int t = 32 * tt + crow(rg, hi); LAS bf16* yp = yt + t * 256 + 64 * g + 32 * ct + r32;
                const float uval = bf2f(*yp); const float y = uval * (a[rg] + bb[rg >> 2][rg & 3]); *yp = (bf16)(pkbf(y, 0.f) & 0xffffu); }
        }
    }
    __syncthreads();
    TS_END(312, lds, wid); TS_BEGIN(313);
#pragma unroll 1
    for (int i = 0; i < 16; i += 4) {
        float y[4][4], ss[4];
#pragma unroll
        for (int b = 0; b < 4; ++b) { const int t = wid * 16 + i + b; const v2u yv = *(const LAS v2u*)(yt + t * 256 + 4 * lane);
            y[b][0] = bflo(yv.x); y[b][1] = bfhi(yv.x); y[b][2] = bflo(yv.y); y[b][3] = bfhi(yv.y);
            ss[b] = (y[b][0] * y[b][0] + y[b][1] * y[b][1]) + (y[b][2] * y[b][2] + y[b][3] * y[b][3]); }
#pragma unroll
        for (int b = 0; b < 4; ++b) ss[b] = wave_sum(ss[b]);
#pragma unroll
        for (int b = 0; b < 4; ++b) { const int t = wid * 16 + i + b; const float rs = fast_rsq(ss[b] * (1.f / 256.f) + LN_EPS);
            v2u w; w.x = pkbf(y[b][0] * rs, y[b][1] * rs); w.y = pkbf(y[b][2] * rs, y[b][3] * rs);
            *(v2u*)(mixed + (tok0 + t) * DM + 512 + 4 * lane) = w; }
    }
    __syncthreads();
    TS_END(313, lds, wid);
}
struct Args { const float* in[17]; float* out; unsigned char* ws; int ph_lo, ph_hi, nlayers, pad; };

template <int NB>
__device__ __forceinline__ void combine_tokens(const bf16* part, const float* ML, bf16* mixed, size_t tok0, size_t tstride, int lane) {
    const int head = lane >> 3;
    f32x2 ml[NB][3]; v4u pv[NB][3];
#pragma unroll
    for (int b = 0; b < NB; ++b) { const size_t tok = tok0 + b * tstride;
#pragma unroll
        for (int br = 0; br < 3; ++br) { ml[b][br] = *(const f32x2*)(ML + (((size_t)br * NTOK + tok) * 8 + head) * 2); pv[b][br] = *(const v4u*)(part + ((size_t)br * NTOK + tok) * 512 + 8 * lane); } }
    float o[NB][8], ss[NB];
#pragma unroll
    for (int b = 0; b < NB; ++b) {
        const float M = fmaxf(ml[b][0].x, fmaxf(ml[b][1].x, ml[b][2].x));
        float w[3], W = 0.f;
#pragma unroll
        for (int br = 0; br < 3; ++br) { w[br] = ml[b][br].y * fast_exp2(ml[b][br].x - M); W += w[br]; }
        const float rW = 1.0f / W;
#pragma unroll
        for (int e = 0; e < 8; ++e) o[b][e] = 0.f;
#pragma unroll
        for (int br = 0; br < 3; ++br) { const float ww = w[br] * rW; const v4u p = pv[b][br];
            o[b][0] += ww * bflo(p.x); o[b][1] += ww * bfhi(p.x); o[b][2] += ww * bflo(p.y); o[b][3] += ww * bfhi(p.y);
            o[b][4] += ww * bflo(p.z); o[b][5] += ww * bfhi(p.z); o[b][6] += ww * bflo(p.w); o[b][7] += ww * bfhi(p.w); }
        float s = 0.f;
#pragma unroll
        for (int e = 0; e < 8; ++e) s += o[b][e] * o[b][e];
        ss[b] = s;
    }
#pragma unroll
    for (int b = 0; b < NB; ++b) ss[b] = wave_sum(ss[b]);
#pragma unroll
    for (int b = 0; b < NB; ++b) {
        const float rs = fast_rsq(ss[b] * (1.f / 512.f) + LN_EPS);
        v4u ov; ov.x = pkbf(o[b][0] * rs, o[b][1] * rs); ov.y = pkbf(o[b][2] * rs, o[b][3] * rs); ov.z = pkbf(o[b][4] * rs, o[b][5] * rs); ov.w = pkbf(o[b][6] * rs, o[b][7] * rs);
        *(v4u*)(mixed + (tok0 + b * tstride) * DM + 8 * lane) = ov;
    }
}
template <int NB>
__device__ __forceinline__ void conv_tokens(const bf16* proj, const float* cw, bf16* mixed, size_t tok0, size_t tstride, int lane) {
    const f32x4 w0 = *(const f32x4*)(cw + 4 * lane), w1 = *(const f32x4*)(cw + 256 + 4 * lane), w2 = *(const f32x4*)(cw + 512 + 4 * lane);
    v2u zz[NB][3], gb[NB];
#pragma unroll
    for (int b = 0; b < NB; ++b) { const size_t tok = tok0 + b * tstride; const int t = (int)(tok & (SEQ - 1));
#pragma unroll
        for (int j = 0; j < 3; ++j) { zz[b][j] = (v2u){0u, 0u};
            if (t - 2 + j >= 0) zz[b][j] = *(const v2u*)(proj + (tok - 2 + j) * PW + OGC + 4 * lane); }
        gb[b] = *(const v2u*)(proj + tok * PW + OGB + 4 * lane); }
    f32x4 y[NB]; float ss[NB];
#pragma unroll
    for (int b = 0; b < NB; ++b) {
        f32x4 acc = (f32x4){0.f, 0.f, 0.f, 0.f};
#pragma unroll
        for (int j = 0; j < 3; ++j) { const v2u g = zz[b][j];
            const f32x4 z = (f32x4){bflo(g.x), bfhi(g.x), bflo(g.y), bfhi(g.y)};
            acc += z * (j == 0 ? w0 : (j == 1 ? w1 : w2)); }
        y[b] = (f32x4){bflo(gb[b].x), bfhi(gb[b].x), bflo(gb[b].y), bfhi(gb[b].y)} * acc;
        ss[b] = (y[b][0] * y[b][0] + y[b][1] * y[b][1]) + (y[b][2] * y[b][2] + y[b][3] * y[b][3]);
    }
#pragma unroll
    for (int b = 0; b < NB; ++b) ss[b] = wave_sum(ss[b]);
#pragma unroll
    for (int b = 0; b < NB; ++b) {
        const float rs = fast_rsq(ss[b] * (1.f / 256.f) + LN_EPS);
        v2u w; w.x = pkbf(y[b][0] * rs, y[b][1] * rs); w.y = pkbf(y[b][2] * rs, y[b][3] * rs);
        *(v2u*)(mixed + (tok0 + b * tstride) * DM + 768 + 4 * lane) = w;
    }
}

struct RSel { int e0, e1, pbin; unsigned half0, r0, r1, rp; float g0, g1; bool own; };
__device__ __forceinline__ void route_block(const bf16* S, const bf16* Wrt  , const float* cr, const float* dr, const float* g1v, const float* b1v, bf16* XN, int* ELIST, int* EDEST, float* EGATE, int* PLIST, gu32* cnt  ,
                                            int blk, LAS unsigned char* lds, int wave_s) {
    const int lane = pg8::lane_id_v(), wid = wave_s, tid = wid * 64 + lane, t16 = lane & 15, q4 = lane >> 4;
    LAS unsigned* hist = (LAS unsigned*)(lds + TB_OFF) + TB_HIST;
    LAS unsigned* base = (LAS unsigned*)(lds + TB_OFF) + TB_BASE;
    if (tid < NCNT) hist[tid] = 0u;
    const unsigned tokA = (unsigned)blk * 256u + 32u * wid + t16, tokB = tokA + 16u;
    const bf16* srA = S + (size_t)tokA * DM + 8 * q4; const bf16* srB = S + (size_t)tokB * DM + 8 * q4;
    v4u ra[32], rb[32];
#pragma unroll
    for (int s = 0; s < 32; ++s) ra[s] = *(const v4u*)(srA + 32 * s);
    LAS float* gbl = (LAS float*)(lds + RING_OFF);
    { const f32x4 gq = *(const f32x4*)(((tid < 256) ? g1v : b1v) + 4 * (tid & 255)); *(LAS f32x4*)(gbl + 4 * tid) = gq; }
    LAS unsigned char* wl = lds + RING_OFF + 8192;
#pragma unroll
    for (int i = 0; i < 9; ++i) { const int pc = tid + 512 * i, p = pc >> 7, c16 = pc & 127;
        const int src = (p < 16) ? (8 * (p >> 2) + (p & 3)) : ((p < 32) ? (8 * ((p - 16) >> 2) + 4 + (p & 3)) : p);
        *(LAS v4u*)(wl + p * 2064 + c16 * 16) = *(const v4u*)(Wrt + (size_t)src * DM + c16 * 8); }
    __syncthreads();
    const LAS unsigned char* wa0 = wl + t16 * 2064 + 16 * q4; const LAS unsigned char* wa1 = wa0 + 16 * 2064; const LAS unsigned char* wa2 = wl + (32 + (t16 & 3)) * 2064 + 16 * q4;

#define RT_MM(r_, c0_, c1_, c2_, mu_, rstd_)                                                                                                                   \
    f32x4 c0_ = (f32x4){0.f, 0.f, 0.f, 0.f}, c1_ = c0_, c2_ = c0_; float mu_, rstd_;                                                                            \
    {   float ssum = 0.f, ssq = 0.f;                                                                                                                            \
        _Pragma("unroll") for (int s4 = 0; s4 < 32; s4 += 4) {                                                                                                  \
            bf16x8 A0[4], A1[4], A2[4];                                                                                                                         \
            _Pragma("unroll") for (int q = 0; q < 4; ++q) { A0[q] = *(const LAS bf16x8*)(wa0 + 64 * (s4 + q)); A1[q] = *(const LAS bf16x8*)(wa1 + 64 * (s4 + q)); A2[q] = *(const LAS bf16x8*)(wa2 + 64 * (s4 + q)); } \
            _Pragma("unroll") for (int q = 0; q < 4; ++q) { const v4u x = r_[s4 + q]; const bf16x8 bfr = __builtin_bit_cast(bf16x8, x);                        \
                c0_ = __builtin_amdgcn_mfma_f32_16x16x32_bf16(A0[q], bfr, c0_, 0, 0, 0);                                                                        \
                c1_ = __builtin_amdgcn_mfma_f32_16x16x32_bf16(A1[q], bfr, c1_, 0, 0, 0);                                                                        \
                c2_ = __builtin_amdgcn_mfma_f32_16x16x32_bf16(A2[q], bfr, c2_, 0, 0, 0);                                                                        \
                const float x0 = bflo(x.x), x1 = bfhi(x.x), x2 = bflo(x.y), x3 = bfhi(x.y), x4 = bflo(x.z), x5 = bfhi(x.z), x6 = bflo(x.w), x7 = bfhi(x.w);     \
                ssum += ((x0 + x1) + (x2 + x3)) + ((x4 + x5) + (x6 + x7));                                                                                      \
                ssq += ((x0 * x0 + x1 * x1) + (x2 * x2 + x3 * x3)) + ((x4 * x4 + x5 * x5) + (x6 * x6 + x7 * x7)); }                                             \
        }                                                                                                                                                       \
        ssum = sum_x32(sum_x16(ssum)); ssq = sum_x32(sum_x16(ssq));                                                                                             \
        mu_ = ssum * (1.f / 1024.f); const float var = ssq * (1.f / 1024.f) - mu_ * mu_; rstd_ = fast_rsq(var + LN_EPS); }

#define RT_SEL(sel_, c0_, c1_, c2_, mu_, rstd_)                                                                                                                 \
    RSel sel_;                                                                                                                                                  \
    {   const float rsmu = rstd_ * mu_;                                                                                                                         \
        const f32x4 crA = *(const f32x4*)(cr + 8 * q4), crB = *(const f32x4*)(cr + 8 * q4 + 4), drA = *(const f32x4*)(dr + 8 * q4), drB = *(const f32x4*)(dr + 8 * q4 + 4); \
        const f32x4 crG = *(const f32x4*)(cr + 32), drG = *(const f32x4*)(dr + 32);                                                                             \
        const f32x4 gl = rstd_ * c2_ - rsmu * crG + drG;                                                                                                        \
        float gmax = gl[0]; int gi = 0;                                                                                                                         \
        if (gl[1] > gmax) { gmax = gl[1]; gi = 1; }                                                                                                             \
        if (gl[2] > gmax) { gmax = gl[2]; gi = 2; }                                                                                                             \
        if (gl[3] > gmax) { gmax = gl[3]; gi = 3; }                                                                                                             \
        const float gp = 1.0f / (expf(gl[0] - gmax) + expf(gl[1] - gmax) + expf(gl[2] - gmax) + expf(gl[3] - gmax));                                            \
        const f32x4 ea = rstd_ * c0_ - rsmu * crA + drA, eb = rstd_ * c1_ - rsmu * crB + drB;                                                                   \
        float v0 = -INFINITY, v1 = -INFINITY; int i0 = 0, i1 = 0;                                                                                               \
        _Pragma("unroll") for (int j = 0; j < 8; ++j) { const float v = (j < 4) ? ea[j & 3] : eb[j & 3];                                                        \
            if (v > v0) { v1 = v0; i1 = i0; v0 = v; i0 = j; } else if (v > v1) { v1 = v; i1 = j; } }                                                            \
        const float e1 = expf(v1 - v0);                                                                                                                         \
        sel_.g0 = gp / (1.0f + e1); sel_.g1 = gp * e1 / (1.0f + e1);                                                                                            \
        sel_.e0 = gi * 8 + i0; sel_.e1 = gi * 8 + i1;                                                                                                           \
        const int ia = i0 < i1 ? i0 : i1, ib = i0 < i1 ? i1 : i0;                                                                                               \
        sel_.pbin = gi * 28 + ((ia * (15 - ia)) >> 1) + (ib - ia - 1);                                                                                          \
        sel_.half0 = (i0 < i1) ? 0u : 1u;                                                                                                                       \
        sel_.own = (q4 == gi); sel_.r0 = 0u; sel_.r1 = 0u; sel_.rp = 0u;                                                                                        \
        if (sel_.own) { sel_.r0 = __hip_atomic_fetch_add(hist + sel_.e0, 1u, __ATOMIC_RELAXED, __HIP_MEMORY_SCOPE_WORKGROUP); sel_.r1 = __hip_atomic_fetch_add(hist + sel_.e1, 1u, __ATOMIC_RELAXED, __HIP_MEMORY_SCOPE_WORKGROUP); \
                        sel_.rp = __hip_atomic_fetch_add(hist + NEB + sel_.pbin, 1u, __ATOMIC_RELAXED, __HIP_MEMORY_SCOPE_WORKGROUP); } }

#define RT_NORM(r_, xrow_, mu_, rstd_, PREF_)                                                                                                                   \
    _Pragma("unroll") for (int s = 0; s < 32; ++s) { v4u x = r_[s]; asm volatile("" : "+v"(x));        \
        const f32x4 ga = *(const LAS f32x4*)(gbl + 32 * s + 8 * q4), gb = *(const LAS f32x4*)(gbl + 32 * s + 8 * q4 + 4), ba = *(const LAS f32x4*)(gbl + 1024 + 32 * s + 8 * q4), bb = *(const LAS f32x4*)(gbl + 1024 + 32 * s + 8 * q4 + 4); \
        f32x4 x0 = (f32x4){bflo(x.x), bfhi(x.x), bflo(x.y), bfhi(x.y)}, x1 = (f32x4){bflo(x.z), bfhi(x.z), bflo(x.w), bfhi(x.w)};                               \
        x0 = (x0 - mu_) * rstd_ * ga + ba; x1 = (x1 - mu_) * rstd_ * gb + bb;                                                                                   \
        v4u w; w.x = pkbf(x0[0], x0[1]); w.y = pkbf(x0[2], x0[3]); w.z = pkbf(x1[0], x1[1]); w.w = pkbf(x1[2], x1[3]);                                          \
        *(v4u*)(xrow_ + 32 * s) = w;                                                                                                                            \
        PREF_                                                                                                                                                   \
        if ((s & 3) == 3) __builtin_amdgcn_sched_barrier(0); }

    RT_MM(ra, a0, a1, a2, muA, rstdA)
    { bf16* xrA = XN + (size_t)tokA * DM + 8 * q4;
      RT_NORM(ra, xrA, muA, rstdA, rb[s] = *(const v4u*)(srB + 32 * s);) }
    RT_SEL(selA, a0, a1, a2, muA, rstdA)
    RT_MM(rb, b0, b1, b2, muB, rstdB)
    RT_SEL(selB, b0, b1, b2, muB, rstdB)
    __syncthreads();
    unsigned gbase = 0u;
    if (tid < NCNT) gbase = __hip_atomic_fetch_add(cnt + tid, hist[tid], RLX_AGENT);
    { bf16* xrB = XN + (size_t)tokB * DM + 8 * q4;
      RT_NORM(rb, xrB, muB, rstdB, ;) }
#undef RT_MM
#undef RT_SEL
#undef RT_NORM
    if (tid < NCNT) base[tid] = gbase;
    __syncthreads();
#pragma unroll
    for (int g = 0; g < 2; ++g) { const RSel& sl = g ? selB : selA; const unsigned tok = g ? tokB : tokA;
        if (sl.own) {
            const unsigned ps = base[NEB + sl.pbin] + sl.rp;
            PLIST[(size_t)sl.pbin * NTOK + ps] = (int)tok;
            const size_t s0 = (size_t)sl.e0 * NTOK + base[sl.e0] + sl.r0, s1 = (size_t)sl.e1 * NTOK + base[sl.e1] + sl.r1;
            ELIST[s0] = (int)tok; EGATE[s0] = sl.g0; EDEST[s0] = (int)(((unsigned)sl.pbin << 18) | (ps << 1) | sl.half0);
            ELIST[s1] = (int)tok; EGATE[s1] = sl.g1; EDEST[s1] = (int)(((unsigned)sl.pbin << 18) | (ps << 1) | (sl.half0 ^ 1u));
        } }
    __syncthreads();
}

__device__ __forceinline__ void moe_setup(const gu32* cnt, const int* ELIST, const int* EDEST, const float* EGATE, const int* PLIST, int G, int vcu, LAS unsigned char* lds, int wave_s) {
    const int tid = wave_s * 64 + pg8::lane_id_v();
    LAS int* tb = (LAS int*)(lds + TB_OFF);
    LAS int* tbE = tb + TB_TBE; LAS int* clE = tb + TB_CLE; LAS int* tbP = tb + TB_TBP; LAS int* clP = tb + TB_CLP;
    LAS int* ut = (LAS int*)(lds + UT_OFF);
    LAS int* tab = (LAS int*)(lds + TAB_OFF); LAS float* tab2 = (LAS float*)(lds + TAB2_OFF); LAS unsigned short* gtab = (LAS unsigned short*)(lds + GTAB_OFF);
    if (tid < NEB) clE[tid] = (int)__hip_atomic_load(cnt + tid, RLX_AGENT);
    else if (tid < NCNT) clP[tid - NEB] = (int)__hip_atomic_load(cnt + tid, RLX_AGENT);
    __syncthreads();
    if (tid < NEB) { int a = 0; for (int j = 0; j < NEB; ++j) { const int tj = (clE[j] + 255) >> 8; a += (j < tid) ? tj : 0; if (tid == NEB - 1 && j == NEB - 1) tbE[NEB] = a + tj; } tbE[tid] = a; }
    else if (tid < NCNT) { const int me = tid - NEB; int a = 0; for (int j = 0; j < NPB; ++j) { const int tj = (clP[j] + 255) >> 8; a += (j < me) ? tj : 0; if (me == NPB - 1 && j == NPB - 1) tbP[NPB] = a + tj; } tbP[me] = a; }
    __syncthreads();
    LAS int* ut6 = (LAS int*)(lds + P6UT_OFF); LAS unsigned short* tab6 = (LAS unsigned short*)(lds + P6TAB_OFF);
    if (tid < NU_MAX) {
        const int L = tid * G + vcu;
        int nv = -1, tile = 0, pn = 0, bin = 0, rb = 0;
        if (L < tbE[NEB] * 4) { tile = L >> 2; pn = L & 3;
            for (int b = 0; b < NEB; ++b) if (tile >= tbE[b] && tile < tbE[b + 1]) bin = b;
            rb = (tile - tbE[bin]) * 256; nv = clE[bin] - rb; nv = nv > 256 ? 256 : nv; }
        ut[tid * 8 + 0] = tile; ut[tid * 8 + 1] = pn; ut[tid * 8 + 2] = bin; ut[tid * 8 + 3] = bin; ut[tid * 8 + 4] = rb; ut[tid * 8 + 5] = nv; ut[tid * 8 + 6] = tid;
    } else if (tid >= 64 && tid < 64 + NU6_MAX) {
        const int i6 = tid - 64, L = i6 * G + vcu;
        int nv = -1, tile = 0, pn = 0, bin = 0, rb = 0, e = 0, e2 = 0;
        if (L < tbP[NPB] * 4) { tile = L >> 2; pn = L & 3;
            for (int b = 0; b < NPB; ++b) if (tile >= tbP[b] && tile < tbP[b + 1]) bin = b;
            rb = (tile - tbP[bin]) * 256; nv = clP[bin] - rb; nv = nv > 256 ? 256 : nv;
            const int gi = bin / 28; int idx = bin % 28, ia = 0; while (idx >= 7 - ia) { idx -= 7 - ia; ++ia; }
            e = gi * 8 + ia; e2 = gi * 8 + ia + 1 + idx; }
        ut6[i6 * 8 + 0] = tile; ut6[i6 * 8 + 1] = pn; ut6[i6 * 8 + 2] = e; ut6[i6 * 8 + 3] = bin; ut6[i6 * 8 + 4] = rb; ut6[i6 * 8 + 5] = nv; ut6[i6 * 8 + 6] = e2;
    }
    __syncthreads();
    {
        constexpr int NE = NU_MAX * 256 / (NWAVES * 64), NE6 = NU6_MAX * 256 / (NWAVES * 64);
        int tokv[NE], dv[NE]; float gv[NE]; int tok6[NE6];
#pragma unroll
        for (int q = 0; q < NE; ++q) { const int en = tid + q * (NWAVES * 64), i = en >> 8, r = en & 255; const int nv = ut[i * 8 + 5];
            tokv[q] = 0; dv[q] = -1; gv[q] = 0.f;
            if (r < nv) { const size_t idx = (size_t)ut[i * 8 + 3] * NTOK + ut[i * 8 + 4] + r; tokv[q] = ELIST[idx]; dv[q] = EDEST[idx]; gv[q] = EGATE[idx]; } }
#pragma unroll
        for (int q = 0; q < NE6; ++q) { const int en = tid + q * (NWAVES * 64), i = en >> 8, r = en & 255; const int nv = ut6[i * 8 + 5];
            tok6[q] = 0xffff;
            if (r < nv) tok6[q] = PLIST[(size_t)ut6[i * 8 + 3] * NTOK + ut6[i * 8 + 4] + r]; }
#pragma unroll
        for (int q = 0; q < NE; ++q) { const int en = tid + q * (NWAVES * 64); gtab[en] = (unsigned short)tokv[q]; tab[en] = dv[q]; tab2[en] = gv[q]; }
#pragma unroll
        for (int q = 0; q < NE6; ++q) tab6[tid + q * (NWAVES * 64)] = (unsigned short)tok6[q];
    }
    __syncthreads();
    if (tid < NU6_MAX) ut6[tid * 8 + 4] = tid;
    __syncthreads();
}

__global__ void __launch_bounds__(NWAVES * 64, 2) mega_fwd(Args args) {
    extern __shared__ __attribute__((aligned(16))) unsigned char lds_raw[];
    LAS unsigned char* lds = (LAS unsigned char*)lds_raw;
    volatile LAS unsigned* MISC = (volatile LAS unsigned*)(lds + MISC_OFF);
    const int wave = __builtin_amdgcn_readfirstlane((int)threadIdx.x >> 6);
#define LANE_TID() const int lane = pg8::lane_id_v(); const int tid = wave * 64 + lane; (void)tid
    const int G = gridDim.x; const int bx = blockIdx.x; const int vcu = (G % 8 == 0) ? (bx % 8) * (G / 8) + bx / 8 : bx;
    unsigned char* ws_top = args.ws;
    gu32* ctl = (gu32*)(ws_top + WS_CTL);
#define WS_PTRS() GAS unsigned char* wsg_ = (GAS unsigned char*)ws_top; asm volatile("" : "+s"(wsg_)); unsigned char* ws = (unsigned char*)wsg_;     \
    float* VEC = (float*)(ws + WS_VEC); float* CS = (float*)(ws + WS_ROPE); \
    bf16* WIN = (bf16*)(ws + WS_WIN); bf16* WOUT = (bf16*)(ws + WS_WOUT); bf16* WRT = (bf16*)(ws + WS_WRT); bf16* WSGU = (bf16*)(ws + WS_WSGU); \
    bf16* WGU = (bf16*)(ws + WS_WGU); bf16* WD = (bf16*)(ws + WS_WD); \
    bf16* Sb = (bf16*)(ws + WS_S); float* ST = (float*)(ws + WS_ST); float* RS0 = (float*)(ws + WS_RS0); bf16* XN1 = (bf16*)(ws + WS_MIXED); \
    bf16* PROJ = (bf16*)(ws + WS_PROJ); bf16* MIXED = (bf16*)(ws + WS_MIXED); bf16* PART = (bf16*)(ws + WS_PART); float* ML = (float*)(ws + WS_ML); \
    bf16* Hb = (bf16*)(ws + WS_H); int* ELIST = (int*)(ws + WS_ELIST); int* EDEST = (int*)(ws + WS_EDEST); float* EGATE = (float*)(ws + WS_EGATE); int* PLIST = (int*)(ws + WS_PLIST); \
    (void)VEC; (void)CS; (void)WIN; (void)WOUT; (void)WRT; (void)WSGU; (void)WGU; (void)WD; (void)Sb; (void)ST; (void)RS0; (void)XN1; (void)PROJ; (void)MIXED; (void)PART; (void)ML; (void)Hb; (void)ELIST; (void)EDEST; (void)EGATE; (void)PLIST
    const float* x_in = args.in[0]; const float* w_in = args.in[1]; const float* w_out = args.in[2]; const float* branch_gain = args.in[3]; const float* sgu_gain = args.in[4];
    const float* sgu_w = args.in[5]; const float* sgu_b = args.in[6]; const float* conv_w = args.in[7]; const float* ln_gain = args.in[8]; const float* ln_bias = args.in[9];
    const float* rgw = args.in[10]; const float* rgb = args.in[11]; const float* rew = args.in[12]; const float* reb = args.in[13];
    const float* ewg = args.in[14]; const float* ewu = args.in[15]; const float* ewd = args.in[16];

    { LANE_TID(); for (int u = tid; u < (LDS_BYTES - TAB_OFF) / 4; u += NWAVES * 64) ((LAS unsigned*)(lds + TAB_OFF))[u] = 0u; }
    __syncthreads();
    XcdBarrier bar = xcd_barrier_post((unsigned*)(ctl + CW_BAR), MISC + 8);
    const int gw = vcu * NWAVES + wave, NGW = G * NWAVES;
#ifndef REP_MASK
#define REP_MASK 0
#endif
#define REPS(idx) for (int rep_ = 0; rep_ < 1 + ((REP_MASK >> (idx)) & 1); ++rep_)
#ifdef STAMP_A
    volatile LAS unsigned* tacc = (volatile LAS unsigned*)(lds + MISC_OFF + 64);
    unsigned long long t_last = __builtin_amdgcn_s_memrealtime();
#define STAMP(ty) do { const unsigned long long _n = __builtin_amdgcn_s_memrealtime(); if (wave == 0 && pg8::lane_id_v() == 0) tacc[ty] += (unsigned)(_n - t_last); t_last = _n; } while (0)
#else
#define STAMP(ty) do { } while (0)
#endif
    LAS float* scr = (LAS float*)(lds + RING_OFF + wave * 16384);
    const int lo = args.ph_lo, hi_ph = args.ph_hi;
#ifndef PHASE_MASK
#define PHASE_MASK 0xFFFFu
#endif
#define IN(k) (((PHASE_MASK >> ((k) == 0 ? 0 : ((k) == 99 ? 9 : 1 + (((k) - 1) & 15)))) & 1u) && lo <= (k) && (k) < hi_ph)

    if (IN(0)) REPS(0) {
        WS_PTRS(); LANE_TID();
        for (int i = gw * 64 + lane; i < 1024; i += NGW * 64) { VEC[V_ONES + i] = 1.0f; VEC[V_ZEROS + i] = 0.0f; }
        const int NRW = NGW - 512, rw = gw - 512;
        if (rw >= 0)
        for (int m0 = rw; m0 < NTOK; m0 += 8 * NRW) {
            f32x4 v[8][4];
#pragma unroll
            for (int b = 0; b < 8; ++b) { const int m = m0 + b * NRW; const GAS f32x4* xr = (const GAS f32x4*)(x_in + (size_t)(m < NTOK ? m : 0) * DM) + lane;
#pragma unroll
                for (int j = 0; j < 4; ++j) v[b][j] = xr[64 * j]; }
#pragma unroll
            for (int b = 0; b < 8; ++b) { const int m = m0 + b * NRW; if (m < NTOK) { GAS v2u* o8 = (GAS v2u*)(Sb + (size_t)m * DM) + lane;
#pragma unroll
                for (int j = 0; j < 4; ++j) { v2u w; w.x = pkbf(v[b][j][0], v[b][j][1]); w.y = pkbf(v[b][j][2], v[b][j][3]); o8[64 * j] = w; }
                if (lane < 32) ST[(size_t)m * 32 + lane] = (lane == 1) ? 1024.0f * (1.0f - LN_EPS) : 0.0f; } }
        }
        for (int i = gw * 64 + lane; i < SEQ * 32; i += NGW * 64) { const int t = i >> 5, f = i & 31; const float inv_freq = powf(10000.0f, -(float)f / 32.0f); const float ang = (float)t * inv_freq;
            float sn, cn; sincosf(ang, &sn, &cn); CS[2 * i] = cn; CS[2 * i + 1] = sn; }
        constexpr int I_IN = 4 * 88, I_OUT = 4 * 32;
        for (int it = gw; it < I_IN + I_OUT; it += NGW) {
            if (it < I_IN) { const int l = it / 88, nb = it % 88, n0 = nb * 32;
                const float* sc = (l == 0) ? nullptr : ln_gain + (size_t)(l - 1) * 2048 + 1024; const float* bk = (l == 0) ? nullptr : ln_bias + (size_t)(l - 1) * 2048 + 1024;
                bf16* wt = WIN + ((size_t)l * PW + n0) * DM; float* cs = VEC + V_CIN + l * PW + n0; float* ds = VEC + V_DIN + l * PW + n0;
                if (n0 < 1024) conv_item(w_in + (size_t)l * DM * PW, DM, PW, ColRope(), n0, wt, 1, sc, bk, cs, ds, scr, lane);
                else if (n0 >= OGC) conv_item(w_in + (size_t)l * DM * PW, DM, PW, ColConv(), n0, wt, 1, sc, bk, cs, ds, scr, lane);
                else conv_item(w_in + (size_t)l * DM * PW, DM, PW, ColId(), n0, wt, 1, sc, bk, cs, ds, scr, lane);
            } else { const int r = it - I_IN, l = r / 32, n0 = (r % 32) * 32;
                conv_item(w_out + (size_t)l * DM * DM, DM, DM, ColId(), n0, WOUT + ((size_t)l * DM + n0) * DM, 1, branch_gain + (size_t)l * 1024, nullptr, nullptr, nullptr, scr, lane); }
        }
        for (int i = gw * 64 + lane; i < 4 * 4 * 128 * 128; i += NGW * 64) {
            const int p = i & 15, s = (i & 112) + 8 * ((p & 7) >> 2) + 4 * (p >> 3) + (p & 3), t = (i >> 7) & 127; WSGU[i] = (bf16)(pkbf((s <= t) ? sgu_w[(i & ~127) + s] : 0.0f, 0.f) & 0xffffu); }
        for (int it = gw; it < 4 * 64; it += NGW) {
            const int l = it >> 6, n = it & 63; const float* g1 = ln_gain + (size_t)l * 2048; const float* b1 = ln_bias + (size_t)l * 2048;
            float cs = 0.f, ds = 0.f;
            for (int k = lane; k < DM; k += 64) { float w = 0.f; if (n < 32) w = rew[((size_t)l * DM + k) * 32 + n]; else if (n < 36) w = rgw[((size_t)l * DM + k) * 4 + (n - 32)];
                const float v = rbf(w * g1[k]); cs += v; ds += b1[k] * w; WRT[((size_t)l * 64 + n) * DM + k] = (bf16)(pkbf(v, 0.f) & 0xffffu); }
            cs = wave_sum(cs); ds = wave_sum(ds);
            if (lane == 0) { float bias = 0.f; if (n < 32) bias = reb[l * 32 + n]; else if (n < 36) bias = rgb[l * 4 + n - 32]; VEC[V_CR + l * 64 + n] = cs; VEC[V_DR + l * 64 + n] = ds + bias; }
        }
        xcd_barrier(bar);
        STAMP(0);
    }

    for (int l = 0; l < args.nlayers; ++l) {
        const int pb = 1 + l * 16;
        const float* G1 = ln_gain + (size_t)l * 2048; const float* B1 = ln_bias + (size_t)l * 2048;
        gu32* cnt = ctl + CW_CNT + l * 256;

        if (IN(pb + 0)) REPS(1) {
            WS_PTRS();
#ifdef STAGGER_P1
            if (vcu & 1) { const unsigned long long s0_ = __builtin_amdgcn_s_memrealtime(); while (__builtin_amdgcn_s_memrealtime() - s0_ < (unsigned long long)(STAGGER_P1)) __builtin_amdgcn_s_sleep(8); }
#endif
            pg8::Gemm g{Sb, WIN + (size_t)l * PW * DM, DM}; pg8::DenseOrder S; S.init(NTOK, PW, DM, G, bx);
            { LAS float* xt = (LAS float*)(lds + TAB_OFF); const int tid_ = wave * 64 + pg8::lane_id_v();
              for (int i = tid_; i < PW; i += NWAVES * 64) { xt[XT_C + i] = VEC[V_CIN + l * PW + i]; xt[XT_D + i] = VEC[V_DIN + l * PW + i]; }
              if (tid_ == 0) ((LAS int*)xt)[XT_LASTPM] = -1;
              __syncthreads(); }
            EpiProj E{PROJ, VEC + V_CIN + l * PW, VEC + V_DIN + l * PW, ST, RS0, CS, (LAS float*)(lds + TAB_OFF)};
            pg8::gemm_phase<EpiProj, pg8::DenseOrder, false>(lds + RING_OFF, g, S, E, nullptr, wave);
            xcd_barrier(bar);
            STAMP(1);
        }
        if (IN(pb + 1)) REPS(2) {
            WS_PTRS();
            attn_phase(PROJ, PART, ML, vcu, G, lds, wave);
            xcd_barrier(bar);
            STAMP(2);
        }
        if (IN(pb + 2)) REPS(3) {
            WS_PTRS(); LANE_TID();
            TS_DECL(); TS_BEGIN(301);
            for (int c = vcu; c < NTOK / 128; c += G) sgu_unit(PROJ, MIXED, WSGU + (size_t)l * 4 * 128 * 128, sgu_gain + (size_t)l * 256, sgu_b + (size_t)l * 512, c, lds, wave);
            TS_END(301, lds, wave); TS_BEGIN(302);
            for (int m = gw; m < NTOK; m += 4 * NGW) { combine_tokens<4>(PART, ML, MIXED, (size_t)m, (size_t)NGW, lane); conv_tokens<4>(PROJ, conv_w + (size_t)l * 768, MIXED, (size_t)m, (size_t)NGW, lane); }
            TS_END(302, lds, wave);
            xcd_barrier(bar);
            STAMP(3);
        }
        if (IN(pb + 3)) REPS(4) {
            WS_PTRS();
            pg8::Gemm g{MIXED, WOUT + (size_t)l * DM * DM, DM}; pg8::DenseOrder S; S.init(NTOK, DM, DM, G, bx);
            const float* Gp = (l == 0) ? VEC + V_ONES : ln_gain + (size_t)(l - 1) * 2048 + 1024;
            const float* Bp = (l == 0) ? VEC + V_ZEROS : ln_bias + (size_t)(l - 1) * 2048 + 1024;
            EpiRes1 E{Sb, RS0, Gp, Bp, (rep_ == ((REP_MASK >> 4) & 1)) ? Sb : PROJ};
            pg8::gemm_phase<EpiRes1, pg8::DenseOrder, false>(lds + RING_OFF, g, S, E, nullptr, wave);
            xcd_barrier(bar);
            STAMP(4);
        }
        if (IN(pb + 4)) REPS(5) {
            WS_PTRS(); LANE_TID();
            for (int blk = vcu; blk < NTOK / 256; blk += G) route_block(Sb, WRT + (size_t)l * 64 * DM, VEC + V_CR + l * 64, VEC + V_DR + l * 64, G1, B1, XN1, ELIST, EDEST, EGATE, PLIST, cnt, blk, lds, wave);
            TS_DECL(); TS_BEGIN(404);
            for (int rc_ = 0; rc_ < 1 + ((REP_MASK >> 10) & 1); ++rc_)
            for (int it0 = gw; it0 < 2048; it0 += NGW) {
                const int it = it0 >> 1, e = it >> 5, mat = (it >> 4) & 1, n0 = (it & 15) * 32, kh = (it0 & 1) * 512;
                const float* W = (mat ? ewu : ewg) + ((size_t)l * 32 + e) * DM * 512;
                conv_item(W + (size_t)kh * 512, 512, 512, ColId(), n0, WGU + ((size_t)e * 1024 + 2 * n0 + mat) * DM + kh, 2, nullptr, nullptr, nullptr, nullptr, scr, lane, DM);
            }
            TS_END(404, lds, wave);
            xcd_barrier(bar);
            STAMP(5);
        }
        if (IN(pb + 5)) REPS(6) {
            WS_PTRS();
            { TS_DECL(); TS_BEGIN(501); moe_setup(cnt, ELIST, EDEST, EGATE, PLIST, G, vcu, lds, wave); TS_END(501, lds, wave); }
            pg8::Gemm g{XN1, WGU, DM}; MoeOrder S{(const LAS int*)(lds + UT_OFF), DM, DM, (size_t)1024 * DM * 2, NU_MAX};
            EpiSwiglu E{Hb, (const LAS int*)(lds + TAB_OFF), (const LAS float*)(lds + TAB2_OFF), (const LAS int*)(lds + TB_OFF) + TB_TBP};
            pg8::gemm_phase<EpiSwiglu, MoeOrder, true, false>(lds + RING_OFF, g, S, E, (const LAS unsigned short*)(lds + GTAB_OFF), wave);
            {   const int T5 = __builtin_amdgcn_readfirstlane(((const LAS int*)(lds + TB_OFF))[TB_TBE + NEB]) * 4, nmax = (T5 + G - 1) / G;
                int x = T5 - (nmax - 1) * G; if (x >= G) x = 0;
                if (vcu >= x) { LANE_TID(); __syncthreads();
                    for (int it = (vcu - x) * NWAVES + wave; it < 1024; it += (G - x) * NWAVES) { const int e = it >> 5, n0 = (it & 31) * 32;
                        conv_item(ewd + ((size_t)l * 32 + e) * 512 * DM, 512, DM, ColId(), n0, WD + ((size_t)e * 1024 + n0) * 512, 1, nullptr, nullptr, nullptr, nullptr, scr, lane); } } }
            xcd_barrier(bar);
            STAMP(6);
        }
        if (IN(pb + 6)) REPS(7) {
            WS_PTRS();
            pg8::Gemm g{Hb, WD, DM}; MoeOrder S{(const LAS int*)(lds + P6UT_OFF), DM, 512, (size_t)1024 * 512 * 2, NU6_MAX};
            EpiDown E{Sb, XN1, (const LAS unsigned short*)(lds + P6TAB_OFF), ST};
            pg8::gemm_phase<EpiDown, MoeOrder, false, true>(lds + RING_OFF, g, S, E, nullptr, wave);
            xcd_barrier(bar);
            STAMP(7);
        }
    }
    if (IN(99)) REPS(9) {
        WS_PTRS(); LANE_TID();
        const int l = args.nlayers - 1;
        const float* G2 = ln_gain + (size_t)l * 2048 + 1024; const float* B2 = ln_bias + (size_t)l * 2048 + 1024;
        const unsigned poison = (__hip_atomic_load(ctl + CW_BAR + XB_TMO, RLX_AGENT) != 0u);
        for (int m0 = gw; m0 < NTOK; m0 += 4 * NGW) {
            float s[4], q[4]; v4u o[4][2];
#pragma unroll
            for (int b = 0; b < 4; ++b) { const int m = m0 + b * NGW; s[b] = 0.f; q[b] = 0.f;
                if (lane < 16) { const f32x2 p = *(const f32x2*)(ST + (size_t)m * 32 + 2 * lane); s[b] = p.x; q[b] = p.y; }
#pragma unroll
                for (int j = 0; j < 2; ++j) o[b][j] = *(const v4u*)(Sb + (size_t)m * DM + 512 * j + 8 * lane); }
#pragma unroll
            for (int b = 0; b < 4; ++b) { s[b] = wave_sum(s[b]); q[b] = wave_sum(q[b]); }
#pragma unroll
            for (int b = 0; b < 4; ++b) { const int m = m0 + b * NGW;
                const float mu = s[b] * (1.f / 1024.f); const float var = q[b] * (1.f / 1024.f) - mu * mu; float rstd = fast_rsq(var + LN_EPS);
                if (poison) rstd = __builtin_nanf("");
#pragma unroll
                for (int j = 0; j < 2; ++j) {
                    const int c = 512 * j + 8 * lane;
                    const f32x4 g0 = *(const f32x4*)(G2 + c), g1 = *(const f32x4*)(G2 + c + 4), b0 = *(const f32x4*)(B2 + c), b1 = *(const f32x4*)(B2 + c + 4);
                    f32x4 x0 = (f32x4){bflo(o[b][j].x), bfhi(o[b][j].x), bflo(o[b][j].y), bfhi(o[b][j].y)}, x1 = (f32x4){bflo(o[b][j].z), bfhi(o[b][j].z), bflo(o[b][j].w), bfhi(o[b][j].w)};
                    x0 = (x0 - mu) * rstd * g0 + b0; x1 = (x1 - mu) * rstd * g1 + b1;
                    *(f32x4*)(args.out + (size_t)m * DM + c) = x0; *(f32x4*)(args.out + (size_t)m * DM + c + 4) = x1;
                } }
        }
    }
#undef IN
#ifdef TSEC
    { __syncthreads(); const unsigned tot = ((volatile LAS unsigned*)(lds + MISC_OFF + 64))[wave]; const unsigned long long s0 = __builtin_amdgcn_s_memrealtime();
      while (__builtin_amdgcn_s_memrealtime() - s0 < (unsigned long long)tot) __builtin_amdgcn_s_sleep(8); }
#endif
}

static int g_grid = 0;
static int mega_prepare() {
    if (g_grid != 0) return g_grid;
    int dev = 0, cus = 0, per_cu = 0;
    if (hipGetDevice(&dev) != hipSuccess || hipDeviceGetAttribute(&cus, hipDeviceAttributeMultiprocessorCount, dev) != hipSuccess) { g_grid = -1; return g_grid; }
    if (hipFuncSetAttribute((const void*)mega_fwd, hipFuncAttributeMaxDynamicSharedMemorySize, LDS_BYTES) != hipSuccess) { fprintf(stderr, "hipFuncSetAttribute failed\n"); g_grid = -1; return g_grid; }
    if (hipOccupancyMaxActiveBlocksPerMultiprocessor(&per_cu, (const void*)mega_fwd, NWAVES * 64, LDS_BYTES) != hipSuccess || per_cu < 1) { fprintf(stderr, "occupancy query: %d blocks per CU\n", per_cu); }
    (void)hipGetLastError();
    g_grid = cus;
    return g_grid;
}
static void mega_launch(void* const* d_in, float* out, unsigned char* ws, hipStream_t stream, int ph_lo, int ph_hi, int nlayers) {
    const int grid = mega_prepare(); if (grid <= 0) return;
    (void)hipMemsetAsync(ws + WS_CTL, 0, CTL_ZERO_BYTES, stream);
    Args a{};
    for (int i = 0; i < 17; ++i) a.in[i] = (const float*)d_in[i];
    a.out = out; a.ws = ws; a.ph_lo = ph_lo; a.ph_hi = ph_hi; a.nlayers = nlayers; a.pad = 0;
    hipLaunchKernelGGL(mega_fwd, dim3(grid), dim3(NWAVES * 64), LDS_BYTES, stream, a);
}
extern "C" void kernel_launch(void* const* d_in, const int* in_sizes, int n_in, void* d_out, int out_size, void* d_ws, size_t ws_size, hipStream_t stream) {
    if (n_in != 17 || ws_size < WS_END) { fprintf(stderr, "kernel_launch: unexpected n_in %d / ws_size %zu\n", n_in, ws_size); return; }
    mega_launch(d_in, (float*)d_out, (unsigned char*)d_ws, stream, 0, 100, NL);
}
```

```cpp
#include <hip/hip_runtime.h>
#include <cstdio>
#include <cstdint>
#include <cmath>
namespace pg8 {
#define PG8_LAS __attribute__((address_space(3)))
typedef unsigned short bf16_t;
typedef short bf16x8 __attribute__((ext_vector_type(8)));
typedef float f32x4 __attribute__((ext_vector_type(4)));
typedef float f32x2 __attribute__((ext_vector_type(2)));
typedef unsigned u32x4 __attribute__((ext_vector_type(4)));
typedef unsigned u32x2 __attribute__((ext_vector_type(2)));
constexpr int BM = 256, BK = 64, HALF = 128, HTB = HALF * BK * 2  , STAGE_BYTES = 8 * HTB, NXCD = 8, WGM = 8;

__host__ __device__ __forceinline__ int lds_byte(int r, int c) { const int st = (r >> 4) * 2 + (c >> 5), rr = r & 15, cc = c & 31, ob = rr * 64 + cc * 2; return st * 1024 + (ob ^ (((ob >> 9) & 1) << 5)); }
__host__ __device__ __forceinline__ void stage_rc(int b, int& R, int& C) { const int st = b / 1024, sb = b % 1024, swz = sb ^ (((sb >> 9) & 1) << 5); R = (st >> 1) * 16 + swz / 64; C = (st & 1) * 32 + (swz % 64) / 2; }
__host__ __device__ __forceinline__ int perm32(int rho) { const int n = rho >> 4, i = rho & 15; return 8 * (i >> 2) + 4 * n + (i & 3); }

struct Unit { int pm, pn, e, bin, rbase, nvalid, e2; };
struct Gemm { const bf16_t* A; const bf16_t* Bt; int K; };

struct DenseOrder {
    int nM, nN, nwg, G, c, K, own_pm;
    __device__ __forceinline__ void init(int M, int N, int K_, int G_, int c_) { nM = M / BM; nN = N / BM; nwg = nM * nN; G = G_; c = c_; K = K_; own_pm = -1; }
    __device__ __forceinline__ bool next(int i, Unit& u) const {
        if (own_pm >= 0) { if (i >= nN) return false; u.pm = own_pm; u.pn = i; u.e = 0; u.bin = 0; u.rbase = 0; u.nvalid = 256; u.e2 = 0; return true; }
        const long L = (long)i * G + c; if (L >= nwg) return false;
        int wgid = (int)L; { const int q = nwg / NXCD, r = nwg % NXCD, xcd = wgid % NXCD, off = wgid / NXCD; wgid = (xcd < r ? xcd * (q + 1) : r * (q + 1) + (xcd - r) * q) + off; }
        const int nig = WGM * nN, gid = wgid / nig, fm = gid * WGM, gsz = (nM - fm) < WGM ? (nM - fm) : WGM;
        u.pm = fm + ((wgid % nig) % gsz); u.pn = (wgid % nig) / gsz; u.e = 0; u.bin = 0; u.rbase = 0; u.nvalid = 256; u.e2 = 0; return true;
    }
    __device__ __forceinline__ size_t a_off(const Unit& u) const { return (size_t)u.pm * (size_t)(BM * 2) * K; }
    __device__ __forceinline__ size_t b_off(const Unit& u) const { return (size_t)u.pn * (size_t)(BM * 2) * K; }
    __device__ __forceinline__ size_t b_off2(const Unit& u) const { return b_off(u); }
};

#ifdef TSEC
#define TS_DECL() unsigned long long ts0_ = 0
#define TS_BEGIN(id) do { if (TSEC == (id)) ts0_ = __builtin_amdgcn_s_memrealtime(); } while (0)
#define TS_END(id, ldsbase, wave) do { if (TSEC == (id)) { const unsigned long long d_ = __builtin_amdgcn_s_memrealtime() - ts0_; if (pg8::lane_id_v() == 0) ((volatile PG8_LAS unsigned*)((ldsbase) + 163840 - 256 + 64))[wave] += (unsigned)d_; } } while (0)
#else
#define TS_DECL() do { } while (0)
#define TS_BEGIN(id) do { } while (0)
#define TS_END(id, ldsbase, wave) do { } while (0)
#endif
__device__ __forceinline__ int lane_id_v() { int l; asm volatile("v_mbcnt_lo_u32_b32 %0, -1, 0\n\tv_mbcnt_hi_u32_b32 %0, -1, %0" : "=v"(l)); return l; }
__device__ __forceinline__ unsigned cvt_pk_bf16(float lo, float hi) { unsigned r; asm volatile("v_cvt_pk_bf16_f32 %0, %1, %2" : "=v"(r) : "v"(lo), "v"(hi)); return r; }

template <class Epi, class Sched, bool GATHER, bool DUALB = false>
__device__ __forceinline__ void gemm_phase(PG8_LAS unsigned char* lds, const Gemm g, const Sched& S, const Epi& E, const PG8_LAS unsigned short* tab, int wave_s) {
    const int lane = lane_id_v(), wid = wave_s, tid = wid * 64 + lane,
              wr = wid >> 2, wc = wid & 3, fr = lane & 15, fq = lane >> 4;
    const int K = g.K, nt = K / BK, Kb = DUALB ? K / 2 : K, nth = nt / 2;
    unsigned voffA[2], voffB[2]; int RA[2]; unsigned CA2[2];
#pragma unroll
    for (int i = 0; i < 2; ++i) { int R, C; stage_rc(tid * 16 + i * 8192, R, C); const int Rb = Epi::PERM ? ((R & ~31) + perm32(R & 31)) : R;
        voffA[i] = (unsigned)(R * K + C) * 2u; voffB[i] = (unsigned)(Rb * Kb + C) * 2u; RA[i] = R; CA2[i] = (unsigned)C * 2u; }
    const size_t kstep = (size_t)(BK * 2);
    const size_t hstep = (size_t)HALF * K * 2;
    const size_t hstepB = (size_t)HALF * Kb * 2;
    const unsigned ldsw = (unsigned)wid * 1024u;
    const int aoff = lds_byte(wr * 64 + fr, fq * 8), boff = lds_byte(wc * 32 + fr, fq * 8);
#define PG8_SA(b, h) (((b) * 2 + (h)) * HTB)
#define PG8_SB(b, h) ((4 + (b) * 2 + (h)) * HTB)
#define PG8_STAGE(bufoff, gbase, voff) do { _Pragma("unroll") for (int _i = 0; _i < 2; ++_i) \
        __builtin_amdgcn_global_load_lds((const unsigned*)((const char*)(gbase) + (voff)[_i]), (PG8_LAS unsigned*)(lds + (bufoff) + ldsw + _i * 8192), 16, 0, 0); } while (0)
#define PG8_LDA(dst, b, h) do { _Pragma("unroll") for (int m = 0; m < 4; ++m) _Pragma("unroll") for (int k = 0; k < 2; ++k) dst[m][k] = *(const PG8_LAS bf16x8*)(lds + PG8_SA(b, h) + aoff + m * 2048 + k * 1024); } while (0)
#define PG8_LDB(dst, b, h) do { _Pragma("unroll") for (int n = 0; n < 2; ++n) _Pragma("unroll") for (int k = 0; k < 2; ++k) dst[n][k] = *(const PG8_LAS bf16x8*)(lds + PG8_SB(b, h) + boff + n * 2048 + k * 1024); } while (0)
#define PG8_MMA(ai, bj, At, Bt) do { __builtin_amdgcn_s_setprio(1); _Pragma("unroll") for (int m = 0; m < 4; ++m) _Pragma("unroll") for (int n = 0; n < 2; ++n) _Pragma("unroll") for (int k = 0; k < 2; ++k) \
        acc[ai][bj][m][n] = __builtin_amdgcn_mfma_f32_16x16x32_bf16(Bt[n][k], At[m][k], acc[ai][bj][m][n], 0, 0, 0); __builtin_amdgcn_s_setprio(0); } while (0)
#define PG8_WAIT_V(n) asm volatile("s_waitcnt vmcnt(" #n ")" ::: "memory")
#define PG8_WAIT_L(n) asm volatile("s_waitcnt lgkmcnt(" #n ")" ::: "memory")
#define PG8_WAIT_V01(flag) do { if constexpr (Epi::NSTORE >= 16) { asm volatile("s_cmp_eq_u32 %0, 0\n\ts_cbranch_scc1 .Lw8_%=\n\ts_waitcnt vmcnt(24)\n\ts_branch .Lwd_%=\n.Lw8_%=:\n\ts_waitcnt vmcnt(8)\n.Lwd_%=:" :: "s"(__builtin_amdgcn_readfirstlane(flag)) : "memory", "scc"); } else { asm volatile("s_waitcnt vmcnt(8)" ::: "memory"); } } while (0)
#define PG8_BAR __builtin_amdgcn_s_barrier()
#define PG8_SCHED __builtin_amdgcn_sched_barrier(0)
    Unit cur, nxt; int ui = 0;
    if (!S.next(0, cur)) return;
    f32x4 acc[2][2][4][2];
#pragma unroll
    for (int a = 0; a < 2; ++a)
#pragma unroll
        for (int b = 0; b < 2; ++b)
#pragma unroll
            for (int m = 0; m < 4; ++m)
#pragma unroll
                for (int n = 0; n < 2; ++n) acc[a][b][m][n] = (f32x4){0.f, 0.f, 0.f, 0.f};
    bf16x8 At[4][2], B0[2][2], B1[2][2];
    [[maybe_unused]] u32x4 pq0 = (u32x4){0u, 0u, 0u, 0u};
    unsigned vc0[2], vc1[2], vn0[2], vn1[2];
#pragma unroll
    for (int i = 0; i < 2; ++i) {
        if constexpr (GATHER) { vc0[i] = (unsigned)tab[RA[i]] * (unsigned)(K * 2) + CA2[i]; vc1[i] = (unsigned)tab[128 + RA[i]] * (unsigned)(K * 2) + CA2[i]; }
        else { vc0[i] = voffA[i]; vc1[i] = voffA[i] + (unsigned)hstep; }
        vn0[i] = vc0[i]; vn1[i] = vc1[i];
    }
    const char* cA = (const char*)g.A + (GATHER ? (size_t)0 : S.a_off(cur)); const char* cB = (const char*)g.Bt + S.b_off(cur); const char* cB1 = (const char*)g.Bt + S.b_off2(cur);
    PG8_STAGE(PG8_SB(0, 0), cB, voffB); PG8_STAGE(PG8_SB(0, 1), cB + hstepB, voffB); PG8_STAGE(PG8_SA(0, 0), cA, vc0); PG8_STAGE(PG8_SA(0, 1), cA, vc1);
    if (wr == 1) PG8_BAR;
    PG8_WAIT_V(2); PG8_BAR;
    PG8_STAGE(PG8_SB(1, 0), cB + kstep, voffB); PG8_STAGE(PG8_SA(1, 0), cA + kstep, vc0); PG8_STAGE(PG8_SB(1, 1), cB + hstepB + kstep, voffB);
    PG8_WAIT_V(6); PG8_BAR;
    for (;;) {
        const bool has_next = S.next(ui + 1, nxt);
        const char* nA = has_next ? (const char*)g.A + (GATHER ? (size_t)0 : S.a_off(nxt)) : cA; const char* nB = has_next ? (const char*)g.Bt + S.b_off(nxt) : cB; const char* nB1 = has_next ? (const char*)g.Bt + S.b_off2(nxt) : cB1;
        if constexpr (GATHER) { if (has_next) {
#pragma unroll
            for (int i = 0; i < 2; ++i) { vn0[i] = (unsigned)tab[(ui + 1) * 256 + RA[i]] * (unsigned)(K * 2) + CA2[i]; vn1[i] = (unsigned)tab[(ui + 1) * 256 + 128 + RA[i]] * (unsigned)(K * 2) + CA2[i]; } } }
#define PG8_TRIP(t, W01) { \
            const int rlx_ = (Epi::NSTORE >= 16 && (t) == 0 && ui > 0) ? 1 : 0; \
            const bool last = (t == nt - 2); \
            const char* a1 = cA + (size_t)(t + 1) * kstep; \
            const char* a2 = last ? nA : cA + (size_t)(t + 2) * kstep; \
            const char* b2 = last ? nB : (DUALB ? ((t + 2 < nth) ? cB + (size_t)(t + 2) * kstep : cB1 + (size_t)(t + 2 - nth) * kstep) : cB + (size_t)(t + 2) * kstep); \
            const char* a3 = a2 + kstep; const char* b3 = b2 + kstep; \
            unsigned x0[2], x1[2]; \
            x0[0] = last ? vn0[0] : vc0[0]; x0[1] = last ? vn0[1] : vc0[1]; x1[0] = last ? vn1[0] : vc1[0]; x1[1] = last ? vn1[1] : vc1[1]; \
            PG8_LDB(B0, 0, 0); PG8_LDB(B1, 0, 1); PG8_SCHED; PG8_LDA(At, 0, 0); PG8_STAGE(PG8_SA(1, 1), a1, vc1); \
            PG8_WAIT_V01(rlx_); PG8_WAIT_L(0); PG8_BAR; PG8_MMA(0, 0, At, B0); PG8_MMA(0, 1, At, B1); PG8_BAR; PG8_SCHED; \
            PG8_LDA(At, 0, 1); PG8_STAGE(PG8_SB(0, 0), b2, voffB); PG8_STAGE(PG8_SB(0, 1), b2 + hstepB, voffB); PG8_STAGE(PG8_SA(0, 0), a2, x0); \
            PG8_WAIT_V01(rlx_); PG8_WAIT_L(0); PG8_BAR; PG8_MMA(1, 0, At, B0); PG8_MMA(1, 1, At, B1); PG8_BAR; PG8_SCHED; \
            if constexpr (Epi::HAS_PRE) { E.pre(acc, cur, t, pq0, wr, wc, fr, fq); PG8_SCHED; } \
            PG8_LDB(B0, 1, 0); PG8_LDB(B1, 1, 1); PG8_SCHED; PG8_LDA(At, 1, 0); PG8_STAGE(PG8_SA(0, 1), a2, x1); \
            PG8_WAIT_V(8); PG8_WAIT_L(0); PG8_BAR; PG8_MMA(0, 0, At, B0); PG8_MMA(0, 1, At, B1); PG8_BAR; PG8_SCHED; \
            PG8_LDA(At, 1, 1); PG8_STAGE(PG8_SB(1, 0), b3, voffB); PG8_STAGE(PG8_SB(1, 1), b3 + hstepB, voffB); PG8_STAGE(PG8_SA(1, 0), a3, x0); \
            PG8_WAIT_V(8); PG8_WAIT_L(0); PG8_BAR; PG8_MMA(1, 0, At, B0); PG8_MMA(1, 1, At, B1); PG8_BAR; PG8_SCHED; \
            if constexpr (Epi::HAS_PRE) { E.pre(acc, cur, t + 1, pq0, wr, wc, fr, fq); PG8_SCHED; } \
        }
        TS_DECL(); TS_BEGIN(120 + Epi::EPI_ID);
        if constexpr (Epi::HAS_PRE) {
            _Pragma("unroll") for (int t = 0; t < 16; t += 2) PG8_TRIP(t, 8)
        } else {
            for (int t = 0; t < nt; t += 2) PG8_TRIP(t, 8)
        }
#undef PG8_TRIP
        TS_END(120 + Epi::EPI_ID, lds, wid);
        if constexpr (Epi::HAS_PRE) E.pre(acc, cur, nt, pq0, wr, wc, fr, fq);
        if (wr == 0) PG8_BAR;
        { TS_BEGIN(100 + Epi::EPI_ID); E(acc, cur, wr, wc, fr, fq, tid); TS_END(100 + Epi::EPI_ID, lds, wid); }
#if defined(REP_EPI_ID)
        if constexpr (Epi::EPI_ID == REP_EPI_ID) E(acc, cur, wr, wc, fr, fq, tid);
#endif
        if (!has_next) break;
#pragma unroll
        for (int a = 0; a < 2; ++a)
#pragma unroll
            for (int b = 0; b < 2; ++b)
#pragma unroll
                for (int m = 0; m < 4; ++m)
#pragma unroll
                    for (int n = 0; n < 2; ++n) acc[a][b][m][n] = (f32x4){0.f, 0.f, 0.f, 0.f};
        cur = nxt; cA = nA; cB = nB; cB1 = nB1; ++ui;
#pragma unroll
        for (int i = 0; i < 2; ++i) { vc0[i] = vn0[i]; vc1[i] = vn1[i]; }
        if (wr == 1) PG8_BAR;
    }
    PG8_WAIT_V(0);
    PG8_BAR;
#undef PG8_SA
#undef PG8_SB
#undef PG8_STAGE
#undef PG8_LDA
#undef PG8_LDB
#undef PG8_MMA
#undef PG8_WAIT_V
#undef PG8_WAIT_L
#undef PG8_BAR
#undef PG8_SCHED
}
}
#define GAS __attribute__((address_space(1)))
#define LAS __attribute__((address_space(3)))
typedef unsigned short bf16;
typedef unsigned v4u __attribute__((ext_vector_type(4)));
typedef unsigned v2u __attribute__((ext_vector_type(2)));
typedef float f32x4 __attribute__((ext_vector_type(4)));
typedef float f32x2 __attribute__((ext_vector_type(2)));
typedef float f32x16 __attribute__((ext_vector_type(16)));
typedef short bf16x8 __attribute__((ext_vector_type(8)));
typedef short s16x4 __attribute__((ext_vector_type(4)));
typedef GAS unsigned gu32;
#define RLX_AGENT __ATOMIC_RELAXED, __HIP_MEMORY_SCOPE_AGENT
#define LDS_WAIT() asm volatile("s_waitcnt lgkmcnt(0)" ::: "memory")
#define VM_WAIT() asm volatile("s_waitcnt vmcnt(0)" ::: "memory")

constexpr int NWAVES = 8;
constexpr int NTOK = 65536, SEQ = 8192, DM = 1024, PW = 2816, NL = 4;
constexpr int OQ = 0, OKK = 512, OV = 1024, OU = 1536, OZ = 1792, OGB = 2048, OGC = 2304, OH = 2560;
constexpr float LN_EPS = 1e-5f, ALPHA = 1.6817928305074290f, LOG2E = 1.4426950408889634f, C2 = 0.125f * 1.4426950408889634f;
constexpr int NU_MAX = 10;
constexpr int NEB = 32, NPB = 112, NCNT = NEB + NPB;

constexpr size_t MiB = 1u << 20;
constexpr size_t WS_CTL = 0, CTL_ZERO_BYTES = 1 * MiB;
constexpr size_t WS_ROPE = 1 * MiB;
constexpr size_t WS_VEC = 3 * MiB;
constexpr size_t WS_WIN = 4 * MiB;
constexpr size_t WS_WOUT = 26 * MiB;
constexpr size_t WS_WRT = 34 * MiB;
constexpr size_t WS_WSGU = 35 * MiB;
constexpr size_t WS_WGU = 36 * MiB;
constexpr size_t WS_WD = 100 * MiB;
constexpr size_t WS_CGU = 132 * MiB;
constexpr size_t WS_S = 134 * MiB;
constexpr size_t WS_ST = 262 * MiB;
constexpr size_t WS_RS0 = 270 * MiB;
constexpr size_t WS_RS1 = 271 * MiB;
constexpr size_t WS_PROJ = 272 * MiB;
constexpr size_t WS_MIXED = 624 * MiB;
constexpr size_t WS_PART = 752 * MiB;
constexpr size_t WS_ML = 944 * MiB;
constexpr size_t WS_H = 272 * MiB;
constexpr size_t WS_ELIST = 456 * MiB;
constexpr size_t WS_EDEST = 464 * MiB;
constexpr size_t WS_EGATE = 472 * MiB;
constexpr size_t WS_PLIST = 480 * MiB;
constexpr size_t WS_END = 956 * MiB;
constexpr int V_ONES = 0, V_ZEROS = 1024, V_CIN = 2048  , V_DIN = V_CIN + 4 * PW, V_CR = V_DIN + 4 * PW  , V_DR = V_CR + 256;
constexpr int CW_TMO = 0, CW_CODE = 1, CW_BAR = 4096, CW_CNT = 16384;
constexpr int RING_OFF = 0, RING_BYTES = 131072;
constexpr int TAB_OFF = 131072;
constexpr int TAB2_OFF = TAB_OFF + NU_MAX * 1024;
constexpr int GTAB_OFF = TAB2_OFF + NU_MAX * 1024;
constexpr int UT_OFF = GTAB_OFF + NU_MAX * 512;
constexpr int TB_OFF = UT_OFF + 512;
constexpr int P6TAB_OFF = TB_OFF + 2560;
constexpr int P6UT_OFF = P6TAB_OFF + 3072;
constexpr int NU6_MAX = 6;
constexpr int TB_TBE = 0, TB_CLE = 33, TB_TBP = 65, TB_CLP = 178, TB_HIST = 290, TB_BASE = 434;
constexpr int LDS_BYTES = 163840;
constexpr int MISC_OFF = LDS_BYTES - 256;
static_assert(P6UT_OFF + 256 <= MISC_OFF && MISC_OFF + 256 <= LDS_BYTES, "LDS map");

__device__ __forceinline__ unsigned pkbf(float lo, float hi) { return pg8::cvt_pk_bf16(lo, hi); }
__device__ __forceinline__ float bflo(unsigned w) { return __uint_as_float(w << 16); }
__device__ __forceinline__ float bfhi(unsigned w) { return __uint_as_float(w & 0xffff0000u); }
__device__ __forceinline__ float bf2f(unsigned short b) { return __uint_as_float((unsigned)b << 16); }
__device__ __forceinline__ float rbf(float x) { return bflo(pkbf(x, 0.f)); }
__device__ __forceinline__ float fast_exp2(float x) { return __builtin_amdgcn_exp2f(x); }
__device__ __forceinline__ float fast_rcp(float x) { return __builtin_amdgcn_rcpf(x); }
__device__ __forceinline__ float fast_rsq(float x) { return __builtin_amdgcn_rsqf(x); }
__device__ __forceinline__ float gelu_t(float x) {
    const float u = 0.7978845608028654f * (x + 0.044715f * x * x * x);
    return x * fast_rcp(1.0f + fast_exp2(-2.0f * LOG2E * u));
}
__device__ __forceinline__ float silu_f(float x) { return x * fast_rcp(1.0f + fast_exp2(-LOG2E * x)); }
template <int CTRL> __device__ __forceinline__ float dppf(float v) { return __uint_as_float((unsigned)__builtin_amdgcn_update_dpp(0, (int)__float_as_uint(v), CTRL, 0xF, 0xF, true)); }
__device__ __forceinline__ float sum_x1(float v) { return v + dppf<0xB1>(v); }
__device__ __forceinline__ float sum_x2(float v) { return v + dppf<0x4E>(v); }
__device__ __forceinline__ float sum_q4(float v) { return v + dppf<0x141>(v); }
__device__ __forceinline__ float sum_q8(float v) { return v + dppf<0x140>(v); }
__device__ __forceinline__ float sum_x16(float v) { const auto r = __builtin_amdgcn_permlane16_swap(__float_as_uint(v), __float_as_uint(v), false, false); return __uint_as_float(r[0]) + __uint_as_float(r[1]); }
__device__ __forceinline__ float sum_x32(float v) { const auto r = __builtin_amdgcn_permlane32_swap(__float_as_uint(v), __float_as_uint(v), false, false); return __uint_as_float(r[0]) + __uint_as_float(r[1]); }
__device__ __forceinline__ float max_x32(float v) { const auto r = __builtin_amdgcn_permlane32_swap(__float_as_uint(v), __float_as_uint(v), false, false); return fmaxf(__uint_as_float(r[0]), __uint_as_float(r[1])); }
__device__ __forceinline__ float other_x32(float v, int hi) { const auto r = __builtin_amdgcn_permlane32_swap(__float_as_uint(v), __float_as_uint(v), false, false); return __uint_as_float(hi ? r[0] : r[1]); }
__device__ __forceinline__ float wave_sum(float v) { return sum_x32(sum_x16(sum_q8(sum_q4(sum_x2(sum_x1(v)))))); }

#define XB_TMO      128
#define XB_XCNT(j)  (256  + 64 * (j))
#define XB_XSUB(j)  (1280 + 64 * (j))
#define XB_XGEN(j)  (2304 + 64 * (j))
#define XB_TOP      3328
#define XB_TOPGEN   3392
#define XCD_BAR_WORDS 3456
#define XB_SPIN_CAP (1u << 18)
__device__ __forceinline__ unsigned xb_ld(unsigned* p)              { return __hip_atomic_load(p, __ATOMIC_RELAXED, __HIP_MEMORY_SCOPE_AGENT); }
__device__ __forceinline__ unsigned xb_add(unsigned* p, unsigned v) { return __hip_atomic_fetch_add(p, v, __ATOMIC_RELAXED, __HIP_MEMORY_SCOPE_AGENT); }
__device__ __forceinline__ unsigned xb_xcc_id() { return (unsigned)__builtin_amdgcn_s_getreg((3 << 11) | 20) & 0xFu; }
#define XB_SPIN(cond, bar) do { unsigned _sp = 0; while (cond) { __builtin_amdgcn_s_sleep(1); \
    if ((++_sp & 255u) == 0u) { if (xb_ld(&(bar)[XB_TMO])) break; if (_sp > XB_SPIN_CAP) { atomicAdd(&(bar)[XB_TMO], 1u); break; } } } } while (0)
struct XcdBarrier { unsigned* bar; unsigned x; volatile LAS unsigned* st; };
__device__ __forceinline__ XcdBarrier xcd_barrier_post(unsigned* bar, volatile LAS unsigned* st) {
    XcdBarrier b; b.bar = bar; b.x = xb_xcc_id(); b.st = st;
    if (threadIdx.x == 0) (void)xb_add(&bar[XB_XCNT(b.x)], 1u);
    return b;
}
__device__ __forceinline__ void xcd_barrier_complete(unsigned* bar, unsigned x, unsigned& nloc, unsigned& nx) {
    const unsigned G = gridDim.x * gridDim.y * gridDim.z;
    unsigned sum, cnt, mine, sp = 0u;
    for (;;) {
        sum = 0u; cnt = 0u; mine = 0u;
#pragma unroll
        for (unsigned j = 0; j < 16; ++j) { const unsigned c = xb_ld(&bar[XB_XCNT(j)]); sum += c; cnt += (c > 0u) ? 1u : 0u; mine = (j == x) ? c : mine; }
        if (sum == G) break;
        __builtin_amdgcn_s_sleep(1);
        if ((++sp & 255u) == 0u) { if (xb_ld(&bar[XB_TMO])) break; if (sp > XB_SPIN_CAP) { atomicAdd(&bar[XB_TMO], 1u); break; } }
    }
    nloc = mine > 0u ? mine : 1u; nx = cnt > 0u ? cnt : 1u;
}
__device__ __forceinline__ void xcd_barrier(const XcdBarrier& b) {
    asm volatile("s_waitcnt vmcnt(0)" ::: "memory");
    __syncthreads();
    if (threadIdx.x == 0) {
        unsigned* bar = b.bar;
        __builtin_amdgcn_s_waitcnt(0);
        unsigned nloc = b.st[0], nx = b.st[1];
        if (nloc == 0u) { xcd_barrier_complete(bar, b.x, nloc, nx); b.st[0] = nloc; b.st[1] = nx; }
        const unsigned old = xb_add(&bar[XB_XSUB(b.x)], 1u);
        const unsigned gen = old / nloc;
        if (old + 1u == (gen + 1u) * nloc) {
            __builtin_amdgcn_fence(__ATOMIC_RELEASE, "agent");
            asm volatile("s_waitcnt vmcnt(0)" ::: "memory");
            const unsigned og = xb_add(&bar[XB_TOP], 1u);
            const unsigned tg = og / nx;
            if (og + 1u == (tg + 1u) * nx) xb_add(&bar[XB_TOPGEN], 1u);
            else XB_SPIN(xb_ld(&bar[XB_TOPGEN]) == tg, bar);
            __builtin_amdgcn_fence(__ATOMIC_ACQUIRE, "agent");
            xb_add(&bar[XB_XGEN(b.x)], 1u);
            asm volatile("s_waitcnt vmcnt(0)" ::: "memory");
        } else {
            XB_SPIN(xb_ld(&bar[XB_XGEN(b.x)]) == gen, bar);
            __builtin_amdgcn_fence(__ATOMIC_ACQUIRE, "agent");
            asm volatile("s_waitcnt vmcnt(0)" ::: "memory");
        }
    }
    __syncthreads();
}

struct MoeOrder {
    const LAS int* ut; int K, Kb; size_t bstride; int numax;
    __device__ __forceinline__ bool next(int i, pg8::Unit& u) const {
        if (i >= numax) return false;
        const LAS int* p = ut + i * 8; const int nv = __builtin_amdgcn_readfirstlane(p[5]);
        if (nv < 0) return false;
        u.pm = __builtin_amdgcn_readfirstlane(p[0]); u.pn = __builtin_amdgcn_readfirstlane(p[1]); u.e = __builtin_amdgcn_readfirstlane(p[2]);
        u.bin = __builtin_amdgcn_readfirstlane(p[3]); u.rbase = __builtin_amdgcn_readfirstlane(p[4]); u.nvalid = nv; u.e2 = __builtin_amdgcn_readfirstlane(p[6]); return true;
    }
    __device__ __forceinline__ size_t a_off(const pg8::Unit& u) const { return (size_t)u.pm * (size_t)(512) * K; }
    __device__ __forceinline__ size_t b_off(const pg8::Unit& u) const { return (size_t)u.e * bstride + (size_t)u.pn * (size_t)(512) * Kb; }
    __device__ __forceinline__ size_t b_off2(const pg8::Unit& u) const { return (size_t)u.e2 * bstride + (size_t)u.pn * (size_t)(512) * Kb; }
};

template <class T> __device__ __forceinline__ T ldg(const void* base, unsigned byteoff) { return *(const T*)((const char*)base + byteoff); }
template <class T> __device__ __forceinline__ void stg_(void* base, unsigned byteoff, T v) { *(T*)((char*)base + byteoff) = v; }
#define EPI_FENCE() asm volatile("" ::: "memory")
constexpr int XT_C = 512, XT_D = XT_C + PW, XT_LASTPM = XT_D + PW;
struct EpiProj {
    static constexpr bool PERM = true, HAS_PRE = false; static constexpr int EPI_ID = 1, NSTORE = 16;
    bf16* O; const float* cvec; const float* dvec; const float* ST; float* RS; const float* CS; LAS float* xt;
    __device__ __forceinline__ void operator()(const f32x4 (&acc)[2][2][4][2], const pg8::Unit& u, int wr, int wc, int fr, int fq, int tid) const {
        const unsigned row0 = u.pm * 256 + wr * 64 + fr;
        const unsigned col0 = u.pn * 256 + wc * 32 + 8 * fq;
        const int seg = u.pn;
        LAS unsigned char* ldsb_ = (LAS unsigned char*)xt - TAB_OFF; (void)ldsb_;
        TS_DECL(); TS_BEGIN(201);
        f32x4 csA = (f32x4){1.f, 0.f, 1.f, 0.f}, csB = csA, wsA = csA, wsB = csA;
        if (seg < 4) { const unsigned t = row0 & (SEQ - 1), i0 = 16 * (wc & 1) + 4 * fq;
            csA = ldg<f32x4>(CS, (t * 32u + i0) * 8u); csB = ldg<f32x4>(CS, (t * 32u + i0) * 8u + 16u);
            wsA = ldg<f32x4>(CS, (16u * 32u + i0) * 8u); wsB = ldg<f32x4>(CS, (16u * 32u + i0) * 8u + 16u); }
        const int lastpm = ((const LAS int*)xt)[XT_LASTPM];
        if (lastpm != (int)u.pm) {
            if (tid < 256) {
                const unsigned row = u.pm * 256 + tid;
                f32x4 p[8];
#pragma unroll
                for (int j = 0; j < 8; ++j) p[j] = ldg<f32x4>(ST, row * 128u + 16u * j);
                float s = 0.f, q = 0.f;
#pragma unroll
                for (int j = 0; j < 8; ++j) { s += p[j][0] + p[j][2]; q += p[j][1] + p[j][3]; }
                const float mu = s * (1.f / 1024.f); const float var = q * (1.f / 1024.f) - mu * mu; const float rstd = fast_rsq(var + LN_EPS);
                stg_<f32x2>(RS, row * 8u, (f32x2){mu, rstd});
                *(LAS f32x2*)(xt + 2 * tid) = (f32x2){rstd, rstd * mu};
            }
            asm volatile("s_waitcnt lgkmcnt(0)" ::: "memory"); __builtin_amdgcn_s_barrier(); asm volatile("" ::: "memory");
            if (tid == 0) ((LAS int*)xt)[XT_LASTPM] = (int)u.pm;
        }
        TS_END(201, ldsb_, tid >> 6); TS_BEGIN(202);
        f32x4 cs0 = csA, cs1 = csB;
#pragma unroll
        for (int ai = 0; ai < 2; ++ai)
#pragma unroll
            for (int m = 0; m < 4; ++m) {
                const unsigned row = row0 + ai * 128 + m * 16;
                const f32x2 t2 = *(const LAS f32x2*)(xt + 2 * (wr * 64 + fr + ai * 128 + m * 16));
                const float rstd = t2.x, rsmu = t2.y;
#pragma unroll
                for (int bj = 0; bj < 2; ++bj) {
                    const int lc = col0 + bj * 128;
                    const f32x4 cv0 = *(const LAS f32x4*)(xt + XT_C + lc), cv1 = *(const LAS f32x4*)(xt + XT_C + lc + 4);
                    const f32x4 dv0 = *(const LAS f32x4*)(xt + XT_D + lc), dv1 = *(const LAS f32x4*)(xt + XT_D + lc + 4);
                    f32x4 v0 = acc[ai][bj][m][0] * rstd - cv0 * rsmu + dv0, v1 = acc[ai][bj][m][1] * rstd - cv1 * rsmu + dv1;
                    if (seg < 4) {
                        const float sc = (seg < 2) ? C2 : 1.0f;
                        f32x4 w0, w1;
                        w0[0] = (v0[0] * cs0[0] - v0[1] * cs0[1]) * sc; w0[1] = (v0[1] * cs0[0] + v0[0] * cs0[1]) * sc;
                        w0[2] = (v0[2] * cs0[2] - v0[3] * cs0[3]) * sc; w0[3] = (v0[3] * cs0[2] + v0[2] * cs0[3]) * sc;
                        w1[0] = (v1[0] * cs1[0] - v1[1] * cs1[1]) * sc; w1[1] = (v1[1] * cs1[0] + v1[0] * cs1[1]) * sc;
                        w1[2] = (v1[2] * cs1[2] - v1[3] * cs1[3]) * sc; w1[3] = (v1[3] * cs1[2] + v1[2] * cs1[3]) * sc;
                        v0 = w0; v1 = w1;
                    } else if (seg == 6 || seg == 7) {
#pragma unroll
                        for (int e = 0; e < 4; ++e) { v0[e] = gelu_t(v0[e]); v1[e] = gelu_t(v1[e]); }
                    }
                    if (seg >= 9) {
                        v2u w2; w2.x = pkbf(v0[0] * v0[1], v0[2] * v0[3]); w2.y = pkbf(v1[0] * v1[1], v1[2] * v1[3]);
                        stg_<v2u>(O, (row * (unsigned)PW + OGC + (seg - 9) * 128 + ((wc * 32 + 8 * fq + bj * 128) >> 1)) * 2u, w2);
                    } else {
                    v4u w; w.x = pkbf(v0[0], v0[1]); w.y = pkbf(v0[2], v0[3]); w.z = pkbf(v1[0], v1[1]); w.w = pkbf(v1[2], v1[3]);
                    stg_<v4u>(O, (row * (unsigned)PW + col0 + bj * 128) * 2u, w);
                    }
                }
                if (seg < 4) {
                    const int nstep = (ai == 0 && m == 3) ? 5 : 1;
#pragma unroll
                    for (int st = 0; st < nstep; ++st) {
                        f32x4 n0, n1;
                        n0[0] = cs0[0] * wsA[0] - cs0[1] * wsA[1]; n0[1] = cs0[1] * wsA[0] + cs0[0] * wsA[1]; n0[2] = cs0[2] * wsA[2] - cs0[3] * wsA[3]; n0[3] = cs0[3] * wsA[2] + cs0[2] * wsA[3];
                        n1[0] = cs1[0] * wsB[0] - cs1[1] * wsB[1]; n1[1] = cs1[1] * wsB[0] + cs1[0] * wsB[1]; n1[2] = cs1[2] * wsB[2] - cs1[3] * wsB[3]; n1[3] = cs1[3] * wsB[2] + cs1[2] * wsB[3];
                        cs0 = n0; cs1 = n1;
                    }
                }
                if (m == 3) EPI_FENCE();
            }
        TS_END(202, ldsb_, tid >> 6);
    }
};
struct EpiRes1 {
    static constexpr bool PERM = true, HAS_PRE = false; static constexpr int EPI_ID = 2, NSTORE = 16;
    bf16* S; const float* RS; const float* G; const float* Bv; bf16* Sout;
    __device__ __forceinline__ void operator()(const f32x4 (&acc)[2][2][4][2], const pg8::Unit& u, int wr, int wc, int fr, int fq, int tid) const {
        const unsigned row0 = u.pm * 256 + wr * 64 + fr;
        const unsigned col0 = u.pn * 256 + wc * 32 + 8 * fq;
        f32x2 st[2][4];
#pragma unroll
        for (int ai = 0; ai < 2; ++ai)
#pragma unroll
            for (int m = 0; m < 4; ++m) st[ai][m] = ldg<f32x2>(RS, (row0 + ai * 128 + m * 16) * 8u);
        f32x4 gv[2][2], bv[2][2];
#pragma unroll
        for (int bj = 0; bj < 2; ++bj) { gv[bj][0] = ldg<f32x4>(G, (col0 + bj * 128) * 4u); gv[bj][1] = ldg<f32x4>(G, (col0 + bj * 128) * 4u + 16u); bv[bj][0] = ldg<f32x4>(Bv, (col0 + bj * 128) * 4u); bv[bj][1] = ldg<f32x4>(Bv, (col0 + bj * 128) * 4u + 16u); }
        v4u o[2][4];
#pragma unroll
        for (int m = 0; m < 4; ++m) o[0][m] = ldg<v4u>(S, ((row0 + m * 16) * (unsigned)DM + col0) * 2u);
#pragma unroll
        for (int g = 0; g < 4; ++g) {
            const int bj = g >> 1, ai = g & 1;
            if (g < 3) { const int bjn = (g + 1) >> 1, ain = (g + 1) & 1;
#pragma unroll
                for (int m = 0; m < 4; ++m) o[(g + 1) & 1][m] = ldg<v4u>(S, ((row0 + ain * 128 + m * 16) * (unsigned)DM + col0 + bjn * 128) * 2u); }
            __builtin_amdgcn_sched_barrier(0);
#pragma unroll
            for (int m = 0; m < 4; ++m) {
                const unsigned off = ((row0 + ai * 128 + m * 16) * (unsigned)DM + col0 + bj * 128) * 2u;
                const v4u oo = o[g & 1][m];
                f32x4 x0 = (f32x4){bflo(oo.x), bfhi(oo.x), bflo(oo.y), bfhi(oo.y)}, x1 = (f32x4){bflo(oo.z), bfhi(oo.z), bflo(oo.w), bfhi(oo.w)};
                x0 = ((x0 - st[ai][m].x) * st[ai][m].y * gv[bj][0] + bv[bj][0]) * ALPHA + acc[ai][bj][m][0];
                x1 = ((x1 - st[ai][m].x) * st[ai][m].y * gv[bj][1] + bv[bj][1]) * ALPHA + acc[ai][bj][m][1];
                v4u w; w.x = pkbf(x0[0], x0[1]); w.y = pkbf(x0[2], x0[3]); w.z = pkbf(x1[0], x1[1]); w.w = pkbf(x1[2], x1[3]);
                stg_<v4u>(Sout, off, w);
            }
            __builtin_amdgcn_sched_barrier(0);
        }
    }
};
struct EpiSwiglu {
    static constexpr bool PERM = true, HAS_PRE = false; static constexpr int EPI_ID = 3, NSTORE = 0;
    bf16* H; const LAS int* dtab; const LAS float* gtab; const LAS int* tbP;
    __device__ __forceinline__ void operator()(const f32x4 (&acc)[2][2][4][2], const pg8::Unit& u, int wr, int wc, int fr, int fq, int tid) const {
        const unsigned lr0 = wr * 64 + fr;
        const unsigned col0 = u.pn * 256 + wc * 32 + 8 * fq;
#pragma unroll
        for (int ai = 0; ai < 2; ++ai)
#pragma unroll
            for (int m = 0; m < 4; ++m) {
                const unsigned lr = lr0 + ai * 128 + m * 16;
                const unsigned d = (unsigned)dtab[u.e2 * 256 + lr]; const float gate = gtab[u.e2 * 256 + lr];
                const bool valid = d != 0xffffffffu;
                const unsigned pb = valid ? (d >> 18) : 0u, pslot = (d >> 1) & 0x1ffffu, half = d & 1u;
                const unsigned prow = (unsigned)tbP[pb] * 256u + pslot;
#pragma unroll
                for (int bj = 0; bj < 2; ++bj) {
                    const f32x4 v0 = acc[ai][bj][m][0], v1 = acc[ai][bj][m][1];
                    v2u w; w.x = pkbf(gate * silu_f(v0[0]) * v0[1], gate * silu_f(v0[2]) * v0[3]); w.y = pkbf(gate * silu_f(v1[0]) * v1[1], gate * silu_f(v1[2]) * v1[3]);
                    if (valid) stg_<v2u>(H, (prow * 1024u + half * 512u + ((col0 + bj * 128) >> 1)) * 2u, w);
                }
            }
    }
};
struct EpiDown {
    static constexpr bool PERM = true, HAS_PRE = false; static constexpr int EPI_ID = 4, NSTORE = 0;
    bf16* S; const bf16* XN; const LAS unsigned short* ttab; float* ST;
    __device__ __forceinline__ void pre(f32x4 (&)[2][2][4][2], const pg8::Unit&, int, pg8::u32x4&, int, int, int, int) const {}
    __device__ __forceinline__ void operator()(const f32x4 (&acc)[2][2][4][2], const pg8::Unit& u, int wr, int wc, int fr, int fq, int tid) const {
        const unsigned lr0 = wr * 64 + fr;
        const unsigned col0 = u.pn * 256 + wc * 32 + 8 * fq;
        TS_DECL(); TS_BEGIN(211);
        unsigned tk[2][4]; v4u o[2][4][2];
#pragma unroll
        for (int ai = 0; ai < 2; ++ai)
#pragma unroll
            for (int m = 0; m < 4; ++m) { const unsigned lr = lr0 + ai * 128 + m * 16; const unsigned t16 = ttab[u.rbase * 256 + lr]; tk[ai][m] = ((int)lr < u.nvalid) ? t16 : 0xffffffffu; }
#pragma unroll
        for (int ai = 0; ai < 2; ++ai)
#pragma unroll
            for (int m = 0; m < 4; ++m) { const unsigned tok = (tk[ai][m] != 0xffffffffu) ? tk[ai][m] : 0u;
#pragma unroll
                for (int bj = 0; bj < 2; ++bj) o[ai][m][bj] = ldg<v4u>(XN, (tok * (unsigned)DM + col0 + bj * 128) * 2u); }
        TS_END(211, (LAS unsigned char*)ttab - TAB_OFF, tid >> 6); TS_BEGIN(212);
#pragma unroll
        for (int ai = 0; ai < 2; ++ai) {
#pragma unroll
            for (int m = 0; m < 4; ++m) {
                const bool valid = tk[ai][m] != 0xffffffffu;
                const unsigned tok = valid ? tk[ai][m] : 0u;
                float ssum = 0.f, ssq = 0.f;
#pragma unroll
                for (int bj = 0; bj < 2; ++bj) {
                    const v4u oo = o[ai][m][bj];
                    f32x4 x0 = (f32x4){bflo(oo.x), bfhi(oo.x), bflo(oo.y), bfhi(oo.y)}, x1 = (f32x4){bflo(oo.z), bfhi(oo.z), bflo(oo.w), bfhi(oo.w)};
                    x0 = x0 * ALPHA + acc[ai][bj][m][0]; x1 = x1 * ALPHA + acc[ai][bj][m][1];
                    v4u w; w.x = pkbf(x0[0], x0[1]); w.y = pkbf(x0[2], x0[3]); w.z = pkbf(x1[0], x1[1]); w.w = pkbf(x1[2], x1[3]);
                    if (valid) stg_<v4u>(S, (tok * (unsigned)DM + col0 + bj * 128) * 2u, w);
                    const f32x4 r0 = (f32x4){bflo(w.x), bfhi(w.x), bflo(w.y), bfhi(w.y)}, r1 = (f32x4){bflo(w.z), bfhi(w.z), bflo(w.w), bfhi(w.w)};
                    ssum += (r0[0] + r0[1]) + (r0[2] + r0[3]) + (r1[0] + r1[1]) + (r1[2] + r1[3]);
                    ssq += (r0[0] * r0[0] + r0[1] * r0[1]) + (r0[2] * r0[2] + r0[3] * r0[3]) + (r1[0] * r1[0] + r1[1] * r1[1]) + (r1[2] * r1[2] + r1[3] * r1[3]);
                }
                ssum = sum_x32(sum_x16(ssum)); ssq = sum_x32(sum_x16(ssq));
                if (valid && fq == 0) stg_<f32x2>(ST, ((tok * 16u + u.pn * 4 + wc) * 2u) * 4u, (f32x2){ssum, ssq});
            }
        }
        TS_END(212, (LAS unsigned char*)ttab - TAB_OFF, tid >> 6);
    }
};

struct ColId { __device__ __forceinline__ int operator()(int n) const { return n; } };
struct ColConv { __device__ __forceinline__ int operator()(int n) const { const int q = n - OGC; return ((q & 1) ? OH : OGC) + (q >> 1); } };
struct ColRope { __device__ __forceinline__ int operator()(int n) const { const int p = n & 63; return (n & ~63) + (p >> 1) + ((p & 1) << 5); } };
template <class CM>
__device__ __forceinline__ void conv_item(const float* W, int K, int ldw, CM cm, int n0, bf16* WT, int rstride, const float* scale, const float* biask, float* csum, float* dsum, LAS float* scr, int lane_, int kst = 0) {
    if (kst == 0) kst = K;
    int lane = lane_; asm volatile("" : "+v"(lane));
    const int col = cm(n0 + (lane & 31));
    float cs = 0.f, ds = 0.f;
    const float* wp = W + (size_t)(lane >> 5) * ldw + col;
    float w[32], wn[32];
#pragma unroll
    for (int i = 0; i < 32; ++i) w[i] = wp[(size_t)(2 * i) * ldw];
    for (int k0 = 0; k0 < K; k0 += 64) {
        if (k0 + 64 < K) {
#pragma unroll
            for (int i = 0; i < 32; ++i) wn[i] = wp[(size_t)(k0 + 64 + 2 * i) * ldw];
        }
#pragma unroll
        for (int i = 0; i < 32; ++i) { const int kk = k0 + 2 * i + (lane >> 5); const float sc = scale ? scale[kk] : 1.0f; const float bk = biask ? biask[kk] : 0.0f;
            const float v = rbf(w[i] * sc); cs += v; ds += bk * w[i]; scr[(2 * i + (lane >> 5)) * 33 + (lane & 31)] = v; }
        LDS_WAIT(); asm volatile("" ::: "memory");
        const int c = lane & 7;
#pragma unroll
        for (int j = 0; j < 4; ++j) { const int n = (lane >> 3) + 8 * j; const LAS float* s = scr + (8 * c) * 33 + n;
            v4u o; o.x = pkbf(s[0 * 33], s[1 * 33]); o.y = pkbf(s[2 * 33], s[3 * 33]); o.z = pkbf(s[4 * 33], s[5 * 33]); o.w = pkbf(s[6 * 33], s[7 * 33]);
            *(GAS v4u*)(WT + (size_t)(n * rstride) * kst + k0 + 8 * c) = o; }
        LDS_WAIT(); asm volatile("" ::: "memory");
#pragma unroll
        for (int i = 0; i < 32; ++i) w[i] = wn[i];
    }
    cs = sum_x32(cs); ds = sum_x32(ds);
    if (lane < 32) { if (csum) csum[lane * rstride] = cs; if (dsum) dsum[lane * rstride] = ds; }
}

constexpr int AT_KA = 0, AT_KB = 49152, AT_V = 98304, AT_WS = 147456, AT_END = AT_WS + 8 * 256;
__device__ __forceinline__ void glds16(const void* gsrc, unsigned lds_dst) { unsigned keep;
    asm volatile("s_mov_b32 %0, m0\n\ts_mov_b32 m0, %2\n\ts_nop 0\n\tglobal_load_lds_dwordx4 %1, off\n\ts_mov_b32 m0, %0" : "=&s"(keep) : "v"(gsrc), "s"(lds_dst) : "memory"); }
__device__ __forceinline__ int crow(int r, int hi) { return (r & 3) + 8 * (r >> 2) + 4 * hi; }
typedef short v4i16_t __attribute__((ext_vector_type(4)));
__device__ __forceinline__ s16x4 vtr(const LAS char* p) { return __builtin_bit_cast(s16x4, __builtin_amdgcn_ds_read_tr16_b64_v4i16((LAS v4i16_t*)p)); }
struct AUnit { int b, h, br, r, m0, d; };
__device__ __forceinline__ AUnit attn_decode(int U) { AUnit a; const int bh = U / 96, rem = U % 96; a.b = bh >> 3; a.h = bh & 7; a.br = rem >> 5; const int uidx = rem & 31; const int dsh = 2 * a.br; a.d = 1 << dsh; a.r = uidx & (a.d - 1); a.m0 = (uidx >> dsh) * 256; return a; }
__device__ __forceinline__ void glds16s(const void* sbase, unsigned voff, unsigned lds_dst) { unsigned keep;
    asm volatile("s_mov_b32 %0, m0\n\ts_mov_b32 m0, %3\n\ts_nop 0\n\tglobal_load_lds_dwordx4 %1, %2\n\ts_mov_b32 m0, %0" : "=&s"(keep) : "v"(voff), "s"(sbase), "s"(lds_dst) : "memory"); }
__device__ __forceinline__ void attn_issue_k(const bf16* proj, const AUnit& a, unsigned ldsK, int wid, int lane) {
    const int kk = lane >> 3, pc = lane & 7;
    const unsigned ubase = (((unsigned)a.b * SEQ + a.r) * PW + OKK + 64 * a.h) * 2u, rstep = (unsigned)a.d * PW * 2u;
#pragma unroll
    for (int i = 0; i < 6; ++i) {
        const int x = wid * 6 + i, T = x >> 2, q = x & 3;
        const int k = 8 * q + kk;
        int sidx = a.m0 - 128 + 32 * T + k; sidx = sidx < 0 ? 0 : sidx;
        const unsigned c = (unsigned)(pc ^ ((k >> 1) & 7));
        glds16s(proj, ubase + (unsigned)sidx * rstep + c * 16u, (unsigned)__builtin_amdgcn_readfirstlane(ldsK + T * 4096 + q * 1024));
    }
}
__device__ __forceinline__ void attn_issue_v(const bf16* proj, const AUnit& a, unsigned ldsV, int wid, int lane) {
    const unsigned ubase = (((unsigned)a.b * SEQ + a.r) * PW + OV + 64 * a.h + (lane & 3) * 8) * 2u, rstep = (unsigned)a.d * PW * 2u;
#pragma unroll
    for (int i = 0; i < 6; ++i) {
        const int x = wid * 6 + i, dh = x / 24, kg = x % 24;
        int sidx = a.m0 - 128 + 16 * kg + (lane >> 2); sidx = sidx < 0 ? 0 : sidx;
        glds16s(proj, ubase + (unsigned)sidx * rstep + dh * 64u, (unsigned)__builtin_amdgcn_readfirstlane(ldsV + dh * 24576 + kg * 1024));
    }
}
__device__ __forceinline__ void attn_load_q(const bf16* proj, const AUnit& a, bf16x8 (&qr)[4], int wid, int r32, int hi) {
    const unsigned off = ((((unsigned)a.b * SEQ + (unsigned)(a.m0 + 32 * wid + r32) * a.d + a.r) * PW) + OQ + 64 * a.h + 8 * hi) * 2u;
    asm volatile("global_load_dwordx4 %0, %4, %5\n\tglobal_load_dwordx4 %1, %4, %5 offset:32\n\tglobal_load_dwordx4 %2, %4, %5 offset:64\n\tglobal_load_dwordx4 %3, %4, %5 offset:96"
                 : "=&v"(qr[0]), "=&v"(qr[1]), "=&v"(qr[2]), "=&v"(qr[3]) : "v"(off), "s"(proj) : "memory");
}

__device__ __forceinline__ void attn_phase(const bf16* proj, bf16* part, float* ML, int vcu, int G, LAS unsigned char* lds, int wave_s) {
    int lane = pg8::lane_id_v(); const int wid = wave_s; int r32 = lane & 31, hi = lane >> 5;
    const unsigned lds0 = (unsigned)(uintptr_t)lds;
    constexpr int NUNITS = 8 * 8 * 96;
    int U = vcu;
    if (U >= NUNITS) return;
    AUnit cur = attn_decode(U);
    bf16x8 qr[4];
    attn_issue_k(proj, cur, lds0 + AT_KA, wid, lane);
    attn_load_q(proj, cur, qr, wid, r32, hi);
    attn_issue_v(proj, cur, lds0 + AT_V, wid, lane);
    f32x16 bias0, bias4;
#pragma unroll
    for (int rg = 0; rg < 16; ++rg) { const int c = crow(rg, hi); bias0[rg] = (c < r32) ? -1e30f : 0.f; bias4[rg] = (c > r32) ? -1e30f : 0.f; }
    int kb = 0; bool first = true;
    for (;;) {
        const int Un = U + G; const bool has_next = Un < NUNITS;
        AUnit nxt = cur; if (has_next) nxt = attn_decode(Un);
        const int koff = kb ? AT_KB : AT_KA, koff_n = kb ? AT_KA : AT_KB;
        asm volatile("" : "+v"(lane)); r32 = lane & 31; hi = lane >> 5;
        TS_DECL();
        TS_BEGIN(1);
        if (first) asm volatile("s_waitcnt vmcnt(6)\n\ts_barrier" ::: "memory"); else asm volatile("s_waitcnt vmcnt(11)\n\ts_barrier" ::: "memory");
        TS_END(1, lds, wid);
        asm volatile("" : "+v"(qr[0]), "+v"(qr[1]), "+v"(qr[2]), "+v"(qr[3]));
        TS_BEGIN(2); if (has_next) attn_issue_k(proj, nxt, lds0 + koff_n, wid, lane); TS_END(2, lds, wid);
        f32x16 p[5];
        TS_BEGIN(3);
#if defined(REP_MASK) && ((REP_MASK >> 12) & 1)
        for (int rr_ = 0; rr_ < 2; ++rr_)
#endif
        {
            const LAS unsigned char* kb0 = lds + koff + wid * 4096 + r32 * 128;
            const int sw = (r32 >> 1) & 7;
            int ko[4];
#pragma unroll
            for (int d0 = 0; d0 < 4; ++d0) ko[d0] = ((2 * d0 + hi) ^ sw) * 16;
            bf16x8 kf[2][4];
#pragma unroll
            for (int d0 = 0; d0 < 4; ++d0) kf[0][d0] = *(const LAS bf16x8*)(kb0 + ko[d0]);
#pragma unroll
            for (int j = 0; j < 5; ++j) {
                if (j < 4) {
#pragma unroll
                    for (int d0 = 0; d0 < 4; ++d0) kf[(j + 1) & 1][d0] = *(const LAS bf16x8*)(kb0 + (j + 1) * 4096 + ko[d0]);
                }
                f32x16 a = (j == 0) ? bias0 : ((j == 4) ? bias4 : f32x16{});
#pragma unroll
                for (int d0 = 0; d0 < 4; ++d0) a = __builtin_amdgcn_mfma_f32_32x32x16_bf16(kf[j & 1][d0], qr[d0], a, 0, 0, 0);
                p[j] = a;
                __builtin_amdgcn_sched_barrier(0);
            }
        }
        asm volatile("" : "+v"(p[4]));
        TS_END(3, lds, wid);
        asm volatile("" ::: "memory");
        if (has_next) attn_load_q(proj, nxt, qr, wid, r32, hi);
        TS_BEGIN(4);
        if (cur.m0 == 0) {
            asm volatile("; first-block mask" ::: "memory");
            const int kfirst = 128 - 32 * wid;
#pragma unroll
            for (int j = 0; j < 5; ++j)
#pragma unroll
                for (int rg = 0; rg < 16; ++rg) if (32 * j + crow(rg, hi) < kfirst) p[j][rg] = -1e30f;
        }
        float mx = p[0][0];
#pragma unroll
        for (int j = 0; j < 5; ++j)
#pragma unroll
            for (int rg = 0; rg < 16; ++rg) mx = fmaxf(mx, p[j][rg]);
        mx = max_x32(mx);
        f32x2 l2 = (f32x2){0.f, 0.f};
#pragma unroll
        for (int j = 0; j < 5; ++j)
#pragma unroll
            for (int rg = 0; rg < 16; rg += 2) { const f32x2 dd = (f32x2){p[j][rg], p[j][rg + 1]} - mx; const f32x2 ee = (f32x2){fast_exp2(dd.x), fast_exp2(dd.y)}; p[j][rg] = ee.x; p[j][rg + 1] = ee.y; l2 += ee; }
        float l = l2.x + l2.y;
        l = sum_x32(l);
        asm volatile("" : "+v"(l)); TS_END(4, lds, wid); TS_BEGIN(5);
        if (has_next) asm volatile("s_waitcnt vmcnt(10) lgkmcnt(0)\n\ts_barrier" ::: "memory"); else asm volatile("s_waitcnt vmcnt(0) lgkmcnt(0)\n\ts_barrier" ::: "memory");
        first = false;
        TS_END(5, lds, wid); TS_BEGIN(6);
        f32x16 o[2];
        const LAS char* vp0 = (const LAS char*)lds + AT_V + ((lane >> 4) & 1) * 32 + (lane & 3) * 8 + (4 * hi + ((lane & 15) >> 2)) * 64;
#if defined(REP_MASK) && ((REP_MASK >> 13) & 1)
        for (int rr_ = 0; rr_ < 2; ++rr_)
#endif
        {
            o[0] = f32x16{}; o[1] = f32x16{};
            s16x4 vl[2][2], vh[2][2];
            const LAS char* vpw = vp0 + (32 * wid) * 64;
#pragma unroll
            for (int dh = 0; dh < 2; ++dh) { vl[0][dh] = vtr(vpw + dh * 24576); vh[0][dh] = vtr(vpw + dh * 24576 + 512); }
#pragma unroll
            for (int st = 0; st < 10; ++st) {
                const int j = st >> 1, s = st & 1;
                if (st < 9) {
#pragma unroll
                    for (int dh = 0; dh < 2; ++dh) { vl[(st + 1) & 1][dh] = vtr(vpw + dh * 24576 + (st + 1) * 1024); vh[(st + 1) & 1][dh] = vtr(vpw + dh * 24576 + (st + 1) * 1024 + 512); }
                }
                v4u pw; pw.x = pkbf(p[j][8 * s + 0], p[j][8 * s + 1]); pw.y = pkbf(p[j][8 * s + 2], p[j][8 * s + 3]); pw.z = pkbf(p[j][8 * s + 4], p[j][8 * s + 5]); pw.w = pkbf(p[j][8 * s + 6], p[j][8 * s + 7]);
                const bf16x8 pa = __builtin_bit_cast(bf16x8, pw);
#pragma unroll
                for (int dh = 0; dh < 2; ++dh) {
                    const s16x4 lo = vl[st & 1][dh], hv = vh[st & 1][dh];
                    const bf16x8 vf = (bf16x8){lo[0], lo[1], lo[2], lo[3], hv[0], hv[1], hv[2], hv[3]};
                    o[dh] = __builtin_amdgcn_mfma_f32_32x32x16_bf16(vf, pa, o[dh], 0, 0, 0);
                }
                __builtin_amdgcn_sched_barrier(0);
            }
        }
        asm volatile("" : "+v"(o[0]), "+v"(o[1])); TS_END(6, lds, wid); TS_BEGIN(7);
        asm volatile("s_waitcnt lgkmcnt(0)\n\ts_barrier" ::: "memory");
        TS_END(7, lds, wid); TS_BEGIN(8);
        const size_t rowbase = (size_t)cur.b * SEQ;
        const size_t qtok = rowbase + (size_t)(cur.m0 + 32 * wid + r32) * cur.d + cur.r;
        if (hi == 0) *(GAS f32x2*)((GAS char*)ML + ((((size_t)cur.br * NTOK + qtok) * 8 + cur.h) * 2) * 4) = (f32x2){mx, l};
        const float rl = fast_rcp(l);
        LAS unsigned char* stg = lds + koff + wid * 4608;
#if defined(REP_MASK) && ((REP_MASK >> 14) & 1)
        for (int rr_ = 0; rr_ < 2; ++rr_) {
#else
        {
#endif
#pragma unroll
        for (int dh = 0; dh < 2; ++dh)
#pragma unroll
            for (int g4 = 0; g4 < 4; ++g4) { v2u w; w.x = pkbf(o[dh][4 * g4 + 0] * rl, o[dh][4 * g4 + 1] * rl); w.y = pkbf(o[dh][4 * g4 + 2] * rl, o[dh][4 * g4 + 3] * rl);
                *(LAS v2u*)(stg + r32 * 144 + (32 * dh + 8 * g4 + 4 * hi) * 2) = w; }
        LDS_WAIT();
#pragma unroll
        for (int i = 0; i < 4; ++i) { const int row = i * 8 + (lane >> 3), ch = lane & 7; const v4u v = *(const LAS v4u*)(stg + row * 144 + ch * 16);
            const size_t ot = rowbase + (size_t)(cur.m0 + 32 * wid + row) * cur.d + cur.r;
            *(GAS v4u*)((GAS char*)part + (((size_t)cur.br * NTOK + ot) * 512 + 64 * cur.h + ch * 8) * 2) = v; }
        }
        if (has_next) attn_issue_v(proj, nxt, lds0 + AT_V, wid, lane);
        TS_END(8, lds, wid); TS_BEGIN(9);
        asm volatile("s_waitcnt lgkmcnt(0)\n\ts_barrier" ::: "memory");
        TS_END(9, lds, wid);
        if (!has_next) break;
        cur = nxt; U = Un; kb ^= 1;
    }
}

constexpr int SG_ZT = 0, SG_ZT_STRIDE = 136  , SG_YT = 4 * 64 * SG_ZT_STRIDE * 2  , SG_END = SG_YT + 128 * 256 * 2;
static_assert(SG_END <= MISC_OFF, "sgu LDS");
static_assert(AT_END <= MISC_OFF, "attention LDS");
__device__ __forceinline__ void sgu_unit(const bf16* proj, bf16* mixed, const bf16* WS, const float* sgain, const float* sbias, int chunk, LAS unsigned char* lds, int wave_s) {
    const int lane = pg8::lane_id_v(), wid = wave_s, tid = wid * 64 + lane, r32 = lane & 31, hi = lane >> 5;
    const size_t tok0 = (size_t)chunk * 128;
    LAS bf16* znT = (LAS bf16*)(lds + SG_ZT);
    LAS bf16* yt = (LAS bf16*)(lds + SG_YT);
    TS_DECL(); TS_BEGIN(311);
    const int pce = tid & 31, g1 = pce >> 3, c1 = (pce & 7) * 8;
    f32x4 ga0 = *(const f32x4*)(sgain + g1 * 64 + c1), ga1 = *(const f32x4*)(sgain + g1 * 64 + c1 + 4);
    {
        v4u uvb[8], zvb[8];
#pragma unroll
        for (int it = 0; it < 8; ++it) { const bf16* rowp = proj + (tok0 + it * 16 + (tid >> 5)) * PW; uvb[it] = *(const v4u*)(rowp + OU + 8 * pce); zvb[it] = *(const v4u*)(rowp + OZ + 8 * pce); }
#pragma unroll
        for (int it = 0; it < 8; ++it) {
            const int t = it * 16 + (tid >> 5);
            *(LAS v4u*)(yt + t * 256 + 8 * pce) = uvb[it];
            const v4u zv = zvb[it];
            float z[8] = {bflo(zv.x), bfhi(zv.x), bflo(zv.y), bfhi(zv.y), bflo(zv.z), bfhi(zv.z), bflo(zv.w), bfhi(zv.w)};
            float s = 0.f;
#pragma unroll
            for (int e = 0; e < 8; ++e) s += z[e];
            s = sum_q4(sum_x2(sum_x1(s)));
            const float mean = s * (1.f / 64.f);
            float q = 0.f;
#pragma unroll
            for (int e = 0; e < 8; ++e) { z[e] -= mean; q += z[e] * z[e]; }
            q = sum_q4(sum_x2(sum_x1(q)));
            const float rstd = fast_rsq(q * (1.f / 64.f) + LN_EPS);
            v4u zw; zw.x = pkbf(z[0] * rstd * ga0[0], z[1] * rstd * ga0[1]); zw.y = pkbf(z[2] * rstd * ga0[2], z[3] * rstd * ga0[3]); zw.z = pkbf(z[4] * rstd * ga1[0], z[5] * rstd * ga1[1]); zw.w = pkbf(z[6] * rstd * ga1[2], z[7] * rstd * ga1[3]);
            *(LAS v4u*)((LAS unsigned char*)znT + ((g1 * 2 + (c1 >> 5)) * 128 + t) * 64 + (c1 & 31) * 2) = zw;
        }
    }
    __syncthreads();
    TS_END(311, lds, wid); TS_BEGIN(312);
    {
        const int g = wid >> 1, ct = wid & 1;
        const bf16* wg_ = WS + (size_t)g * 128 * 128;
        const LAS char* zb = (const LAS char*)znT + ((g * 2 + ct) * 128 + 4 * hi + ((lane & 15) >> 2)) * 64 + ((lane >> 4) & 1) * 32 + (lane & 3) * 8;
#pragma unroll
        for (int tt = 0; tt < 4; ++tt) {
            f32x16 a = {};
            bf16x8 af[8];
#pragma unroll
            for (int ks = 0; ks < 2 * (tt + 1); ++ks) af[ks] = *(const bf16x8*)(wg_ + (size_t)(32 * tt + r32) * 128 + 16 * ks + 8 * hi);
            f32x4 bb[4];
#pragma unroll
            for (int q4 = 0; q4 < 4; ++q4) bb[q4] = *(const f32x4*)(sbias + g * 128 + 32 * tt + 8 * q4 + 4 * hi);
#pragma unroll
            for (int ks = 0; ks < 2 * (tt + 1); ++ks) {
                const s16x4 lo = vtr(zb + ks * 1024), hv = vtr(zb + ks * 1024 + 512);
                const bf16x8 bfr = (bf16x8){lo[0], lo[1], lo[2], lo[3], hv[0], hv[1], hv[2], hv[3]};
                a = __builtin_amdgcn_mfma_f32_32x32x16_bf16(af[ks], bfr, a, 0, 0, 0);
            }
#pragma unroll
            for (int rg = 0; rg < 16; ++rg) { const int t = 32 * tt + crow(rg, hi); LAS bf16* yp = yt + t * 256 + 64 * g + 32 * ct + r32;
                const float uval = bf2f(*yp); const float y = uval * (a[rg] + bb[rg >> 2][rg & 3]); *yp = (bf16)(pkbf(y, 0.f) & 0xffffu); }
        }
    }
    __syncthreads();
    TS_END(312, lds, wid); TS_BEGIN(313);
#pragma unroll 1
    for (int i = 0; i < 16; i += 4) {
        float y[4][4], ss[4];
#pragma unroll
        for (int b = 0; b < 4; ++b) { const int t = wid * 16 + i + b; const v2u yv = *(const LAS v2u*)(yt + t * 256 + 4 * lane);
            y[b][0] = bflo(yv.x); y[b][1] = bfhi(yv.x); y[b][2] = bflo(yv.y); y[b][3] = bfhi(yv.y);
            ss[b] = (y[b][0] * y[b][0] + y[b][1] * y[b][1]) + (y[b][2] * y[b][2] + y[b][3] * y[b][3]); }
#pragma unroll
        for (int b = 0; b < 4; ++b) ss[b] = wave_sum(ss[b]);
#pragma unroll
        for (int b = 0; b < 4; ++b) { const int t = wid * 16 + i + b; const float rs = fast_rsq(ss[b] * (1.f / 256.f) + LN_EPS);
            v2u w; w.x = pkbf(y[b][0] * rs, y[b][1] * rs); w.y = pkbf(y[b][2] * rs, y[b][3] * rs);
            *(v2u*)(mixed + (tok0 + t) * DM + 512 + 4 * lane) = w; }
    }
    __syncthreads();
    TS_END(313, lds, wid);
}
struct Args { const float* in[17]; float* out; unsigned char* ws; int ph_lo, ph_hi, nlayers, pad; };

template <int NB>
__device__ __forceinline__ void combine_tokens(const bf16* part, const float* ML, bf16* mixed, size_t tok0, size_t tstride, int lane) {
    const int head = lane >> 3;
    f32x2 ml[NB][3]; v4u pv[NB][3];
#pragma unroll
    for (int b = 0; b < NB; ++b) { const size_t tok = tok0 + b * tstride;
#pragma unroll
        for (int br = 0; br < 3; ++br) { ml[b][br] = *(const f32x2*)(ML + (((size_t)br * NTOK + tok) * 8 + head) * 2); pv[b][br] = *(const v4u*)(part + ((size_t)br * NTOK + tok) * 512 + 8 * lane); } }
    float o[NB][8], ss[NB];
#pragma unroll
    for (int b = 0; b < NB; ++b) {
        const float M = fmaxf(ml[b][0].x, fmaxf(ml[b][1].x, ml[b][2].x));
        float w[3], W = 0.f;
#pragma unroll
        for (int br = 0; br < 3; ++br) { w[br] = ml[b][br].y * fast_exp2(ml[b][br].x - M); W += w[br]; }
        const float rW = 1.0f / W;
#pragma unroll
        for (int e = 0; e < 8; ++e) o[b][e] = 0.f;
#pragma unroll
        for (int br = 0; br < 3; ++br) { const float ww = w[br] * rW; const v4u p = pv[b][br];
            o[b][0] += ww * bflo(p.x); o[b][1] += ww * bfhi(p.x); o[b][2] += ww * bflo(p.y); o[b][3] += ww * bfhi(p.y);
            o[b][4] += ww * bflo(p.z); o[b][5] += ww * bfhi(p.z); o[b][6] += ww * bflo(p.w); o[b][7] += ww * bfhi(p.w); }
        float s = 0.f;
#pragma unroll
        for (int e = 0; e < 8; ++e) s += o[b][e] * o[b][e];
        ss[b] = s;
    }
#pragma unroll
    for (int b = 0; b < NB; ++b) ss[b] = wave_sum(ss[b]);
#pragma unroll
    for (int b = 0; b < NB; ++b) {
        const float rs = fast_rsq(ss[b] * (1.f / 512.f) + LN_EPS);
        v4u ov; ov.x = pkbf(o[b][0] * rs, o[b][1] * rs); ov.y = pkbf(o[b][2] * rs, o[b][3] * rs); ov.z = pkbf(o[b][4] * rs, o[b][5] * rs); ov.w = pkbf(o[b][6] * rs, o[b][7] * rs);
        *(v4u*)(mixed + (tok0 + b * tstride) * DM + 8 * lane) = ov;
    }
}
template <int NB>
__device__ __forceinline__ void conv_tokens(const bf16* proj, const float* cw, bf16* mixed, size_t tok0, size_t tstride, int lane) {
    const f32x4 w0 = *(const f32x4*)(cw + 4 * lane), w1 = *(const f32x4*)(cw + 256 + 4 * lane), w2 = *(const f32x4*)(cw + 512 + 4 * lane);
    v2u zz[NB][3], gb[NB];
#pragma unroll
    for (int b = 0; b < NB; ++b) { const size_t tok = tok0 + b * tstride; const int t = (int)(tok & (SEQ - 1));
#pragma unroll
        for (int j = 0; j < 3; ++j) { zz[b][j] = (v2u){0u, 0u};
            if (t - 2 + j >= 0) zz[b][j] = *(const v2u*)(proj + (tok - 2 + j) * PW + OGC + 4 * lane); }
        gb[b] = *(const v2u*)(proj + tok * PW + OGB + 4 * lane); }
    f32x4 y[NB]; float ss[NB];
#pragma unroll
    for (int b = 0; b < NB; ++b) {
        f32x4 acc = (f32x4){0.f, 0.f, 0.f, 0.f};
#pragma unroll
        for (int j = 0; j < 3; ++j) { const v2u g = zz[b][j];
            const f32x4 z = (f32x4){bflo(g.x), bfhi(g.x), bflo(g.y), bfhi(g.y)};
            acc += z * (j == 0 ? w0 : (j == 1 ? w1 : w2)); }
        y[b] = (f32x4){bflo(gb[b].x), bfhi(gb[b].x), bflo(gb[b].y), bfhi(gb[b].y)} * acc;
        ss[b] = (y[b][0] * y[b][0] + y[b][1] * y[b][1]) + (y[b][2] * y[b][2] + y[b][3] * y[b][3]);
    }
#pragma unroll
    for (int b = 0; b < NB; ++b) ss[b] = wave_sum(ss[b]);
#pragma unroll
    for (int b = 0; b < NB; ++b) {
        const float rs = fast_rsq(ss[b] * (1.f / 256.f) + LN_EPS);
        v2u w; w.x = pkbf(y[b][0] * rs, y[b][1] * rs); w.y = pkbf(y[b][2] * rs, y[b][3] * rs);
        *(v2u*)(mixed + (tok0 + b * tstride) * DM + 768 + 4 * lane) = w;
    }
}

struct RSel { int e0, e1, pbin; unsigned half0, r0, r1, rp; float g0, g1; bool own; };
__device__ __forceinline__ void route_block(const bf16* S, const bf16* Wrt  , const float* cr, const float* dr, const float* g1v, const float* b1v, bf16* XN, int* ELIST, int* EDEST, float* EGATE, int* PLIST, gu32* cnt  ,
                                            int blk, LAS unsigned char* lds, int wave_s) {
    const int lane = pg8::lane_id_v(), wid = wave_s, tid = wid * 64 + lane, t16 = lane & 15, q4 = lane >> 4;
    LAS unsigned* hist = (LAS unsigned*)(lds + TB_OFF) + TB_HIST;
    LAS unsigned* base = (LAS unsigned*)(lds + TB_OFF) + TB_BASE;
    if (tid < NCNT) hist[tid] = 0u;
    const unsigned tokA = (unsigned)blk * 256u + 32u * wid + t16, tokB = tokA + 16u;
    const bf16* srA = S + (size_t)tokA * DM + 8 * q4; const bf16* srB = S + (size_t)tokB * DM + 8 * q4;
    v4u ra[32], rb[32];
#pragma unroll
    for (int s = 0; s < 32; ++s) ra[s] = *(const v4u*)(srA + 32 * s);
    LAS float* gbl = (LAS float*)(lds + RING_OFF);
    { const f32x4 gq = *(const f32x4*)(((tid < 256) ? g1v : b1v) + 4 * (tid & 255)); *(LAS f32x4*)(gbl + 4 * tid) = gq; }
    LAS unsigned char* wl = lds + RING_OFF + 8192;
#pragma unroll
    for (int i = 0; i < 9; ++i) { const int pc = tid + 512 * i, p = pc >> 7, c16 = pc & 127;
        const int src = (p < 16) ? (8 * (p >> 2) + (p & 3)) : ((p < 32) ? (8 * ((p - 16) >> 2) + 4 + (p & 3)) : p);
        *(LAS v4u*)(wl + p * 2064 + c16 * 16) = *(const v4u*)(Wrt + (size_t)src * DM + c16 * 8); }
    __syncthreads();
    const LAS unsigned char* wa0 = wl + t16 * 2064 + 16 * q4; const LAS unsigned char* wa1 = wa0 + 16 * 2064; const LAS unsigned char* wa2 = wl + (32 + (t16 & 3)) * 2064 + 16 * q4;

#define RT_MM(r_, c0_, c1_, c2_, mu_, rstd_)                                                                                                                   \
    f32x4 c0_ = (f32x4){0.f, 0.f, 0.f, 0.f}, c1_ = c0_, c2_ = c0_; float mu_, rstd_;                                                                            \
    {   float ssum = 0.f, ssq = 0.f;                                                                                                                            \
        _Pragma("unroll") for (int s4 = 0; s4 < 32; s4 += 4) {                                                                                                  \
            bf16x8 A0[4], A1[4], A2[4];                                                                                                                         \
            _Pragma("unroll") for (int q = 0; q < 4; ++q) { A0[q] = *(const LAS bf16x8*)(wa0 + 64 * (s4 + q)); A1[q] = *(const LAS bf16x8*)(wa1 + 64 * (s4 + q)); A2[q] = *(const LAS bf16x8*)(wa2 + 64 * (s4 + q)); } \
            _Pragma("unroll") for (int q = 0; q < 4; ++q) { const v4u x = r_[s4 + q]; const bf16x8 bfr = __builtin_bit_cast(bf16x8, x);                        \
                c0_ = __builtin_amdgcn_mfma_f32_16x16x32_bf16(A0[q], bfr, c0_, 0, 0, 0);                                                                        \
                c1_ = __builtin_amdgcn_mfma_f32_16x16x32_bf16(A1[q], bfr, c1_, 0, 0, 0);                                                                        \
                c2_ = __builtin_amdgcn_mfma_f32_16x16x32_bf16(A2[q], bfr, c2_, 0, 0, 0);                                                                        \
                const float x0 = bflo(x.x), x1 = bfhi(x.x), x2 = bflo(x.y), x3 = bfhi(x.y), x4 = bflo(x.z), x5 = bfhi(x.z), x6 = bflo(x.w), x7 = bfhi(x.w);     \
                ssum += ((x0 + x1) + (x2 + x3)) + ((x4 + x5) + (x6 + x7));                                                                                      \
                ssq += ((x0 * x0 + x1 * x1) + (x2 * x2 + x3 * x3)) + ((x4 * x4 + x5 * x5) + (x6 * x6 + x7 * x7)); }                                             \
        }                                                                                                                                                       \
        ssum = sum_x32(sum_x16(ssum)); ssq = sum_x32(sum_x16(ssq));                                                                                             \
        mu_ = ssum * (1.f / 1024.f); const float var = ssq * (1.f / 1024.f) - mu_ * mu_; rstd_ = fast_rsq(var + LN_EPS); }

#define RT_SEL(sel_, c0_, c1_, c2_, mu_, rstd_)                                                                                                                 \
    RSel sel_;                                                                                                                                                  \
    {   const float rsmu = rstd_ * mu_;                                                                                                                         \
        const f32x4 crA = *(const f32x4*)(cr + 8 * q4), crB = *(const f32x4*)(cr + 8 * q4 + 4), drA = *(const f32x4*)(dr + 8 * q4), drB = *(const f32x4*)(dr + 8 * q4 + 4); \
        const f32x4 crG = *(const f32x4*)(cr + 32), drG = *(const f32x4*)(dr + 32);                                                                             \
        const f32x4 gl = rstd_ * c2_ - rsmu * crG + drG;                                                                                                        \
        float gmax = gl[0]; int gi = 0;                                                                                                                         \
        if (gl[1] > gmax) { gmax = gl[1]; gi = 1; }                                                                                                             \
        if (gl[2] > gmax) { gmax = gl[2]; gi = 2; }                                                                                                             \
        if (gl[3] > gmax) { gmax = gl[3]; gi = 3; }                                                                                                             \
        const float gp = 1.0f / (expf(gl[0] - gmax) + expf(gl[1] - gmax) + expf(gl[2] - gmax) + expf(gl[3] - gmax));                                            \
        const f32x4 ea = rstd_ * c0_ - rsmu * crA + drA, eb = rstd_ * c1_ - rsmu * crB + drB;                                                                   \
        float v0 = -INFINITY, v1 = -INFINITY; int i0 = 0, i1 = 0;                                                                                               \
        _Pragma("unroll") for (int j = 0; j < 8; ++j) { const float v = (j < 4) ? ea[j & 3] : eb[j & 3];                                                        \
            if (v > v0) { v1 = v0; i1 = i0; v0 = v; i0 = j; } else if (v > v1) { v1 = v; i1 = j; } }                                                            \
        const float e1 = expf(v1 - v0);                                                                                                                         \
        sel_.g0 = gp / (1.0f + e1); sel_.g1 = gp * e1 / (1.0f + e1);                                                                                            \
        sel_.e0 = gi * 8 + i0; sel_.e1 = gi * 8 + i1;                                                                                                           \
        const int ia = i0 < i1 ? i0 : i1, ib = i0 < i1 ? i1 : i0;                                                                                               \
        sel_.pbin = gi * 28 + ((ia * (15 - ia)) >> 1) + (ib - ia - 1);                                                                                          \
        sel_.half0 = (i0 < i1) ? 0u : 1u;                                                                                                                       \
        sel_.own = (q4 == gi); sel_.r0 = 0u; sel_.r1 = 0u; sel_.rp = 0u;                                                                                        \
        if (sel_.own) { sel_.r0 = __hip_atomic_fetch_add(hist + sel_.e0, 1u, __ATOMIC_RELAXED, __HIP_MEMORY_SCOPE_WORKGROUP); sel_.r1 = __hip_atomic_fetch_add(hist + sel_.e1, 1u, __ATOMIC_RELAXED, __HIP_MEMORY_SCOPE_WORKGROUP); \
                        sel_.rp = __hip_atomic_fetch_add(hist + NEB + sel_.pbin, 1u, __ATOMIC_RELAXED, __HIP_MEMORY_SCOPE_WORKGROUP); } }

#define RT_NORM(r_, xrow_, mu_, rstd_, PREF_)                                                                                                                   \
    _Pragma("unroll") for (int s = 0; s < 32; ++s) { v4u x = r_[s]; asm volatile("" : "+v"(x));        \
        const f32x4 ga = *(const LAS f32x4*)(gbl + 32 * s + 8 * q4), gb = *(const LAS f32x4*)(gbl + 32 * s + 8 * q4 + 4), ba = *(const LAS f32x4*)(gbl + 1024 + 32 * s + 8 * q4), bb = *(const LAS f32x4*)(gbl + 1024 + 32 * s + 8 * q4 + 4); \
        f32x4 x0 = (f32x4){bflo(x.x), bfhi(x.x), bflo(x.y), bfhi(x.y)}, x1 = (f32x4){bflo(x.z), bfhi(x.z), bflo(x.w), bfhi(x.w)};                               \
        x0 = (x0 - mu_) * rstd_ * ga + ba; x1 = (x1 - mu_) * rstd_ * gb + bb;                                                                                   \
        v4u w; w.x = pkbf(x0[0], x0[1]); w.y = pkbf(x0[2], x0[3]); w.z = pkbf(x1[0], x1[1]); w.w = pkbf(x1[2], x1[3]);                                          \
        *(v4u*)(xrow_ + 32 * s) = w;                                                                                                                            \
        PREF_                                                                                                                                                   \
        if ((s & 3) == 3) __builtin_amdgcn_sched_barrier(0); }

    RT_MM(ra, a0, a1, a2, muA, rstdA)
    { bf16* xrA = XN + (size_t)tokA * DM + 8 * q4;
      RT_NORM(ra, xrA, muA, rstdA, rb[s] = *(const v4u*)(srB + 32 * s);) }
    RT_SEL(selA, a0, a1, a2, muA, rstdA)
    RT_MM(rb, b0, b1, b2, muB, rstdB)
    RT_SEL(selB, b0, b1, b2, muB, rstdB)
    __syncthreads();
    unsigned gbase = 0u;
    if (tid < NCNT) gbase = __hip_atomic_fetch_add(cnt + tid, hist[tid], RLX_AGENT);
    { bf16* xrB = XN + (size_t)tokB * DM + 8 * q4;
      RT_NORM(rb, xrB, muB, rstdB, ;) }
#undef RT_MM
#undef RT_SEL
#undef RT_NORM
    if (tid < NCNT) base[tid] = gbase;
    __syncthreads();
#pragma unroll
    for (int g = 0; g < 2; ++g) { const RSel& sl = g ? selB : selA; const unsigned tok = g ? tokB : tokA;
        if (sl.own) {
            const unsigned ps = base[NEB + sl.pbin] + sl.rp;
            PLIST[(size_t)sl.pbin * NTOK + ps] = (int)tok;
            const size_t s0 = (size_t)sl.e0 * NTOK + base[sl.e0] + sl.r0, s1 = (size_t)sl.e1 * NTOK + base[sl.e1] + sl.r1;
            ELIST[s0] = (int)tok; EGATE[s0] = sl.g0; EDEST[s0] = (int)(((unsigned)sl.pbin << 18) | (ps << 1) | sl.half0);
            ELIST[s1] = (int)tok; EGATE[s1] = sl.g1; EDEST[s1] = (int)(((unsigned)sl.pbin << 18) | (ps << 1) | (sl.half0 ^ 1u));
        } }
    __syncthreads();
}

__device__ __forceinline__ void moe_setup(const gu32* cnt, const int* ELIST, const int* EDEST, const float* EGATE, const int* PLIST, int G, int vcu, LAS unsigned char* lds, int wave_s) {
    const int tid = wave_s * 64 + pg8::lane_id_v();
    LAS int* tb = (LAS int*)(lds + TB_OFF);
    LAS int* tbE = tb + TB_TBE; LAS int* clE = tb + TB_CLE; LAS int* tbP = tb + TB_TBP; LAS int* clP = tb + TB_CLP;
    LAS int* ut = (LAS int*)(lds + UT_OFF);
    LAS int* tab = (LAS int*)(lds + TAB_OFF); LAS float* tab2 = (LAS float*)(lds + TAB2_OFF); LAS unsigned short* gtab = (LAS unsigned short*)(lds + GTAB_OFF);
    if (tid < NEB) clE[tid] = (int)__hip_atomic_load(cnt + tid, RLX_AGENT);
    else if (tid < NCNT) clP[tid - NEB] = (int)__hip_atomic_load(cnt + tid, RLX_AGENT);
    __syncthreads();
    if (tid < NEB) { int a = 0; for (int j = 0; j < NEB; ++j) { const int tj = (clE[j] + 255) >> 8; a += (j < tid) ? tj : 0; if (tid == NEB - 1 && j == NEB - 1) tbE[NEB] = a + tj; } tbE[tid] = a; }
    else if (tid < NCNT) { const int me = tid - NEB; int a = 0; for (int j = 0; j < NPB; ++j) { const int tj = (clP[j] + 255) >> 8; a += (j < me) ? tj : 0; if (me == NPB - 1 && j == NPB - 1) tbP[NPB] = a + tj; } tbP[me] = a; }
    __syncthreads();
    LAS int* ut6 = (LAS int*)(lds + P6UT_OFF); LAS unsigned short* tab6 = (LAS unsigned short*)(lds + P6TAB_OFF);
    if (tid < NU_MAX) {
        const int L = tid * G + vcu;
        int nv = -1, tile = 0, pn = 0, bin = 0, rb = 0;
        if (L < tbE[NEB] * 4) { tile = L >> 2; pn = L & 3;
            for (int b = 0; b < NEB; ++b) if (tile >= tbE[b] && tile < tbE[b + 1]) bin = b;
            rb = (tile - tbE[bin]) * 256; nv = clE[bin] - rb; nv = nv > 256 ? 256 : nv; }
        ut[tid * 8 + 0] = tile; ut[tid * 8 + 1] = pn; ut[tid * 8 + 2] = bin; ut[tid * 8 + 3] = bin; ut[tid * 8 + 4] = rb; ut[tid * 8 + 5] = nv; ut[tid * 8 + 6] = tid;
    } else if (tid >= 64 && tid < 64 + NU6_MAX) {
        const int i6 = tid - 64, L = i6 * G + vcu;
        int nv = -1, tile = 0, pn = 0, bin = 0, rb = 0, e = 0, e2 = 0;
        if (L < tbP[NPB] * 4) { tile = L >> 2; pn = L & 3;
            for (int b = 0; b < NPB; ++b) if (tile >= tbP[b] && tile < tbP[b + 1]) bin = b;
            rb = (tile - tbP[bin]) * 256; nv = clP[bin] - rb; nv = nv > 256 ? 256 : nv;
            const int gi = bin / 28; int idx = bin % 28, ia = 0; while (idx >= 7 - ia) { idx -= 7 - ia; ++ia; }
            e = gi * 8 + ia; e2 = gi * 8 + ia + 1 + idx; }
        ut6[i6 * 8 + 0] = tile; ut6[i6 * 8 + 1] = pn; ut6[i6 * 8 + 2] = e; ut6[i6 * 8 + 3] = bin; ut6[i6 * 8 + 4] = rb; ut6[i6 * 8 + 5] = nv; ut6[i6 * 8 + 6] = e2;
    }
    __syncthreads();
    {
        constexpr int NE = NU_MAX * 256 / (NWAVES * 64), NE6 = NU6_MAX * 256 / (NWAVES * 64);
        int tokv[NE], dv[NE]; float gv[NE]; int tok6[NE6];
#pragma unroll
        for (int q = 0; q < NE; ++q) { const int en = tid + q * (NWAVES * 64), i = en >> 8, r = en & 255; const int nv = ut[i * 8 + 5];
            tokv[q] = 0; dv[q] = -1; gv[q] = 0.f;
            if (r < nv) { const size_t idx = (size_t)ut[i * 8 + 3] * NTOK + ut[i * 8 + 4] + r; tokv[q] = ELIST[idx]; dv[q] = EDEST[idx]; gv[q] = EGATE[idx]; } }
#pragma unroll
        for (int q = 0; q < NE6; ++q) { const int en = tid + q * (NWAVES * 64), i = en >> 8, r = en & 255; const int nv = ut6[i * 8 + 5];
            tok6[q] = 0xffff;
            if (r < nv) tok6[q] = PLIST[(size_t)ut6[i * 8 + 3] * NTOK + ut6[i * 8 + 4] + r]; }
#pragma unroll
        for (int q = 0; q < NE; ++q) { const int en = tid + q * (NWAVES * 64); gtab[en] = (unsigned short)tokv[q]; tab[en] = dv[q]; tab2[en] = gv[q]; }
#pragma unroll
        for (int q = 0; q < NE6; ++q) tab6[tid + q * (NWAVES * 64)] = (unsigned short)tok6[q];
    }
    __syncthreads();
    if (tid < NU6_MAX) ut6[tid * 8 + 4] = tid;
    __syncthreads();
}

__global__ void __launch_bounds__(NWAVES * 64, 2) mega_fwd(Args args) {
    extern __shared__ __attribute__((aligned(16))) unsigned char lds_raw[];
    LAS unsigned char* lds = (LAS unsigned char*)lds_raw;
    volatile LAS unsigned* MISC = (volatile LAS unsigned*)(lds + MISC_OFF);
    const int wave = __builtin_amdgcn_readfirstlane((int)threadIdx.x >> 6);
#define LANE_TID() const int lane = pg8::lane_id_v(); const int tid = wave * 64 + lane; (void)tid
    const int G = gridDim.x; const int bx = blockIdx.x; const int vcu = (G % 8 == 0) ? (bx % 8) * (G / 8) + bx / 8 : bx;
    unsigned char* ws_top = args.ws;
    gu32* ctl = (gu32*)(ws_top + WS_CTL);
#define WS_PTRS() GAS unsigned char* wsg_ = (GAS unsigned char*)ws_top; asm volatile("" : "+s"(wsg_)); unsigned char* ws = (unsigned char*)wsg_;     \
    float* VEC = (float*)(ws + WS_VEC); float* CS = (float*)(ws + WS_ROPE); \
    bf16* WIN = (bf16*)(ws + WS_WIN); bf16* WOUT = (bf16*)(ws + WS_WOUT); bf16* WRT = (bf16*)(ws + WS_WRT); bf16* WSGU = (bf16*)(ws + WS_WSGU); \
    bf16* WGU = (bf16*)(ws + WS_WGU); bf16* WD = (bf16*)(ws + WS_WD); \
    bf16* Sb = (bf16*)(ws + WS_S); float* ST = (float*)(ws + WS_ST); float* RS0 = (float*)(ws + WS_RS0); bf16* XN1 = (bf16*)(ws + WS_MIXED); \
    bf16* PROJ = (bf16*)(ws + WS_PROJ); bf16* MIXED = (bf16*)(ws + WS_MIXED); bf16* PART = (bf16*)(ws + WS_PART); float* ML = (float*)(ws + WS_ML); \
    bf16* Hb = (bf16*)(ws + WS_H); int* ELIST = (int*)(ws + WS_ELIST); int* EDEST = (int*)(ws + WS_EDEST); float* EGATE = (float*)(ws + WS_EGATE); int* PLIST = (int*)(ws + WS_PLIST); \
    (void)VEC; (void)CS; (void)WIN; (void)WOUT; (void)WRT; (void)WSGU; (void)WGU; (void)WD; (void)Sb; (void)ST; (void)RS0; (void)XN1; (void)PROJ; (void)MIXED; (void)PART; (void)ML; (void)Hb; (void)ELIST; (void)EDEST; (void)EGATE; (void)PLIST
    const float* x_in = args.in[0]; const float* w_in = args.in[1]; const float* w_out = args.in[2]; const float* branch_gain = args.in[3]; const float* sgu_gain = args.in[4];
    const float* sgu_w = args.in[5]; const float* sgu_b = args.in[6]; const float* conv_w = args.in[7]; const float* ln_gain = args.in[8]; const float* ln_bias = args.in[9];
    const float* rgw = args.in[10]; const float* rgb = args.in[11]; const float* rew = args.in[12]; const float* reb = args.in[13];
    const float* ewg = args.in[14]; const float* ewu = args.in[15]; const float* ewd = args.in[16];

    { LANE_TID(); for (int u = tid; u < (LDS_BYTES - TAB_OFF) / 4; u += NWAVES * 64) ((LAS unsigned*)(lds + TAB_OFF))[u] = 0u; }
    __syncthreads();
    XcdBarrier bar = xcd_barrier_post((unsigned*)(ctl + CW_BAR), MISC + 8);
    const int gw = vcu * NWAVES + wave, NGW = G * NWAVES;
    const bool own_rows = (G == NTOK / 256);
#define LOCAL_SEAM() do { asm volatile("s_waitcnt vmcnt(0)" ::: "memory"); __builtin_amdgcn_fence(__ATOMIC_RELEASE, "workgroup"); __syncthreads(); __builtin_amdgcn_fence(__ATOMIC_ACQUIRE, "workgroup"); } while (0)
#ifndef REP_MASK
#define REP_MASK 0
#endif
#define REPS(idx) for (int rep_ = 0; rep_ < 1 + ((REP_MASK >> (idx)) & 1); ++rep_)
#ifdef STAMP_A
    volatile LAS unsigned* tacc = (volatile LAS unsigned*)(lds + MISC_OFF + 64);
    unsigned long long t_last = __builtin_amdgcn_s_memrealtime();
#define STAMP(ty) do { const unsigned long long _n = __builtin_amdgcn_s_memrealtime(); if (wave == 0 && pg8::lane_id_v() == 0) tacc[ty] += (unsigned)(_n - t_last); t_last = _n; } while (0)
#else
#define STAMP(ty) do { } while (0)
#endif
    LAS float* scr = (LAS float*)(lds + RING_OFF + wave * 16384);
    const int lo = args.ph_lo, hi_ph = args.ph_hi;
#ifndef PHASE_MASK
#define PHASE_MASK 0xFFFFu
#endif
#define IN(k) (((PHASE_MASK >> ((k) == 0 ? 0 : ((k) == 99 ? 9 : 1 + (((k) - 1) & 15)))) & 1u) && lo <= (k) && (k) < hi_ph)

    if (IN(0)) REPS(0) {
        WS_PTRS(); LANE_TID();
        for (int i = gw * 64 + lane; i < 1024; i += NGW * 64) { VEC[V_ONES + i] = 1.0f; VEC[V_ZEROS + i] = 0.0f; }
        const int NRW = NGW - 512, rw = gw - 512;
        if (rw >= 0)
        for (int m0 = rw; m0 < NTOK; m0 += 8 * NRW) {
            f32x4 v[8][4];
#pragma unroll
            for (int b = 0; b < 8; ++b) { const int m = m0 + b * NRW; const GAS f32x4* xr = (const GAS f32x4*)(x_in + (size_t)(m < NTOK ? m : 0) * DM) + lane;
#pragma unroll
                for (int j = 0; j < 4; ++j) v[b][j] = xr[64 * j]; }
#pragma unroll
            for (int b = 0; b < 8; ++b) { const int m = m0 + b * NRW; if (m < NTOK) { GAS v2u* o8 = (GAS v2u*)(Sb + (size_t)m * DM) + lane;
#pragma unroll
                for (int j = 0; j < 4; ++j) { v2u w; w.x = pkbf(v[b][j][0], v[b][j][1]); w.y = pkbf(v[b][j][2], v[b][j][3]); o8[64 * j] = w; }
                if (lane < 32) ST[(size_t)m * 32 + lane] = (lane == 1) ? 1024.0f * (1.0f - LN_EPS) : 0.0f; } }
        }
        for (int i = gw * 64 + lane; i < SEQ * 32; i += NGW * 64) { const int t = i >> 5, f = i & 31; const float inv_freq = powf(10000.0f, -(float)f / 32.0f); const float ang = (float)t * inv_freq;
            float sn, cn; sincosf(ang, &sn, &cn); CS[2 * i] = cn; CS[2 * i + 1] = sn; }
        constexpr int I_IN = 4 * 88, I_OUT = 4 * 32;
        for (int it = gw; it < I_IN + I_OUT; it += NGW) {
            if (it < I_IN) { const int l = it / 88, nb = it % 88, n0 = nb * 32;
                const float* sc = (l == 0) ? nullptr : ln_gain + (size_t)(l - 1) * 2048 + 1024; const float* bk = (l == 0) ? nullptr : ln_bias + (size_t)(l - 1) * 2048 + 1024;
                bf16* wt = WIN + ((size_t)l * PW + n0) * DM; float* cs = VEC + V_CIN + l * PW + n0; float* ds = VEC + V_DIN + l * PW + n0;
                if (n0 < 1024) conv_item(w_in + (size_t)l * DM * PW, DM, PW, ColRope(), n0, wt, 1, sc, bk, cs, ds, scr, lane);
                else if (n0 >= OGC) conv_item(w_in + (size_t)l * DM * PW, DM, PW, ColConv(), n0, wt, 1, sc, bk, cs, ds, scr, lane);
                else conv_item(w_in + (size_t)l * DM * PW, DM, PW, ColId(), n0, wt, 1, sc, bk, cs, ds, scr, lane);
            } else { const int r = it - I_IN, l = r / 32, n0 = (r % 32) * 32;
                conv_item(w_out + (size_t)l * DM * DM, DM, DM, ColId(), n0, WOUT + ((size_t)l * DM + n0) * DM, 1, branch_gain + (size_t)l * 1024, nullptr, nullptr, nullptr, scr, lane); }
        }
        for (int i = gw * 64 + lane; i < 4 * 4 * 128 * 128; i += NGW * 64) {
            const int p = i & 15, s = (i & 112) + 8 * ((p & 7) >> 2) + 4 * (p >> 3) + (p & 3), t = (i >> 7) & 127; WSGU[i] = (bf16)(pkbf((s <= t) ? sgu_w[(i & ~127) + s] : 0.0f, 0.f) & 0xffffu); }
        for (int it = gw; it < 4 * 64; it += NGW) {
            const int l = it >> 6, n = it & 63; const float* g1 = ln_gain + (size_t)l * 2048; const float* b1 = ln_bias + (size_t)l * 2048;
            float cs = 0.f, ds = 0.f;
            for (int k = lane; k < DM; k += 64) { float w = 0.f; if (n < 32) w = rew[((size_t)l * DM + k) * 32 + n]; else if (n < 36) w = rgw[((size_t)l * DM + k) * 4 + (n - 32)];
                const float v = rbf(w * g1[k]); cs += v; ds += b1[k] * w; WRT[((size_t)l * 64 + n) * DM + k] = (bf16)(pkbf(v, 0.f) & 0xffffu); }
            cs = wave_sum(cs); ds = wave_sum(ds);
            if (lane == 0) { float bias = 0.f; if (n < 32) bias = reb[l * 32 + n]; else if (n < 36) bias = rgb[l * 4 + n - 32]; VEC[V_CR + l * 64 + n] = cs; VEC[V_DR + l * 64 + n] = ds + bias; }
        }
        xcd_barrier(bar);
        STAMP(0);
    }

    for (int l = 0; l < args.nlayers; ++l) {
        const int pb = 1 + l * 16;
        const float* G1 = ln_gain + (size_t)l * 2048; const float* B1 = ln_bias + (size_t)l * 2048;
        gu32* cnt = ctl + CW_CNT + l * 256;

        if (IN(pb + 0)) REPS(1) {
            WS_PTRS();
#ifdef STAGGER_P1
            if (vcu & 1) { const unsigned long long s0_ = __builtin_amdgcn_s_memrealtime(); while (__builtin_amdgcn_s_memrealtime() - s0_ < (unsigned long long)(STAGGER_P1)) __builtin_amdgcn_s_sleep(8); }
#endif
            pg8::Gemm g{Sb, WIN + (size_t)l * PW * DM, DM}; pg8::DenseOrder S; S.init(NTOK, PW, DM, G, bx);
            { LAS float* xt = (LAS float*)(lds + TAB_OFF); const int tid_ = wave * 64 + pg8::lane_id_v();
              for (int i = tid_; i < PW; i += NWAVES * 64) { xt[XT_C + i] = VEC[V_CIN + l * PW + i]; xt[XT_D + i] = VEC[V_DIN + l * PW + i]; }
              if (tid_ == 0) ((LAS int*)xt)[XT_LASTPM] = -1;
              __syncthreads(); }
            EpiProj E{PROJ, VEC + V_CIN + l * PW, VEC + V_DIN + l * PW, ST, RS0, CS, (LAS float*)(lds + TAB_OFF)};
            pg8::gemm_phase<EpiProj, pg8::DenseOrder, false>(lds + RING_OFF, g, S, E, nullptr, wave);
            xcd_barrier(bar);
            STAMP(1);
        }
        if (IN(pb + 1)) REPS(2) {
            WS_PTRS();
            attn_phase(PROJ, PART, ML, vcu, G, lds, wave);
            xcd_barrier(bar);
            STAMP(2);
        }
        if (IN(pb + 2)) REPS(3) {
            WS_PTRS(); LANE_TID();
            TS_DECL(); TS_BEGIN(301);
            if (own_rows) {
                for (int c = 2 * vcu; c < 2 * vcu + 2; ++c) sgu_unit(PROJ, MIXED, WSGU + (size_t)l * 4 * 128 * 128, sgu_gain + (size_t)l * 256, sgu_b + (size_t)l * 512, c, lds, wave);
                const size_t t0 = (size_t)vcu * 256 + wave * 32;
                for (int j = 0; j < 32; j += 4) { combine_tokens<4>(PART, ML, MIXED, t0 + j, (size_t)1, lane); conv_tokens<4>(PROJ, conv_w + (size_t)l * 768, MIXED, t0 + j, (size_t)1, lane); }
                LOCAL_SEAM();
            } else {
            for (int c = vcu; c < NTOK / 128; c += G) sgu_unit(PROJ, MIXED, WSGU + (size_t)l * 4 * 128 * 128, sgu_gain + (size_t)l * 256, sgu_b + (size_t)l * 512, c, lds, wave);
            TS_END(301, lds, wave); TS_BEGIN(302);
            for (int m = gw; m < NTOK; m += 4 * NGW) { combine_tokens<4>(PART, ML, MIXED, (size_t)m, (size_t)NGW, lane); conv_tokens<4>(PROJ, conv_w + (size_t)l * 768, MIXED, (size_t)m, (size_t)NGW, lane); }
            TS_END(302, lds, wave);
            xcd_barrier(bar);
            }
            STAMP(3);
        }
        if (IN(pb + 3)) REPS(4) {
            WS_PTRS();
            pg8::Gemm g{MIXED, WOUT + (size_t)l * DM * DM, DM}; pg8::DenseOrder S; S.init(NTOK, DM, DM, G, bx); if (own_rows) S.own_pm = vcu;
            const float* Gp = (l == 0) ? VEC + V_ONES : ln_gain + (size_t)(l - 1) * 2048 + 1024;
            const float* Bp = (l == 0) ? VEC + V_ZEROS : ln_bias + (size_t)(l - 1) * 2048 + 1024;
            EpiRes1 E{Sb, RS0, Gp, Bp, (rep_ == ((REP_MASK >> 4) & 1)) ? Sb : PROJ};
            pg8::gemm_phase<EpiRes1, pg8::DenseOrder, false>(lds + RING_OFF, g, S, E, nullptr, wave);
            if (own_rows) { LOCAL_SEAM(); } else xcd_barrier(bar);
            STAMP(4);
        }
        if (IN(pb + 4)) REPS(5) {
            WS_PTRS(); LANE_TID();
            for (int blk = vcu; blk < NTOK / 256; blk += G) route_block(Sb, WRT + (size_t)l * 64 * DM, VEC + V_CR + l * 64, VEC + V_DR + l * 64, G1, B1, XN1, ELIST, EDEST, EGATE, PLIST, cnt, blk, lds, wave);
            TS_DECL(); TS_BEGIN(404);
            for (int rc_ = 0; rc_ < 1 + ((REP_MASK >> 10) & 1); ++rc_)
            for (int it0 = gw; it0 < 2048; it0 += NGW) {
                const int it = it0 >> 1, e = it >> 5, mat = (it >> 4) & 1, n0 = (it & 15) * 32, kh = (it0 & 1) * 512;
                const float* W = (mat ? ewu : ewg) + ((size_t)l * 32 + e) * DM * 512;
                conv_item(W + (size_t)kh * 512, 512, 512, ColId(), n0, WGU + ((size_t)e * 1024 + 2 * n0 + mat) * DM + kh, 2, nullptr, nullptr, nullptr, nullptr, scr, lane, DM);
            }
            TS_END(404, lds, wave);
            xcd_barrier(bar);
            STAMP(5);
        }
        if (IN(pb + 5)) REPS(6) {
            WS_PTRS();
            { TS_DECL(); TS_BEGIN(501); moe_setup(cnt, ELIST, EDEST, EGATE, PLIST, G, vcu, lds, wave); TS_END(501, lds, wave); }
            pg8::Gemm g{XN1, WGU, DM}; MoeOrder S{(const LAS int*)(lds + UT_OFF), DM, DM, (size_t)1024 * DM * 2, NU_MAX};
            EpiSwiglu E{Hb, (const LAS int*)(lds + TAB_OFF), (const LAS float*)(lds + TAB2_OFF), (const LAS int*)(lds + TB_OFF) + TB_TBP};
            pg8::gemm_phase<EpiSwiglu, MoeOrder, true, false>(lds + RING_OFF, g, S, E, (const LAS unsigned short*)(lds + GTAB_OFF), wave);
            {   const int T5 = __builtin_amdgcn_readfirstlane(((const LAS int*)(lds + TB_OFF))[TB_TBE + NEB]) * 4, nmax = (T5 + G - 1) / G;
                int x = T5 - (nmax - 1) * G; if (x >= G) x = 0;
                if (vcu >= x) { LANE_TID(); __syncthreads();
                    for (int it = (vcu - x) * NWAVES + wave; it < 1024; it += (G - x) * NWAVES) { const int e = it >> 5, n0 = (it & 31) * 32;
                        conv_item(ewd + ((size_t)l * 32 + e) * 512 * DM, 512, DM, ColId(), n0, WD + ((size_t)e * 1024 + n0) * 512, 1, nullptr, nullptr, nullptr, nullptr, scr, lane); } } }
            xcd_barrier(bar);
            STAMP(6);
        }
        if (IN(pb + 6)) REPS(7) {
            WS_PTRS();
            pg8::Gemm g{Hb, WD, DM}; MoeOrder S{(const LAS int*)(lds + P6UT_OFF), DM, 512, (size_t)1024 * 512 * 2, NU6_MAX};
            EpiDown E{Sb, XN1, (const LAS unsigned short*)(lds + P6TAB_OFF), ST};
            pg8::gemm_phase<EpiDown, MoeOrder, false, true>(lds + RING_OFF, g, S, E, nullptr, wave);
            xcd_barrier(bar);
            STAMP(7);
        }
    }
    if (IN(99)) REPS(9) {
        WS_PTRS(); LANE_TID();
        const int l = args.nlayers - 1;
        const float* G2 = ln_gain + (size_t)l * 2048 + 1024; const float* B2 = ln_bias + (size_t)l * 2048 + 1024;
        const unsigned poison = (__hip_atomic_load(ctl + CW_BAR + XB_TMO, RLX_AGENT) != 0u);
        for (int m0 = gw; m0 < NTOK; m0 += 4 * NGW) {
            float s[4], q[4]; v4u o[4][2];
#pragma unroll
            for (int b = 0; b < 4; ++b) { const int m = m0 + b * NGW; s[b] = 0.f; q[b] = 0.f;
                if (lane < 16) { const f32x2 p = *(const f32x2*)(ST + (size_t)m * 32 + 2 * lane); s[b] = p.x; q[b] = p.y; }
#pragma unroll
                for (int j = 0; j < 2; ++j) o[b][j] = *(const v4u*)(Sb + (size_t)m * DM + 512 * j + 8 * lane); }
#pragma unroll
            for (int b = 0; b < 4; ++b) { s[b] = wave_sum(s[b]); q[b] = wave_sum(q[b]); }
#pragma unroll
            for (int b = 0; b < 4; ++b) { const int m = m0 + b * NGW;
                const float mu = s[b] * (1.f / 1024.f); const float var = q[b] * (1.f / 1024.f) - mu * mu; float rstd = fast_rsq(var + LN_EPS);
                if (poison) rstd = __builtin_nanf("");
#pragma unroll
                for (int j = 0; j < 2; ++j) {
                    const int c = 512 * j + 8 * lane;
                    const f32x4 g0 = *(const f32x4*)(G2 + c), g1 = *(const f32x4*)(G2 + c + 4), b0 = *(const f32x4*)(B2 + c), b1 = *(const f32x4*)(B2 + c + 4);
                    f32x4 x0 = (f32x4){bflo(o[b][j].x), bfhi(o[b][j].x), bflo(o[b][j].y), bfhi(o[b][j].y)}, x1 = (f32x4){bflo(o[b][j].z), bfhi(o[b][j].z), bflo(o[b][j].w), bfhi(o[b][j].w)};
                    x0 = (x0 - mu) * rstd * g0 + b0; x1 = (x1 - mu) * rstd * g1 + b1;
                    *(f32x4*)(args.out + (size_t)m * DM + c) = x0; *(f32x4*)(args.out + (size_t)m * DM + c + 4) = x1;
                } }
        }
    }
#undef IN
#ifdef TSEC
    { __syncthreads(); const unsigned tot = ((volatile LAS unsigned*)(lds + MISC_OFF + 64))[wave]; const unsigned long long s0 = __builtin_amdgcn_s_memrealtime();
      while (__builtin_amdgcn_s_memrealtime() - s0 < (unsigned long long)tot) __builtin_amdgcn_s_sleep(8); }
#endif
}

static int g_grid = 0;
static int mega_prepare() {
    if (g_grid != 0) return g_grid;
    int dev = 0, cus = 0, per_cu = 0;
    if (hipGetDevice(&dev) != hipSuccess || hipDeviceGetAttribute(&cus, hipDeviceAttributeMultiprocessorCount, dev) != hipSuccess) { g_grid = -1; return g_grid; }
    if (hipFuncSetAttribute((const void*)mega_fwd, hipFuncAttributeMaxDynamicSharedMemorySize, LDS_BYTES) != hipSuccess) { fprintf(stderr, "hipFuncSetAttribute failed\n"); g_grid = -1; return g_grid; }
    if (hipOccupancyMaxActiveBlocksPerMultiprocessor(&per_cu, (const void*)mega_fwd, NWAVES * 64, LDS_BYTES) != hipSuccess || per_cu < 1) { fprintf(stderr, "occupancy query: %d blocks per CU\n", per_cu); }
    (void)hipGetLastError();
    g_grid = cus;
    return g_grid;
}
static void mega_launch(void* const* d_in, float* out, unsigned char* ws, hipStream_t stream, int ph_lo, int ph_hi, int nlayers) {
    const int grid = mega_prepare(); if (grid <= 0) return;
    (void)hipMemsetAsync(ws + WS_CTL, 0, CTL_ZERO_BYTES, stream);
    Args a{};
    for (int i = 0; i < 17; ++i) a.in[i] = (const float*)d_in[i];
    a.out = out; a.ws = ws; a.ph_lo = ph_lo; a.ph_hi = ph_hi; a.nlayers = nlayers; a.pad = 0;
    hipLaunchKernelGGL(mega_fwd, dim3(grid), dim3(NWAVES * 64), LDS_BYTES, stream, a);
}
extern "C" void kernel_launch(void* const* d_in, const int* in_sizes, int n_in, void* d_out, int out_size, void* d_ws, size_t ws_size, hipStream_t stream) {
    if (n_in != 17 || ws_size < WS_END) { fprintf(stderr, "kernel_launch: unexpected n_in %d / ws_size %zu\n", n_in, ws_size); return; }
    mega_launch(d_in, (float*)d_out, (unsigned char*)d_ws, stream, 0, 100, NL);
}
```

```cpp
#include <hip/hip_runtime.h>
#include <cstdio>
#include <cstdint>
#include <cmath>
namespace pg8 {
#define PG8_LAS __attribute__((address_space(3)))
typedef unsigned short bf16_t;
typedef short bf16x8 __attribute__((ext_vector_type(8)));
typedef float f32x4 __attribute__((ext_vector_type(4)));
typedef float f32x2 __attribute__((ext_vector_type(2)));
typedef unsigned u32x4 __attribute__((ext_vector_type(4)));
typedef unsigned u32x2 __attribute__((ext_vector_type(2)));
constexpr int BM = 256, BK = 64, HALF = 128, HTB = HALF * BK * 2  , STAGE_BYTES = 8 * HTB, NXCD = 8, WGM = 8;

__host__ __device__ __forceinline__ int lds_byte(int r, int c) { const int st = (r >> 4) * 2 + (c >> 5), rr = r & 15, cc = c & 31, ob = rr * 64 + cc * 2; return st * 1024 + (ob ^ (((ob >> 9) & 1) << 5)); }
__host__ __device__ __forceinline__ void stage_rc(int b, int& R, int& C) { const int st = b / 1024, sb = b % 1024, swz = sb ^ (((sb >> 9) & 1) << 5); R = (st >> 1) * 16 + swz / 64; C = (st & 1) * 32 + (swz % 64) / 2; }
__host__ __device__ __forceinline__ int perm32(int rho) { const int n = rho >> 4, i = rho & 15; return 8 * (i >> 2) + 4 * n + (i & 3); }

struct Unit { int pm, pn, e, bin, rbase, nvalid, e2; };
struct Gemm { const bf16_t* A; const bf16_t* Bt; int K; };

struct DenseOrder {
    int nM, nN, nwg, G, c, K, own_pm;
    __device__ __forceinline__ void init(int M, int N, int K_, int G_, int c_) { nM = M / BM; nN = N / BM; nwg = nM * nN; G = G_; c = c_; K = K_; own_pm = -1; }
    __device__ __forceinline__ bool next(int i, Unit& u) const {
        if (own_pm >= 0) { if (i >= nN) return false; u.pm = own_pm; u.pn = i; u.e = 0; u.bin = 0; u.rbase = 0; u.nvalid = 256; u.e2 = 0; return true; }
        const long L = (long)i * G + c; if (L >= nwg) return false;
        int wgid = (int)L; { const int q = nwg / NXCD, r = nwg % NXCD, xcd = wgid % NXCD, off = wgid / NXCD; wgid = (xcd < r ? xcd * (q + 1) : r * (q + 1) + (xcd - r) * q) + off; }
        const int nig = WGM * nN, gid = wgid / nig, fm = gid * WGM, gsz = (nM - fm) < WGM ? (nM - fm) : WGM;
        u.pm = fm + ((wgid % nig) % gsz); u.pn = (wgid % nig) / gsz; u.e = 0; u.bin = 0; u.rbase = 0; u.nvalid = 256; u.e2 = 0; return true;
    }
    __device__ __forceinline__ size_t a_off(const Unit& u) const { return (size_t)u.pm * (size_t)(BM * 2) * K; }
    __device__ __forceinline__ size_t b_off(const Unit& u) const { return (size_t)u.pn * (size_t)(BM * 2) * K; }
    __device__ __forceinline__ size_t b_off2(const Unit& u) const { return b_off(u); }
};

#ifdef TSEC
#define TS_DECL() unsigned long long ts0_ = 0
#define TS_BEGIN(id) do { if (TSEC == (id)) ts0_ = __builtin_amdgcn_s_memrealtime(); } while (0)
#define TS_END(id, ldsbase, wave) do { if (TSEC == (id)) { const unsigned long long d_ = __builtin_amdgcn_s_memrealtime() - ts0_; if (pg8::lane_id_v() == 0) ((volatile PG8_LAS unsigned*)((ldsbase) + 163840 - 256 + 64))[wave] += (unsigned)d_; } } while (0)
#else
#define TS_DECL() do { } while (0)
#define TS_BEGIN(id) do { } while (0)
#define TS_END(id, ldsbase, wave) do { } while (0)
#endif
__device__ __forceinline__ int lane_id_v() { int l; asm volatile("v_mbcnt_lo_u32_b32 %0, -1, 0\n\tv_mbcnt_hi_u32_b32 %0, -1, %0" : "=v"(l)); return l; }
__device__ __forceinline__ unsigned cvt_pk_bf16(float lo, float hi) { unsigned r; asm volatile("v_cvt_pk_bf16_f32 %0, %1, %2" : "=v"(r) : "v"(lo), "v"(hi)); return r; }

template <class Epi, class Sched, bool GATHER, bool DUALB = false>
__device__ __forceinline__ void gemm_phase(PG8_LAS unsigned char* lds, const Gemm g, const Sched& S, const Epi& E, const PG8_LAS unsigned short* tab, int wave_s) {
    const int lane = lane_id_v(), wid = wave_s, tid = wid * 64 + lane,
              wr = wid >> 2, wc = wid & 3, fr = lane & 15, fq = lane >> 4;
    const int K = g.K, nt = K / BK, Kb = DUALB ? K / 2 : K, nth = nt / 2;
    unsigned voffA[2], voffB[2]; int RA[2]; unsigned CA2[2];
#pragma unroll
    for (int i = 0; i < 2; ++i) { int R, C; stage_rc(tid * 16 + i * 8192, R, C); const int Rb = Epi::PERM ? ((R & ~31) + perm32(R & 31)) : R;
        voffA[i] = (unsigned)(R * K + C) * 2u; voffB[i] = (unsigned)(Rb * Kb + C) * 2u; RA[i] = R; CA2[i] = (unsigned)C * 2u; }
    const size_t kstep = (size_t)(BK * 2);
    const size_t hstep = (size_t)HALF * K * 2;
    const size_t hstepB = (size_t)HALF * Kb * 2;
    const unsigned ldsw = (unsigned)wid * 1024u;
    const int aoff = lds_byte(wr * 64 + fr, fq * 8), boff = lds_byte(wc * 32 + fr, fq * 8);
#define PG8_SA(b, h) (((b) * 2 + (h)) * HTB)
#define PG8_SB(b, h) ((4 + (b) * 2 + (h)) * HTB)
#define PG8_STAGE(bufoff, gbase, voff) do { _Pragma("unroll") for (int _i = 0; _i < 2; ++_i) \
        __builtin_amdgcn_global_load_lds((const unsigned*)((const char*)(gbase) + (voff)[_i]), (PG8_LAS unsigned*)(lds + (bufoff) + ldsw + _i * 8192), 16, 0, 0); } while (0)
#define PG8_LDA(dst, b, h) do { _Pragma("unroll") for (int m = 0; m < 4; ++m) _Pragma("unroll") for (int k = 0; k < 2; ++k) dst[m][k] = *(const PG8_LAS bf16x8*)(lds + PG8_SA(b, h) + aoff + m * 2048 + k * 1024); } while (0)
#define PG8_LDB(dst, b, h) do { _Pragma("unroll") for (int n = 0; n < 2; ++n) _Pragma("unroll") for (int k = 0; k < 2; ++k) dst[n][k] = *(const PG8_LAS bf16x8*)(lds + PG8_SB(b, h) + boff + n * 2048 + k * 1024); } while (0)
#define PG8_MMA(ai, bj, At, Bt) do { __builtin_amdgcn_s_setprio(1); _Pragma("unroll") for (int m = 0; m < 4; ++m) _Pragma("unroll") for (int n = 0; n < 2; ++n) _Pragma("unroll") for (int k = 0; k < 2; ++k) \
        acc[ai][bj][m][n] = __builtin_amdgcn_mfma_f32_16x16x32_bf16(Bt[n][k], At[m][k], acc[ai][bj][m][n], 0, 0, 0); __builtin_amdgcn_s_setprio(0); } while (0)
#define PG8_WAIT_V(n) asm volatile("s_waitcnt vmcnt(" #n ")" ::: "memory")
#define PG8_WAIT_L(n) asm volatile("s_waitcnt lgkmcnt(" #n ")" ::: "memory")
#define PG8_WAIT_V01(flag) do { if constexpr (Epi::NSTORE >= 16) { asm volatile("s_cmp_eq_u32 %0, 0\n\ts_cbranch_scc1 .Lw8_%=\n\ts_waitcnt vmcnt(24)\n\ts_branch .Lwd_%=\n.Lw8_%=:\n\ts_waitcnt vmcnt(8)\n.Lwd_%=:" :: "s"(__builtin_amdgcn_readfirstlane(flag)) : "memory", "scc"); } else { asm volatile("s_waitcnt vmcnt(8)" ::: "memory"); } } while (0)
#define PG8_BAR __builtin_amdgcn_s_barrier()
#define PG8_SCHED __builtin_amdgcn_sched_barrier(0)
    Unit cur, nxt; int ui = 0;
    if (!S.next(0, cur)) return;
    f32x4 acc[2][2][4][2];
#pragma unroll
    for (int a = 0; a < 2; ++a)
#pragma unroll
        for (int b = 0; b < 2; ++b)
#pragma unroll
            for (int m = 0; m < 4; ++m)
#pragma unroll
                for (int n = 0; n < 2; ++n) acc[a][b][m][n] = (f32x4){0.f, 0.f, 0.f, 0.f};
    bf16x8 At[4][2], B0[2][2], B1[2][2];
    [[maybe_unused]] u32x4 pq0 = (u32x4){0u, 0u, 0u, 0u};
    unsigned vc0[2], vc1[2], vn0[2], vn1[2];
#pragma unroll
    for (int i = 0; i < 2; ++i) {
        if constexpr (GATHER) { vc0[i] = (unsigned)tab[RA[i]] * (unsigned)(K * 2) + CA2[i]; vc1[i] = (unsigned)tab[128 + RA[i]] * (unsigned)(K * 2) + CA2[i]; }
        else { vc0[i] = voffA[i]; vc1[i] = voffA[i] + (unsigned)hstep; }
        vn0[i] = vc0[i]; vn1[i] = vc1[i];
    }
    const char* cA = (const char*)g.A + (GATHER ? (size_t)0 : S.a_off(cur)); const char* cB = (const char*)g.Bt + S.b_off(cur); const char* cB1 = (const char*)g.Bt + S.b_off2(cur);
    PG8_STAGE(PG8_SB(0, 0), cB, voffB); PG8_STAGE(PG8_SB(0, 1), cB + hstepB, voffB); PG8_STAGE(PG8_SA(0, 0), cA, vc0); PG8_STAGE(PG8_SA(0, 1), cA, vc1);
    if (wr == 1) PG8_BAR;
    PG8_WAIT_V(2); PG8_BAR;
    PG8_STAGE(PG8_SB(1, 0), cB + kstep, voffB); PG8_STAGE(PG8_SA(1, 0), cA + kstep, vc0); PG8_STAGE(PG8_SB(1, 1), cB + hstepB + kstep, voffB);
    PG8_WAIT_V(6); PG8_BAR;
    for (;;) {
        const bool has_next = S.next(ui + 1, nxt);
        const char* nA = has_next ? (const char*)g.A + (GATHER ? (size_t)0 : S.a_off(nxt)) : cA; const char* nB = has_next ? (const char*)g.Bt + S.b_off(nxt) : cB; const char* nB1 = has_next ? (const char*)g.Bt + S.b_off2(nxt) : cB1;
        if constexpr (GATHER) { if (has_next) {
#pragma unroll
            for (int i = 0; i < 2; ++i) { vn0[i] = (unsigned)tab[(ui + 1) * 256 + RA[i]] * (unsigned)(K * 2) + CA2[i]; vn1[i] = (unsigned)tab[(ui + 1) * 256 + 128 + RA[i]] * (unsigned)(K * 2) + CA2[i]; } } }
#define PG8_TRIP(t, W01) { \
            const int rlx_ = (Epi::NSTORE >= 16 && (t) == 0 && ui > 0) ? 1 : 0; \
            const bool last = (t == nt - 2); \
            const char* a1 = cA + (size_t)(t + 1) * kstep; \
            const char* a2 = last ? nA : cA + (size_t)(t + 2) * kstep; \
            const char* b2 = last ? nB : (DUALB ? ((t + 2 < nth) ? cB + (size_t)(t + 2) * kstep : cB1 + (size_t)(t + 2 - nth) * kstep) : cB + (size_t)(t + 2) * kstep); \
            const char* a3 = a2 + kstep; const char* b3 = b2 + kstep; \
            unsigned x0[2], x1[2]; \
            x0[0] = last ? vn0[0] : vc0[0]; x0[1] = last ? vn0[1] : vc0[1]; x1[0] = last ? vn1[0] : vc1[0]; x1[1] = last ? vn1[1] : vc1[1]; \
            PG8_LDB(B0, 0, 0); PG8_LDB(B1, 0, 1); PG8_SCHED; PG8_LDA(At, 0, 0); PG8_STAGE(PG8_SA(1, 1), a1, vc1); \
            PG8_WAIT_V01(rlx_); PG8_WAIT_L(0); PG8_BAR; PG8_MMA(0, 0, At, B0); PG8_MMA(0, 1, At, B1); PG8_BAR; PG8_SCHED; \
            PG8_LDA(At, 0, 1); PG8_STAGE(PG8_SB(0, 0), b2, voffB); PG8_STAGE(PG8_SB(0, 1), b2 + hstepB, voffB); PG8_STAGE(PG8_SA(0, 0), a2, x0); \
            PG8_WAIT_V01(rlx_); PG8_WAIT_L(0); PG8_BAR; PG8_MMA(1, 0, At, B0); PG8_MMA(1, 1, At, B1); PG8_BAR; PG8_SCHED; \
            if constexpr (Epi::HAS_PRE) { E.pre(acc, cur, t, pq0, wr, wc, fr, fq); PG8_SCHED; } \
            PG8_LDB(B0, 1, 0); PG8_LDB(B1, 1, 1); PG8_SCHED; PG8_LDA(At, 1, 0); PG8_STAGE(PG8_SA(0, 1), a2, x1); \
            PG8_WAIT_V(8); PG8_WAIT_L(0); PG8_BAR; PG8_MMA(0, 0, At, B0); PG8_MMA(0, 1, At, B1); PG8_BAR; PG8_SCHED; \
            PG8_LDA(At, 1, 1); PG8_STAGE(PG8_SB(1, 0), b3, voffB); PG8_STAGE(PG8_SB(1, 1), b3 + hstepB, voffB); PG8_STAGE(PG8_SA(1, 0), a3, x0); \
            PG8_WAIT_V(8); PG8_WAIT_L(0); PG8_BAR; PG8_MMA(1, 0, At, B0); PG8_MMA(1, 1, At, B1); PG8_BAR; PG8_SCHED; \
            if constexpr (Epi::HAS_PRE) { E.pre(acc, cur, t + 1, pq0, wr, wc, fr, fq); PG8_SCHED; } \
        }
        TS_DECL(); TS_BEGIN(120 + Epi::EPI_ID);
        if constexpr (Epi::HAS_PRE) {
            _Pragma("unroll") for (int t = 0; t < 16; t += 2) PG8_TRIP(t, 8)
        } else {
            for (int t = 0; t < nt; t += 2) PG8_TRIP(t, 8)
        }
#undef PG8_TRIP
        TS_END(120 + Epi::EPI_ID, lds, wid);
        if constexpr (Epi::HAS_PRE) E.pre(acc, cur, nt, pq0, wr, wc, fr, fq);
        if (wr == 0) PG8_BAR;
        { TS_BEGIN(100 + Epi::EPI_ID); E(acc, cur, wr, wc, fr, fq, tid); TS_END(100 + Epi::EPI_ID, lds, wid); }
#if defined(REP_EPI_ID)
        if constexpr (Epi::EPI_ID == REP_EPI_ID) E(acc, cur, wr, wc, fr, fq, tid);
#endif
        if (!has_next) break;
#pragma unroll
        for (int a = 0; a < 2; ++a)
#pragma unroll
            for (int b = 0; b < 2; ++b)
#pragma unroll
                for (int m = 0; m < 4; ++m)
#pragma unroll
                    for (int n = 0; n < 2; ++n) acc[a][b][m][n] = (f32x4){0.f, 0.f, 0.f, 0.f};
        cur = nxt; cA = nA; cB = nB; cB1 = nB1; ++ui;
#pragma unroll
        for (int i = 0; i < 2; ++i) { vc0[i] = vn0[i]; vc1[i] = vn1[i]; }
        if (wr == 1) PG8_BAR;
    }
    PG8_WAIT_V(0);
    PG8_BAR;
#undef PG8_SA
#undef PG8_SB
#undef PG8_STAGE
#undef PG8_LDA
#undef PG8_LDB
#undef PG8_MMA
#undef PG8_WAIT_V
#undef PG8_WAIT_L
#undef PG8_BAR
#undef PG8_SCHED
}
}
#define GAS __attribute__((address_space(1)))
#define LAS __attribute__((address_space(3)))
typedef unsigned short bf16;
typedef unsigned v4u __attribute__((ext_vector_type(4)));
typedef unsigned v2u __attribute__((ext_vector_type(2)));
typedef float f32x4 __attribute__((ext_vector_type(4)));
typedef float f32x2 __attribute__((ext_vector_type(2)));
typedef float f32x16 __attribute__((ext_vector_type(16)));
typedef short bf16x8 __attribute__((ext_vector_type(8)));
typedef short s16x4 __attribute__((ext_vector_type(4)));
typedef GAS unsigned gu32;
#define RLX_AGENT __ATOMIC_RELAXED, __HIP_MEMORY_SCOPE_AGENT
#define LDS_WAIT() asm volatile("s_waitcnt lgkmcnt(0)" ::: "memory")
#define VM_WAIT() asm volatile("s_waitcnt vmcnt(0)" ::: "memory")

constexpr int NWAVES = 8;
constexpr int NTOK = 65536, SEQ = 8192, DM = 1024, PW = 2816, NL = 4;
constexpr int OQ = 0, OKK = 512, OV = 1024, OU = 1536, OZ = 1792, OGB = 2048, OGC = 2304, OH = 2560;
constexpr float LN_EPS = 1e-5f, ALPHA = 1.6817928305074290f, LOG2E = 1.4426950408889634f, C2 = 0.125f * 1.4426950408889634f;
constexpr int NU_MAX = 10;
constexpr int NEB = 32, NPB = 112, NCNT = NEB + NPB;

constexpr size_t MiB = 1u << 20;
constexpr size_t WS_CTL = 0, CTL_ZERO_BYTES = 128 * 1024;
constexpr size_t WS_ROPE = 1 * MiB;
constexpr size_t WS_VEC = 3 * MiB;
constexpr size_t WS_WIN = 4 * MiB;
constexpr size_t WS_WOUT = 26 * MiB;
constexpr size_t WS_WRT = 34 * MiB;
constexpr size_t WS_WSGU = 35 * MiB;
constexpr size_t WS_WGU = 36 * MiB;
constexpr size_t WS_WD = 100 * MiB;
constexpr size_t WS_CGU = 132 * MiB;
constexpr size_t WS_S = 134 * MiB;
constexpr size_t WS_ST = 262 * MiB;
constexpr size_t WS_RS0 = 270 * MiB;
constexpr size_t WS_RS1 = 271 * MiB;
constexpr size_t WS_PROJ = 272 * MiB;
constexpr size_t WS_MIXED = 624 * MiB;
constexpr size_t WS_PART = 752 * MiB;
constexpr size_t WS_ML = 944 * MiB;
constexpr size_t WS_H = 272 * MiB;
constexpr size_t WS_ELIST = 456 * MiB;
constexpr size_t WS_EDEST = 464 * MiB;
constexpr size_t WS_EGATE = 472 * MiB;
constexpr size_t WS_PLIST = 480 * MiB;
constexpr size_t WS_END = 956 * MiB;
constexpr int V_ONES = 0, V_ZEROS = 1024, V_CIN = 2048  , V_DIN = V_CIN + 4 * PW, V_CR = V_DIN + 4 * PW  , V_DR = V_CR + 256;
constexpr int CW_TMO = 0, CW_CODE = 1, CW_BAR = 4096, CW_CNT = 16384;
constexpr int RING_OFF = 0, RING_BYTES = 131072;
constexpr int TAB_OFF = 131072;
constexpr int TAB2_OFF = TAB_OFF + NU_MAX * 1024;
constexpr int GTAB_OFF = TAB2_OFF + NU_MAX * 1024;
constexpr int UT_OFF = GTAB_OFF + NU_MAX * 512;
constexpr int TB_OFF = UT_OFF + 512;
constexpr int P6TAB_OFF = TB_OFF + 2560;
constexpr int P6UT_OFF = P6TAB_OFF + 3072;
constexpr int NU6_MAX = 6;
constexpr int TB_TBE = 0, TB_CLE = 33, TB_TBP = 65, TB_CLP = 178, TB_HIST = 290, TB_BASE = 434;
constexpr int LDS_BYTES = 163840;
constexpr int MISC_OFF = LDS_BYTES - 256;
static_assert(P6UT_OFF + 256 <= MISC_OFF && MISC_OFF + 256 <= LDS_BYTES, "LDS map");

__device__ __forceinline__ unsigned pkbf(float lo, float hi) { return pg8::cvt_pk_bf16(lo, hi); }
__device__ __forceinline__ float bflo(unsigned w) { return __uint_as_float(w << 16); }
__device__ __forceinline__ float bfhi(unsigned w) { return __uint_as_float(w & 0xffff0000u); }
__device__ __forceinline__ float bf2f(unsigned short b) { return __uint_as_float((unsigned)b << 16); }
__device__ __forceinline__ float rbf(float x) { return bflo(pkbf(x, 0.f)); }
__device__ __forceinline__ float fast_exp2(float x) { return __builtin_amdgcn_exp2f(x); }
__device__ __forceinline__ float fast_rcp(float x) { return __builtin_amdgcn_rcpf(x); }
__device__ __forceinline__ float fast_rsq(float x) { return __builtin_amdgcn_rsqf(x); }
__device__ __forceinline__ float gelu_t(float x) {
    const float u = 0.7978845608028654f * (x + 0.044715f * x * x * x);
    return x * fast_rcp(1.0f + fast_exp2(-2.0f * LOG2E * u));
}
__device__ __forceinline__ float silu_f(float x) { return x * fast_rcp(1.0f + fast_exp2(-LOG2E * x)); }
template <int CTRL> __device__ __forceinline__ float dppf(float v) { return __uint_as_float((unsigned)__builtin_amdgcn_update_dpp(0, (int)__float_as_uint(v), CTRL, 0xF, 0xF, true)); }
__device__ __forceinline__ float sum_x1(float v) { return v + dppf<0xB1>(v); }
__device__ __forceinline__ float sum_x2(float v) { return v + dppf<0x4E>(v); }
__device__ __forceinline__ float sum_q4(float v) { return v + dppf<0x141>(v); }
__device__ __forceinline__ float sum_q8(float v) { return v + dppf<0x140>(v); }
__device__ __forceinline__ float sum_x16(float v) { const auto r = __builtin_amdgcn_permlane16_swap(__float_as_uint(v), __float_as_uint(v), false, false); return __uint_as_float(r[0]) + __uint_as_float(r[1]); }
__device__ __forceinline__ float sum_x32(float v) { const auto r = __builtin_amdgcn_permlane32_swap(__float_as_uint(v), __float_as_uint(v), false, false); return __uint_as_float(r[0]) + __uint_as_float(r[1]); }
__device__ __forceinline__ float max_x32(float v) { const auto r = __builtin_amdgcn_permlane32_swap(__float_as_uint(v), __float_as_uint(v), false, false); return fmaxf(__uint_as_float(r[0]), __uint_as_float(r[1])); }
__device__ __forceinline__ float other_x32(float v, int hi) { const auto r = __builtin_amdgcn_permlane32_swap(__float_as_uint(v), __float_as_uint(v), false, false); return __uint_as_float(hi ? r[0] : r[1]); }
__device__ __forceinline__ float wave_sum(float v) { return sum_x32(sum_x16(sum_q8(sum_q4(sum_x2(sum_x1(v)))))); }

#define XB_TMO      128
#define XB_XCNT(j)  (256  + 64 * (j))
#define XB_XSUB(j)  (1280 + 64 * (j))
#define XB_XGEN(j)  (2304 + 64 * (j))
#define XB_TOP      3328
#define XB_TOPGEN   3392
#define XCD_BAR_WORDS 3456
#define XB_SPIN_CAP (1u << 18)
__device__ __forceinline__ unsigned xb_ld(unsigned* p)              { return __hip_atomic_load(p, __ATOMIC_RELAXED, __HIP_MEMORY_SCOPE_AGENT); }
__device__ __forceinline__ unsigned xb_add(unsigned* p, unsigned v) { return __hip_atomic_fetch_add(p, v, __ATOMIC_RELAXED, __HIP_MEMORY_SCOPE_AGENT); }
__device__ __forceinline__ unsigned xb_xcc_id() { return (unsigned)__builtin_amdgcn_s_getreg((3 << 11) | 20) & 0xFu; }
#define XB_SPIN(cond, bar) do { unsigned _sp = 0; while (cond) { __builtin_amdgcn_s_sleep(1); \
    if ((++_sp & 255u) == 0u) { if (xb_ld(&(bar)[XB_TMO])) break; if (_sp > XB_SPIN_CAP) { atomicAdd(&(bar)[XB_TMO], 1u); break; } } } } while (0)
struct XcdBarrier { unsigned* bar; unsigned x; volatile LAS unsigned* st; };
__device__ __forceinline__ XcdBarrier xcd_barrier_post(unsigned* bar, volatile LAS unsigned* st) {
    XcdBarrier b; b.bar = bar; b.x = xb_xcc_id(); b.st = st;
    if (threadIdx.x == 0) (void)xb_add(&bar[XB_XCNT(b.x)], 1u);
    return b;
}
__device__ __forceinline__ void xcd_barrier_complete(unsigned* bar, unsigned x, unsigned& nloc, unsigned& nx) {
    const unsigned G = gridDim.x * gridDim.y * gridDim.z;
    unsigned sum, cnt, mine, sp = 0u;
    for (;;) {
        sum = 0u; cnt = 0u; mine = 0u;
#pragma unroll
        for (unsigned j = 0; j < 16; ++j) { const unsigned c = xb_ld(&bar[XB_XCNT(j)]); sum += c; cnt += (c > 0u) ? 1u : 0u; mine = (j == x) ? c : mine; }
        if (sum == G) break;
        __builtin_amdgcn_s_sleep(1);
        if ((++sp & 255u) == 0u) { if (xb_ld(&bar[XB_TMO])) break; if (sp > XB_SPIN_CAP) { atomicAdd(&bar[XB_TMO], 1u); break; } }
    }
    nloc = mine > 0u ? mine : 1u; nx = cnt > 0u ? cnt : 1u;
}
__device__ __forceinline__ void xcd_barrier(const XcdBarrier& b) {
    asm volatile("s_waitcnt vmcnt(0)" ::: "memory");
    __syncthreads();
    if (threadIdx.x == 0) {
        unsigned* bar = b.bar;
        __builtin_amdgcn_s_waitcnt(0);
        unsigned nloc = b.st[0], nx = b.st[1];
        if (nloc == 0u) { xcd_barrier_complete(bar, b.x, nloc, nx); b.st[0] = nloc; b.st[1] = nx; }
        const unsigned old = xb_add(&bar[XB_XSUB(b.x)], 1u);
        const unsigned gen = old / nloc;
        if (old + 1u == (gen + 1u) * nloc) {
            __builtin_amdgcn_fence(__ATOMIC_RELEASE, "agent");
            asm volatile("s_waitcnt vmcnt(0)" ::: "memory");
            const unsigned og = xb_add(&bar[XB_TOP], 1u);
            const unsigned tg = og / nx;
            if (og + 1u == (tg + 1u) * nx) xb_add(&bar[XB_TOPGEN], 1u);
            else XB_SPIN(xb_ld(&bar[XB_TOPGEN]) == tg, bar);
            __builtin_amdgcn_fence(__ATOMIC_ACQUIRE, "agent");
            xb_add(&bar[XB_XGEN(b.x)], 1u);
            asm volatile("s_waitcnt vmcnt(0)" ::: "memory");
        } else {
            XB_SPIN(xb_ld(&bar[XB_XGEN(b.x)]) == gen, bar);
            __builtin_amdgcn_fence(__ATOMIC_ACQUIRE, "agent");
            asm volatile("s_waitcnt vmcnt(0)" ::: "memory");
        }
    }
    __syncthreads();
}

struct MoeOrder {
    const LAS int* ut; int K, Kb; size_t bstride; int numax;
    __device__ __forceinline__ bool next(int i, pg8::Unit& u) const {
        if (i >= numax) return false;
        const LAS int* p = ut + i * 8; const int nv = __builtin_amdgcn_readfirstlane(p[5]);
        if (nv < 0) return false;
        u.pm = __builtin_amdgcn_readfirstlane(p[0]); u.pn = __builtin_amdgcn_readfirstlane(p[1]); u.e = __builtin_amdgcn_readfirstlane(p[2]);
        u.bin = __builtin_amdgcn_readfirstlane(p[3]); u.rbase = __builtin_amdgcn_readfirstlane(p[4]); u.nvalid = nv; u.e2 = __builtin_amdgcn_readfirstlane(p[6]); return true;
    }
    __device__ __forceinline__ size_t a_off(const pg8::Unit& u) const { return (size_t)u.pm * (size_t)(512) * K; }
    __device__ __forceinline__ size_t b_off(const pg8::Unit& u) const { return (size_t)u.e * bstride + (size_t)u.pn * (size_t)(512) * Kb; }
    __device__ __forceinline__ size_t b_off2(const pg8::Unit& u) const { return (size_t)u.e2 * bstride + (size_t)u.pn * (size_t)(512) * Kb; }
};

template <class T> __device__ __forceinline__ T ldg(const void* base, unsigned byteoff) { return *(const T*)((const char*)base + byteoff); }
template <class T> __device__ __forceinline__ void stg_(void* base, unsigned byteoff, T v) { *(T*)((char*)base + byteoff) = v; }
#define EPI_FENCE() asm volatile("" ::: "memory")
constexpr int XT_C = 512, XT_D = XT_C + PW, XT_LASTPM = XT_D + PW;
struct EpiProj {
    static constexpr bool PERM = true, HAS_PRE = false; static constexpr int EPI_ID = 1, NSTORE = 16;
    bf16* O; const float* cvec; const float* dvec; const float* ST; float* RS; const float* CS; LAS float* xt;
    __device__ __forceinline__ void operator()(const f32x4 (&acc)[2][2][4][2], const pg8::Unit& u, int wr, int wc, int fr, int fq, int tid) const {
        const unsigned row0 = u.pm * 256 + wr * 64 + fr;
        const unsigned col0 = u.pn * 256 + wc * 32 + 8 * fq;
        const int seg = u.pn;
        LAS unsigned char* ldsb_ = (LAS unsigned char*)xt - TAB_OFF; (void)ldsb_;
        TS_DECL(); TS_BEGIN(201);
        f32x4 csA = (f32x4){1.f, 0.f, 1.f, 0.f}, csB = csA, wsA = csA, wsB = csA;
        if (seg < 4) { const unsigned t = row0 & (SEQ - 1), i0 = 16 * (wc & 1) + 4 * fq;
            csA = ldg<f32x4>(CS, (t * 32u + i0) * 8u); csB = ldg<f32x4>(CS, (t * 32u + i0) * 8u + 16u);
            wsA = ldg<f32x4>(CS, (16u * 32u + i0) * 8u); wsB = ldg<f32x4>(CS, (16u * 32u + i0) * 8u + 16u); }
        const int lastpm = ((const LAS int*)xt)[XT_LASTPM];
        if (lastpm != (int)u.pm) {
            if (tid < 256) {
                const unsigned row = u.pm * 256 + tid;
                f32x4 p[8];
#pragma unroll
                for (int j = 0; j < 8; ++j) p[j] = ldg<f32x4>(ST, row * 128u + 16u * j);
                float s = 0.f, q = 0.f;
#pragma unroll
                for (int j = 0; j < 8; ++j) { s += p[j][0] + p[j][2]; q += p[j][1] + p[j][3]; }
                const float mu = s * (1.f / 1024.f); const float var = q * (1.f / 1024.f) - mu * mu; const float rstd = fast_rsq(var + LN_EPS);
                stg_<f32x2>(RS, row * 8u, (f32x2){mu, rstd});
                *(LAS f32x2*)(xt + 2 * tid) = (f32x2){rstd, rstd * mu};
            }
            asm volatile("s_waitcnt lgkmcnt(0)" ::: "memory"); __builtin_amdgcn_s_barrier(); asm volatile("" ::: "memory");
            if (tid == 0) ((LAS int*)xt)[XT_LASTPM] = (int)u.pm;
        }
        TS_END(201, ldsb_, tid >> 6); TS_BEGIN(202);
        f32x4 cs0 = csA, cs1 = csB;
#pragma unroll
        for (int ai = 0; ai < 2; ++ai)
#pragma unroll
            for (int m = 0; m < 4; ++m) {
                const unsigned row = row0 + ai * 128 + m * 16;
                const f32x2 t2 = *(const LAS f32x2*)(xt + 2 * (wr * 64 + fr + ai * 128 + m * 16));
                const float rstd = t2.x, rsmu = t2.y;
#pragma unroll
                for (int bj = 0; bj < 2; ++bj) {
                    const int lc = col0 + bj * 128;
                    const f32x4 cv0 = *(const LAS f32x4*)(xt + XT_C + lc), cv1 = *(const LAS f32x4*)(xt + XT_C + lc + 4);
                    const f32x4 dv0 = *(const LAS f32x4*)(xt + XT_D + lc), dv1 = *(const LAS f32x4*)(xt + XT_D + lc + 4);
                    f32x4 v0 = acc[ai][bj][m][0] * rstd - cv0 * rsmu + dv0, v1 = acc[ai][bj][m][1] * rstd - cv1 * rsmu + dv1;
                    if (seg < 4) {
                        const float sc = (seg < 2) ? C2 : 1.0f;
                        f32x4 w0, w1;
                        w0[0] = (v0[0] * cs0[0] - v0[1] * cs0[1]) * sc; w0[1] = (v0[1] * cs0[0] + v0[0] * cs0[1]) * sc;
                        w0[2] = (v0[2] * cs0[2] - v0[3] * cs0[3]) * sc; w0[3] = (v0[3] * cs0[2] + v0[2] * cs0[3]) * sc;
                        w1[0] = (v1[0] * cs1[0] - v1[1] * cs1[1]) * sc; w1[1] = (v1[1] * cs1[0] + v1[0] * cs1[1]) * sc;
                        w1[2] = (v1[2] * cs1[2] - v1[3] * cs1[3]) * sc; w1[3] = (v1[3] * cs1[2] + v1[2] * cs1[3]) * sc;
                        v0 = w0; v1 = w1;
                    } else if (seg == 6 || seg == 7) {
#pragma unroll
                        for (int e = 0; e < 4; ++e) { v0[e] = gelu_t(v0[e]); v1[e] = gelu_t(v1[e]); }
                    }
                    if (seg >= 9) {
                        v2u w2; w2.x = pkbf(v0[0] * v0[1], v0[2] * v0[3]); w2.y = pkbf(v1[0] * v1[1], v1[2] * v1[3]);
                        stg_<v2u>(O, (row * (unsigned)PW + OGC + (seg - 9) * 128 + ((wc * 32 + 8 * fq + bj * 128) >> 1)) * 2u, w2);
                    } else {
                    v4u w; w.x = pkbf(v0[0], v0[1]); w.y = pkbf(v0[2], v0[3]); w.z = pkbf(v1[0], v1[1]); w.w = pkbf(v1[2], v1[3]);
                    stg_<v4u>(O, (row * (unsigned)PW + col0 + bj * 128) * 2u, w);
                    }
                }
                if (seg < 4) {
                    const int nstep = (ai == 0 && m == 3) ? 5 : 1;
#pragma unroll
                    for (int st = 0; st < nstep; ++st) {
                        f32x4 n0, n1;
                        n0[0] = cs0[0] * wsA[0] - cs0[1] * wsA[1]; n0[1] = cs0[1] * wsA[0] + cs0[0] * wsA[1]; n0[2] = cs0[2] * wsA[2] - cs0[3] * wsA[3]; n0[3] = cs0[3] * wsA[2] + cs0[2] * wsA[3];
                        n1[0] = cs1[0] * wsB[0] - cs1[1] * wsB[1]; n1[1] = cs1[1] * wsB[0] + cs1[0] * wsB[1]; n1[2] = cs1[2] * wsB[2] - cs1[3] * wsB[3]; n1[3] = cs1[3] * wsB[2] + cs1[2] * wsB[3];
                        cs0 = n0; cs1 = n1;
                    }
                }
                if (m == 3) EPI_FENCE();
            }
        TS_END(202, ldsb_, tid >> 6);
    }
};
struct EpiRes1 {
    static constexpr bool PERM = true, HAS_PRE = false; static constexpr int EPI_ID = 2, NSTORE = 16;
    bf16* S; const float* RS; const float* G; const float* Bv; bf16* Sout;
    __device__ __forceinline__ void operator()(const f32x4 (&acc)[2][2][4][2], const pg8::Unit& u, int wr, int wc, int fr, int fq, int tid) const {
        const unsigned row0 = u.pm * 256 + wr * 64 + fr;
        const unsigned col0 = u.pn * 256 + wc * 32 + 8 * fq;
        f32x2 st[2][4];
#pragma unroll
        for (int ai = 0; ai < 2; ++ai)
#pragma unroll
            for (int m = 0; m < 4; ++m) st[ai][m] = ldg<f32x2>(RS, (row0 + ai * 128 + m * 16) * 8u);
        f32x4 gv[2][2], bv[2][2];
#pragma unroll
        for (int bj = 0; bj < 2; ++bj) { gv[bj][0] = ldg<f32x4>(G, (col0 + bj * 128) * 4u); gv[bj][1] = ldg<f32x4>(G, (col0 + bj * 128) * 4u + 16u); bv[bj][0] = ldg<f32x4>(Bv, (col0 + bj * 128) * 4u); bv[bj][1] = ldg<f32x4>(Bv, (col0 + bj * 128) * 4u + 16u); }
        v4u o[2][4];
#pragma unroll
        for (int m = 0; m < 4; ++m) o[0][m] = ldg<v4u>(S, ((row0 + m * 16) * (unsigned)DM + col0) * 2u);
#pragma unroll
        for (int g = 0; g < 4; ++g) {
            const int bj = g >> 1, ai = g & 1;
            if (g < 3) { const int bjn = (g + 1) >> 1, ain = (g + 1) & 1;
#pragma unroll
                for (int m = 0; m < 4; ++m) o[(g + 1) & 1][m] = ldg<v4u>(S, ((row0 + ain * 128 + m * 16) * (unsigned)DM + col0 + bjn * 128) * 2u); }
            __builtin_amdgcn_sched_barrier(0);
#pragma unroll
            for (int m = 0; m < 4; ++m) {
                const unsigned off = ((row0 + ai * 128 + m * 16) * (unsigned)DM + col0 + bj * 128) * 2u;
                const v4u oo = o[g & 1][m];
                f32x4 x0 = (f32x4){bflo(oo.x), bfhi(oo.x), bflo(oo.y), bfhi(oo.y)}, x1 = (f32x4){bflo(oo.z), bfhi(oo.z), bflo(oo.w), bfhi(oo.w)};
                x0 = ((x0 - st[ai][m].x) * st[ai][m].y * gv[bj][0] + bv[bj][0]) * ALPHA + acc[ai][bj][m][0];
                x1 = ((x1 - st[ai][m].x) * st[ai][m].y * gv[bj][1] + bv[bj][1]) * ALPHA + acc[ai][bj][m][1];
                v4u w; w.x = pkbf(x0[0], x0[1]); w.y = pkbf(x0[2], x0[3]); w.z = pkbf(x1[0], x1[1]); w.w = pkbf(x1[2], x1[3]);
                stg_<v4u>(Sout, off, w);
            }
            __builtin_amdgcn_sched_barrier(0);
        }
    }
};
struct EpiSwiglu {
    static constexpr bool PERM = true, HAS_PRE = false; static constexpr int EPI_ID = 3, NSTORE = 0;
    bf16* H; const LAS int* dtab; const LAS float* gtab; const LAS int* tbP;
    __device__ __forceinline__ void operator()(const f32x4 (&acc)[2][2][4][2], const pg8::Unit& u, int wr, int wc, int fr, int fq, int tid) const {
        const unsigned lr0 = wr * 64 + fr;
        const unsigned col0 = u.pn * 256 + wc * 32 + 8 * fq;
#pragma unroll
        for (int ai = 0; ai < 2; ++ai)
#pragma unroll
            for (int m = 0; m < 4; ++m) {
                const unsigned lr = lr0 + ai * 128 + m * 16;
                const unsigned d = (unsigned)dtab[u.e2 * 256 + lr]; const float gate = gtab[u.e2 * 256 + lr];
                const bool valid = d != 0xffffffffu;
                const unsigned pb = valid ? (d >> 18) : 0u, pslot = (d >> 1) & 0x1ffffu, half = d & 1u;
                const unsigned prow = (unsigned)tbP[pb] * 256u + pslot;
                v4u w;
                { const f32x4 v0 = acc[ai][0][m][0], v1 = acc[ai][0][m][1]; w.x = pkbf(gate * silu_f(v0[0]) * v0[1], gate * silu_f(v0[2]) * v0[3]); w.y = pkbf(gate * silu_f(v1[0]) * v1[1], gate * silu_f(v1[2]) * v1[3]); }
                { const f32x4 v0 = acc[ai][1][m][0], v1 = acc[ai][1][m][1]; w.z = pkbf(gate * silu_f(v0[0]) * v0[1], gate * silu_f(v0[2]) * v0[3]); w.w = pkbf(gate * silu_f(v1[0]) * v1[1], gate * silu_f(v1[2]) * v1[3]); }
                if (valid) stg_<v4u>(H, (prow * 1024u + half * 512u + (unsigned)(u.pn * 128 + wc * 32 + fq * 8)) * 2u, w);
            }
    }
};
struct EpiDown {
    static constexpr bool PERM = true, HAS_PRE = false; static constexpr int EPI_ID = 4, NSTORE = 0;
    bf16* S; const bf16* XN; const LAS unsigned short* ttab; float* ST;
    __device__ __forceinline__ void pre(f32x4 (&)[2][2][4][2], const pg8::Unit&, int, pg8::u32x4&, int, int, int, int) const {}
    __device__ __forceinline__ void operator()(const f32x4 (&acc)[2][2][4][2], const pg8::Unit& u, int wr, int wc, int fr, int fq, int tid) const {
        const unsigned lr0 = wr * 64 + fr;
        const unsigned col0 = u.pn * 256 + wc * 32 + 8 * fq;
        TS_DECL(); TS_BEGIN(211);
        unsigned tk[2][4]; v4u o[2][4][2];
#pragma unroll
        for (int ai = 0; ai < 2; ++ai)
#pragma unroll
            for (int m = 0; m < 4; ++m) { const unsigned lr = lr0 + ai * 128 + m * 16; const unsigned t16 = ttab[u.rbase * 256 + lr]; tk[ai][m] = ((int)lr < u.nvalid) ? t16 : 0xffffffffu; }
#pragma unroll
        for (int ai = 0; ai < 2; ++ai)
#pragma unroll
            for (int m = 0; m < 4; ++m) { const unsigned tok = (tk[ai][m] != 0xffffffffu) ? tk[ai][m] : 0u;
#pragma unroll
                for (int bj = 0; bj < 2; ++bj) o[ai][m][bj] = ldg<v4u>(XN, (tok * (unsigned)DM + col0 + bj * 128) * 2u); }
        TS_END(211, (LAS unsigned char*)ttab - TAB_OFF, tid >> 6); TS_BEGIN(212);
#pragma unroll
        for (int ai = 0; ai < 2; ++ai) {
#pragma unroll
            for (int m = 0; m < 4; ++m) {
                const bool valid = tk[ai][m] != 0xffffffffu;
                const unsigned tok = valid ? tk[ai][m] : 0u;
                float ssum = 0.f, ssq = 0.f;
#pragma unroll
                for (int bj = 0; bj < 2; ++bj) {
                    const v4u oo = o[ai][m][bj];
                    f32x4 x0 = (f32x4){bflo(oo.x), bfhi(oo.x), bflo(oo.y), bfhi(oo.y)}, x1 = (f32x4){bflo(oo.z), bfhi(oo.z), bflo(oo.w), bfhi(oo.w)};
                    x0 = x0 * ALPHA + acc[ai][bj][m][0]; x1 = x1 * ALPHA + acc[ai][bj][m][1];
                    v4u w; w.x = pkbf(x0[0], x0[1]); w.y = pkbf(x0[2], x0[3]); w.z = pkbf(x1[0], x1[1]); w.w = pkbf(x1[2], x1[3]);
                    if (valid) stg_<v4u>(S, (tok * (unsigned)DM + col0 + bj * 128) * 2u, w);
                    const f32x4 r0 = (f32x4){bflo(w.x), bfhi(w.x), bflo(w.y), bfhi(w.y)}, r1 = (f32x4){bflo(w.z), bfhi(w.z), bflo(w.w), bfhi(w.w)};
                    ssum += (r0[0] + r0[1]) + (r0[2] + r0[3]) + (r1[0] + r1[1]) + (r1[2] + r1[3]);
                    ssq += (r0[0] * r0[0] + r0[1] * r0[1]) + (r0[2] * r0[2] + r0[3] * r0[3]) + (r1[0] * r1[0] + r1[1] * r1[1]) + (r1[2] * r1[2] + r1[3] * r1[3]);
                }
                ssum = sum_x32(sum_x16(ssum)); ssq = sum_x32(sum_x16(ssq));
                if (valid && fq == 0) stg_<f32x2>(ST, ((tok * 16u + u.pn * 4 + wc) * 2u) * 4u, (f32x2){ssum, ssq});
            }
        }
        TS_END(212, (LAS unsigned char*)ttab - TAB_OFF, tid >> 6);
    }
};

struct ColId { __device__ __forceinline__ int operator()(int n) const { return n; } };
struct ColConv { __device__ __forceinline__ int operator()(int n) const { const int q = n - OGC; return ((q & 1) ? OH : OGC) + (q >> 1); } };
struct ColRope { __device__ __forceinline__ int operator()(int n) const { const int p = n & 63; return (n & ~63) + (p >> 1) + ((p & 1) << 5); } };
template <class CM>
__device__ __forceinline__ void conv_item(const float* W, int K, int ldw, CM cm, int n0, bf16* WT, int rstride, const float* scale, const float* biask, float* csum, float* dsum, LAS float* scr, int lane_, int kst = 0, int gumap = 0) {
    if (kst == 0) kst = K;
    int lane = lane_; asm volatile("" : "+v"(lane));
    const int col = cm(n0 + (lane & 31));
    float cs = 0.f, ds = 0.f;
    const float* wp = W + (size_t)(lane >> 5) * ldw + col;
    float w[32], wn[32];
#pragma unroll
    for (int i = 0; i < 32; ++i) w[i] = wp[(size_t)(2 * i) * ldw];
    for (int k0 = 0; k0 < K; k0 += 64) {
        if (k0 + 64 < K) {
#pragma unroll
            for (int i = 0; i < 32; ++i) wn[i] = wp[(size_t)(k0 + 64 + 2 * i) * ldw];
        }
#pragma unroll
        for (int i = 0; i < 32; ++i) { const int kk = k0 + 2 * i + (lane >> 5); const float sc = scale ? scale[kk] : 1.0f; const float bk = biask ? biask[kk] : 0.0f;
            const float v = rbf(w[i] * sc); cs += v; ds += bk * w[i]; scr[(2 * i + (lane >> 5)) * 33 + (lane & 31)] = v; }
        LDS_WAIT(); asm volatile("" ::: "memory");
        const int c = lane & 7;
#pragma unroll
        for (int j = 0; j < 4; ++j) { const int n = (lane >> 3) + 8 * j; const LAS float* s = scr + (8 * c) * 33 + n;
            v4u o; o.x = pkbf(s[0 * 33], s[1 * 33]); o.y = pkbf(s[2 * 33], s[3 * 33]); o.z = pkbf(s[4 * 33], s[5 * 33]); o.w = pkbf(s[6 * 33], s[7 * 33]);
            const int rown = gumap ? (((n >> 2) & 1) * 128 + (n >> 3) * 8 + (n & 3) * 2) : n * rstride;
            *(GAS v4u*)(WT + (size_t)rown * kst + k0 + 8 * c) = o; }
        LDS_WAIT(); asm volatile("" ::: "memory");
#pragma unroll
        for (int i = 0; i < 32; ++i) w[i] = wn[i];
    }
    cs = sum_x32(cs); ds = sum_x32(ds);
    if (lane < 32) { if (csum) csum[lane * rstride] = cs; if (dsum) dsum[lane * rstride] = ds; }
}

template <class CM>
__device__ __forceinline__ void conv_item3(const float* W, int K, int ldw, CM cm, int n0, bf16* WT, int rstride, LAS float* scr, int lane_, int kst = 0, int gumap = 0) {
    if (kst == 0) kst = K;
    int lane = lane_; asm volatile("" : "+v"(lane));
    const int col = cm(n0 + (lane & 31));
    const float* wp = W + (size_t)(lane >> 5) * ldw + col;
    float wa[32], wb[32], wc[32];
#pragma unroll
    for (int i = 0; i < 32; ++i) wa[i] = wp[(size_t)(2 * i) * ldw];
#pragma unroll
    for (int i = 0; i < 32; ++i) wb[i] = wp[(size_t)(64 + 2 * i) * ldw];
    for (int k0 = 0; k0 < K; k0 += 64) {
        if (k0 + 128 < K) {
#pragma unroll
            for (int i = 0; i < 32; ++i) wc[i] = wp[(size_t)(k0 + 128 + 2 * i) * ldw];
        }
        __builtin_amdgcn_sched_barrier(0);
#pragma unroll
        for (int i = 0; i < 32; ++i) scr[(2 * i + (lane >> 5)) * 33 + (lane & 31)] = rbf(wa[i]);
        LDS_WAIT(); asm volatile("" ::: "memory");
        const int c = lane & 7;
#pragma unroll
        for (int j = 0; j < 4; ++j) { const int n = (lane >> 3) + 8 * j; const LAS float* s = scr + (8 * c) * 33 + n;
            v4u o; o.x = pkbf(s[0 * 33], s[1 * 33]); o.y = pkbf(s[2 * 33], s[3 * 33]); o.z = pkbf(s[4 * 33], s[5 * 33]); o.w = pkbf(s[6 * 33], s[7 * 33]);
            const int rown = gumap ? (((n >> 2) & 1) * 128 + (n >> 3) * 8 + (n & 3) * 2) : n * rstride;
            *(GAS v4u*)(WT + (size_t)rown * kst + k0 + 8 * c) = o; }
        LDS_WAIT(); asm volatile("" ::: "memory");
#pragma unroll
        for (int i = 0; i < 32; ++i) { wa[i] = wb[i]; wb[i] = wc[i]; }
    }
}

constexpr int AT_KA = 0, AT_KB = 49152, AT_V = 98304, AT_WS = 147456, AT_END = AT_WS + 8 * 256;
__device__ __forceinline__ void glds16(const void* gsrc, unsigned lds_dst) { unsigned keep;
    asm volatile("s_mov_b32 %0, m0\n\ts_mov_b32 m0, %2\n\ts_nop 0\n\tglobal_load_lds_dwordx4 %1, off\n\ts_mov_b32 m0, %0" : "=&s"(keep) : "v"(gsrc), "s"(lds_dst) : "memory"); }
__device__ __forceinline__ int crow(int r, int hi) { return (r & 3) + 8 * (r >> 2) + 4 * hi; }
typedef short v4i16_t __attribute__((ext_vector_type(4)));
__device__ __forceinline__ s16x4 vtr(const LAS char* p) { return __builtin_bit_cast(s16x4, __builtin_amdgcn_ds_read_tr16_b64_v4i16((LAS v4i16_t*)p)); }
struct AUnit { int b, h, br, r, m0, d; };
__device__ __forceinline__ AUnit attn_decode(int U) { AUnit a; const int bh = U / 96, rem = U % 96; a.b = bh >> 3; a.h = bh & 7; a.br = rem >> 5; const int uidx = rem & 31; const int dsh = 2 * a.br; a.d = 1 << dsh; a.r = uidx & (a.d - 1); a.m0 = (uidx >> dsh) * 256; return a; }
__device__ __forceinline__ void glds16s(const void* sbase, unsigned voff, unsigned lds_dst) { unsigned keep;
    asm volatile("s_mov_b32 %0, m0\n\ts_mov_b32 m0, %3\n\ts_nop 0\n\tglobal_load_lds_dwordx4 %1, %2\n\ts_mov_b32 m0, %0" : "=&s"(keep) : "v"(voff), "s"(sbase), "s"(lds_dst) : "memory"); }
__device__ __forceinline__ void attn_issue_k(const bf16* proj, const AUnit& a, unsigned ldsK, int wid, int lane) {
    const int kk = lane >> 3, pc = lane & 7;
    const unsigned ubase = (((unsigned)a.b * SEQ + a.r) * PW + OKK + 64 * a.h) * 2u, rstep = (unsigned)a.d * PW * 2u;
#pragma unroll
    for (int i = 0; i < 6; ++i) {
        const int x = wid * 6 + i, T = x >> 2, q = x & 3;
        const int k = 8 * q + kk;
        int sidx = a.m0 - 128 + 32 * T + k; sidx = sidx < 0 ? 0 : sidx;
        const unsigned c = (unsigned)(pc ^ ((k >> 1) & 7));
        glds16s(proj, ubase + (unsigned)sidx * rstep + c * 16u, (unsigned)__builtin_amdgcn_readfirstlane(ldsK + T * 4096 + q * 1024));
    }
}
__device__ __forceinline__ void attn_issue_v(const bf16* proj, const AUnit& a, unsigned ldsV, int wid, int lane) {
    const int kk = lane >> 3, pc = lane & 7;
    const unsigned ubase = (((unsigned)a.b * SEQ + a.r) * PW + OV + 64 * a.h) * 2u, rstep = (unsigned)a.d * PW * 2u;
#pragma unroll
    for (int i = 0; i < 6; ++i) {
        const int x = wid * 6 + i, k = 8 * x + kk;
        int sidx = a.m0 - 128 + k; sidx = sidx < 0 ? 0 : sidx;
        const unsigned c = (unsigned)(pc ^ (((k >> 1) & 1) << 2));
        glds16s(proj, ubase + (unsigned)sidx * rstep + c * 16u, (unsigned)__builtin_amdgcn_readfirstlane(ldsV + x * 1024));
    }
}
__device__ __forceinline__ void attn_load_q(const bf16* proj, const AUnit& a, bf16x8 (&qr)[4], int wid, int r32, int hi) {
    const unsigned off = ((((unsigned)a.b * SEQ + (unsigned)(a.m0 + 32 * wid + r32) * a.d + a.r) * PW) + OQ + 64 * a.h + 8 * hi) * 2u;
    asm volatile("global_load_dwordx4 %0, %4, %5\n\tglobal_load_dwordx4 %1, %4, %5 offset:32\n\tglobal_load_dwordx4 %2, %4, %5 offset:64\n\tglobal_load_dwordx4 %3, %4, %5 offset:96"
                 : "=&v"(qr[0]), "=&v"(qr[1]), "=&v"(qr[2]), "=&v"(qr[3]) : "v"(off), "s"(proj) : "memory");
}

__device__ __forceinline__ void attn_phase(const bf16* proj, bf16* part, float* ML, int vcu, int G, LAS unsigned char* lds, int wave_s) {
    int lane = pg8::lane_id_v(); const int wid = wave_s; int r32 = lane & 31, hi = lane >> 5;
    const unsigned lds0 = (unsigned)(uintptr_t)lds;
    constexpr int NUNITS = 8 * 8 * 96;
    int U = vcu;
    if (U >= NUNITS) return;
    AUnit cur = attn_decode(U);
    bf16x8 qr[4];
    attn_issue_k(proj, cur, lds0 + AT_KA, wid, lane);
    attn_load_q(proj, cur, qr, wid, r32, hi);
    attn_issue_v(proj, cur, lds0 + AT_V, wid, lane);
    f32x16 bias0, bias4;
#pragma unroll
    for (int rg = 0; rg < 16; ++rg) { const int c = crow(rg, hi); bias0[rg] = (c < r32) ? -1e30f : 0.f; bias4[rg] = (c > r32) ? -1e30f : 0.f; }
    int kb = 0; bool first = true;
    for (;;) {
        const int Un = U + G; const bool has_next = Un < NUNITS;
        AUnit nxt = cur; if (has_next) nxt = attn_decode(Un);
        const int koff = kb ? AT_KB : AT_KA, koff_n = kb ? AT_KA : AT_KB;
        asm volatile("" : "+v"(lane)); r32 = lane & 31; hi = lane >> 5;
        TS_DECL();
        TS_BEGIN(1);
        if (first) asm volatile("s_waitcnt vmcnt(6)\n\ts_barrier" ::: "memory"); else asm volatile("s_waitcnt vmcnt(11)\n\ts_barrier" ::: "memory");
        TS_END(1, lds, wid);
        asm volatile("" : "+v"(qr[0]), "+v"(qr[1]), "+v"(qr[2]), "+v"(qr[3]));
        TS_BEGIN(2); if (has_next) attn_issue_k(proj, nxt, lds0 + koff_n, wid, lane); TS_END(2, lds, wid);
        f32x16 p[5];
        TS_BEGIN(3);
#if defined(REP_MASK) && ((REP_MASK >> 12) & 1)
        for (int rr_ = 0; rr_ < 2; ++rr_)
#endif
        {
            const LAS unsigned char* kb0 = lds + koff + wid * 4096 + r32 * 128;
            const int sw = (r32 >> 1) & 7;
            int ko[4];
#pragma unroll
            for (int d0 = 0; d0 < 4; ++d0) ko[d0] = ((2 * d0 + hi) ^ sw) * 16;
            bf16x8 kf[2][4];
#pragma unroll
            for (int d0 = 0; d0 < 4; ++d0) kf[0][d0] = *(const LAS bf16x8*)(kb0 + ko[d0]);
#pragma unroll
            for (int j = 0; j < 5; ++j) {
                if (j < 4) {
#pragma unroll
                    for (int d0 = 0; d0 < 4; ++d0) kf[(j + 1) & 1][d0] = *(const LAS bf16x8*)(kb0 + (j + 1) * 4096 + ko[d0]);
                }
                f32x16 a = (j == 0) ? bias0 : ((j == 4) ? bias4 : f32x16{});
                __builtin_amdgcn_s_setprio(1);
#pragma unroll
                for (int d0 = 0; d0 < 4; ++d0) a = __builtin_amdgcn_mfma_f32_32x32x16_bf16(kf[j & 1][d0], qr[d0], a, 0, 0, 0);
                __builtin_amdgcn_s_setprio(0);
                p[j] = a;
                __builtin_amdgcn_sched_barrier(0);
            }
        }
        asm volatile("" : "+v"(p[4]));
        TS_END(3, lds, wid);
        asm volatile("" ::: "memory");
        if (has_next) attn_load_q(proj, nxt, qr, wid, r32, hi);
        TS_BEGIN(4);
        if (cur.m0 == 0) {
            asm volatile("; first-block mask" ::: "memory");
            const int kfirst = 128 - 32 * wid;
#pragma unroll
            for (int j = 0; j < 5; ++j)
#pragma unroll
                for (int rg = 0; rg < 16; ++rg) if (32 * j + crow(rg, hi) < kfirst) p[j][rg] = -1e30f;
        }
        float mx = p[0][0];
#pragma unroll
        for (int j = 0; j < 5; ++j)
#pragma unroll
            for (int rg = 0; rg < 16; ++rg) mx = fmaxf(mx, p[j][rg]);
        mx = max_x32(mx);
        f32x2 l2 = (f32x2){0.f, 0.f};
#pragma unroll
        for (int j = 0; j < 5; ++j)
#pragma unroll
            for (int rg = 0; rg < 16; rg += 2) { const f32x2 dd = (f32x2){p[j][rg], p[j][rg + 1]} - mx; const f32x2 ee = (f32x2){fast_exp2(dd.x), fast_exp2(dd.y)}; p[j][rg] = ee.x; p[j][rg + 1] = ee.y; l2 += ee; }
        float l = l2.x + l2.y;
        l = sum_x32(l);
        asm volatile("" : "+v"(l)); TS_END(4, lds, wid); TS_BEGIN(5);
        if (has_next) asm volatile("s_waitcnt vmcnt(10) lgkmcnt(0)\n\ts_barrier" ::: "memory"); else asm volatile("s_waitcnt vmcnt(0) lgkmcnt(0)\n\ts_barrier" ::: "memory");
        first = false;
        TS_END(5, lds, wid); TS_BEGIN(6);
        f32x16 o[2];
        const LAS char* vp0 = (const LAS char*)lds + AT_V + ((lane >> 4) & 1) * 32 + (lane & 3) * 8 + (4 * hi + ((lane & 15) >> 2)) * 128 + ((lane >> 3) & 1) * 64;
#if defined(REP_MASK) && ((REP_MASK >> 13) & 1)
        for (int rr_ = 0; rr_ < 2; ++rr_)
#endif
        {
            o[0] = f32x16{}; o[1] = f32x16{};
            s16x4 vl[2][2], vh[2][2];
            const LAS char* vpw0 = vp0 + (32 * wid) * 128;
            const LAS char* vpwd[2] = { vpw0, (const LAS char*)((unsigned)(uintptr_t)vpw0 ^ 64u) };
#pragma unroll
            for (int dh = 0; dh < 2; ++dh) { vl[0][dh] = vtr(vpwd[dh]); vh[0][dh] = vtr(vpwd[dh] + 1024); }
#pragma unroll
            for (int st = 0; st < 10; ++st) {
                const int j = st >> 1, s = st & 1;
                if (st < 9) {
#pragma unroll
                    for (int dh = 0; dh < 2; ++dh) { vl[(st + 1) & 1][dh] = vtr(vpwd[dh] + (st + 1) * 2048); vh[(st + 1) & 1][dh] = vtr(vpwd[dh] + (st + 1) * 2048 + 1024); }
                }
                v4u pw; pw.x = pkbf(p[j][8 * s + 0], p[j][8 * s + 1]); pw.y = pkbf(p[j][8 * s + 2], p[j][8 * s + 3]); pw.z = pkbf(p[j][8 * s + 4], p[j][8 * s + 5]); pw.w = pkbf(p[j][8 * s + 6], p[j][8 * s + 7]);
                const bf16x8 pa = __builtin_bit_cast(bf16x8, pw);
                __builtin_amdgcn_s_setprio(1);
#pragma unroll
                for (int dh = 0; dh < 2; ++dh) {
                    const s16x4 lo = vl[st & 1][dh], hv = vh[st & 1][dh];
                    const bf16x8 vf = (bf16x8){lo[0], lo[1], lo[2], lo[3], hv[0], hv[1], hv[2], hv[3]};
                    o[dh] = __builtin_amdgcn_mfma_f32_32x32x16_bf16(vf, pa, o[dh], 0, 0, 0);
                }
                __builtin_amdgcn_s_setprio(0);
                __builtin_amdgcn_sched_barrier(0);
            }
        }
        asm volatile("" : "+v"(o[0]), "+v"(o[1])); TS_END(6, lds, wid); TS_BEGIN(7);
        asm volatile("s_waitcnt lgkmcnt(0)\n\ts_barrier" ::: "memory");
        TS_END(7, lds, wid); TS_BEGIN(8);
        const size_t rowbase = (size_t)cur.b * SEQ;
        const size_t qtok = rowbase + (size_t)(cur.m0 + 32 * wid + r32) * cur.d + cur.r;
        if (hi == 0) *(GAS f32x2*)((GAS char*)ML + ((((size_t)cur.br * NTOK + qtok) * 8 + cur.h) * 2) * 4) = (f32x2){mx, l};
        const float rl = fast_rcp(l);
        LAS unsigned char* stg = lds + koff + wid * 4608;
#if defined(REP_MASK) && ((REP_MASK >> 14) & 1)
        for (int rr_ = 0; rr_ < 2; ++rr_) {
#else
        {
#endif
#pragma unroll
        for (int dh = 0; dh < 2; ++dh)
#pragma unroll
            for (int g4 = 0; g4 < 4; ++g4) { v2u w; w.x = pkbf(o[dh][4 * g4 + 0] * rl, o[dh][4 * g4 + 1] * rl); w.y = pkbf(o[dh][4 * g4 + 2] * rl, o[dh][4 * g4 + 3] * rl);
                *(LAS v2u*)(stg + r32 * 144 + (32 * dh + 8 * g4 + 4 * hi) * 2) = w; }
        LDS_WAIT();
#pragma unroll
        for (int i = 0; i < 4; ++i) { const int row = i * 8 + (lane >> 3), ch = lane & 7; const v4u v = *(const LAS v4u*)(stg + row * 144 + ch * 16);
            const size_t ot = rowbase + (size_t)(cur.m0 + 32 * wid + row) * cur.d + cur.r;
            *(GAS v4u*)((GAS char*)part + (((size_t)cur.br * NTOK + ot) * 512 + 64 * cur.h + ch * 8) * 2) = v; }
        }
        if (has_next) attn_issue_v(proj, nxt, lds0 + AT_V, wid, lane);
        TS_END(8, lds, wid); TS_BEGIN(9);
        asm volatile("s_waitcnt lgkmcnt(0)\n\ts_barrier" ::: "memory");
        TS_END(9, lds, wid);
        if (!has_next) break;
        cur = nxt; U = Un; kb ^= 1;
    }
}

constexpr int SG_ZT = 0, SG_ZT_STRIDE = 136  , SG_YT = 4 * 64 * SG_ZT_STRIDE * 2  , SG_END = SG_YT + 128 * 256 * 2;
static_assert(SG_END <= MISC_OFF, "sgu LDS");
static_assert(AT_END <= MISC_OFF, "attention LDS");
__device__ __forceinline__ void sgu_unit(const bf16* proj, bf16* mixed, const bf16* WS, const float* sgain, const float* sbias, int chunk, LAS unsigned char* lds, int wave_s) {
    const int lane = pg8::lane_id_v(), wid = wave_s, tid = wid * 64 + lane, r32 = lane & 31, hi = lane >> 5;
    const size_t tok0 = (size_t)chunk * 128;
    LAS bf16* znT = (LAS bf16*)(lds + SG_ZT);
    LAS bf16* yt = (LAS bf16*)(lds + SG_YT);
    TS_DECL(); TS_BEGIN(311);
    const int pce = tid & 31, g1 = pce >> 3, c1 = (pce & 7) * 8;
    f32x4 ga0 = *(const f32x4*)(sgain + g1 * 64 + c1), ga1 = *(const f32x4*)(sgain + g1 * 64 + c1 + 4);
    {
        v4u uvb[8], zvb[8];
#pragma unroll
        for (int it = 0; it < 8; ++it) { const bf16* rowp = proj + (tok0 + it * 16 + (tid >> 5)) * PW; uvb[it] = *(const v4u*)(rowp + OU + 8 * pce); zvb[it] = *(const v4u*)(rowp + OZ + 8 * pce); }
#pragma unroll
        for (int it = 0; it < 8; ++it) {
            const int t = it * 16 + (tid >> 5);
            *(LAS v4u*)(yt + t * 256 + 8 * pce) = uvb[it];
            const v4u zv = zvb[it];
            float z[8] = {bflo(zv.x), bfhi(zv.x), bflo(zv.y), bfhi(zv.y), bflo(zv.z), bfhi(zv.z), bflo(zv.w), bfhi(zv.w)};
            float s = 0.f;
#pragma unroll
            for (int e = 0; e < 8; ++e) s += z[e];
            s = sum_q4(sum_x2(sum_x1(s)));
            const float mean = s * (1.f / 64.f);
            float q = 0.f;
#pragma unroll
            for (int e = 0; e < 8; ++e) { z[e] -= mean; q += z[e] * z[e]; }
            q = sum_q4(sum_x2(sum_x1(q)));
            const float rstd = fast_rsq(q * (1.f / 64.f) + LN_EPS);
            v4u zw; zw.x = pkbf(z[0] * rstd * ga0[0], z[1] * rstd * ga0[1]); zw.y = pkbf(z[2] * rstd * ga0[2], z[3] * rstd * ga0[3]); zw.z = pkbf(z[4] * rstd * ga1[0], z[5] * rstd * ga1[1]); zw.w = pkbf(z[6] * rstd * ga1[2], z[7] * rstd * ga1[3]);
            *(LAS v4u*)((LAS unsigned char*)znT + ((g1 * 2 + (c1 >> 5)) * 128 + t) * 64 + (c1 & 31) * 2) = zw;
        }
    }
    __syncthreads();
    TS_END(311, lds, wid); TS_BEGIN(312);
    {
        const int g = wid >> 1, ct = wid & 1;
        const bf16* wg_ = WS + (size_t)g * 128 * 128;
        const LAS char* zb = (const LAS char*)znT + ((g * 2 + ct) * 128 + 4 * hi + ((lane & 15) >> 2)) * 64 + ((lane >> 4) & 1) * 32 + (lane & 3) * 8;
#pragma unroll
        for (int tt = 0; tt < 4; ++tt) {
            f32x16 a = {};
            bf16x8 af[8];
#pragma unroll
            for (int ks = 0; ks < 2 * (tt + 1); ++ks) af[ks] = *(const bf16x8*)(wg_ + (size_t)(32 * tt + r32) * 128 + 16 * ks + 8 * hi);
            f32x4 bb[4];
#pragma unroll
            for (int q4 = 0; q4 < 4; ++q4) bb[q4] = *(const f32x4*)(sbias + g * 128 + 32 * tt + 8 * q4 + 4 * hi);
#pragma unroll
            for (int ks = 0; ks < 2 * (tt + 1); ++ks) {
                const s16x4 lo = vtr(zb + ks * 1024), hv = vtr(zb + ks * 1024 + 512);
                const bf16x8 bfr = (bf16x8){lo[0], lo[1], lo[2], lo[3], hv[0], hv[1], hv[2], hv[3]};
                a = __builtin_amdgcn_mfma_f32_32x32x16_bf16(af[ks], bfr, a, 0, 0, 0);
            }
#pragma unroll
            for (int rg = 0; rg < 16; ++rg) { const int t = 32 * tt + crow(rg, hi); LAS bf16* yp = yt + t * 256 + 64 * g + 32 * ct + r32;
                const float uval = bf2f(*yp); const float y = uval * (a[rg] + bb[rg >> 2][rg & 3]); *yp = (bf16)(pkbf(y, 0.f) & 0xffffu); }
        }
    }
    __syncthreads();
    TS_END(312, lds, wid); TS_BEGIN(313);
#pragma unroll 1
    for (int i = 0; i < 16; i += 4) {
        float y[4][4], ss[4];
#pragma unroll
        for (int b = 0; b < 4; ++b) { const int t = wid * 16 + i + b; const v2u yv = *(const LAS v2u*)(yt + t * 256 + 4 * lane);
            y[b][0] = bflo(yv.x); y[b][1] = bfhi(yv.x); y[b][2] = bflo(yv.y); y[b][3] = bfhi(yv.y);
            ss[b] = (y[b][0] * y[b][0] + y[b][1] * y[b][1]) + (y[b][2] * y[b][2] + y[b][3] * y[b][3]); }
#pragma unroll
        for (int b = 0; b < 4; ++b) ss[b] = wave_sum(ss[b]);
#pragma unroll
        for (int b = 0; b < 4; ++b) { const int t = wid * 16 + i + b; const float rs = fast_rsq(ss[b] * (1.f / 256.f) + LN_EPS);
            v2u w; w.x = pkbf(y[b][0] * rs, y[b][1] * rs); w.y = pkbf(y[b][2] * rs, y[b][3] * rs);
            *(v2u*)(mixed + (tok0 + t) * DM + 512 + 4 * lane) = w; }
    }
    __syncthreads();
    TS_END(313, lds, wid);
}
struct Args { const float* in[17]; float* out; unsigned char* ws; int ph_lo, ph_hi, nlayers, pad; };

template <int NB>
__device__ __forceinline__ void combine_tokens(const bf16* part, const float* ML, bf16* mixed, size_t tok0, size_t tstride, int lane) {
    const int head = lane >> 3;
    f32x2 ml[NB][3]; v4u pv[NB][3];
#pragma unroll
    for (int b = 0; b < NB; ++b) { const size_t tok = tok0 + b * tstride;
#pragma unroll
        for (int br = 0; br < 3; ++br) { ml[b][br] = *(const f32x2*)(ML + (((size_t)br * NTOK + tok) * 8 + head) * 2); pv[b][br] = *(const v4u*)(part + ((size_t)br * NTOK + tok) * 512 + 8 * lane); } }
    float o[NB][8], ss[NB];
#pragma unroll
    for (int b = 0; b < NB; ++b) {
        const float M = fmaxf(ml[b][0].x, fmaxf(ml[b][1].x, ml[b][2].x));
        float w[3], W = 0.f;
#pragma unroll
        for (int br = 0; br < 3; ++br) { w[br] = ml[b][br].y * fast_exp2(ml[b][br].x - M); W += w[br]; }
        const float rW = 1.0f / W;
#pragma unroll
        for (int e = 0; e < 8; ++e) o[b][e] = 0.f;
#pragma unroll
        for (int br = 0; br < 3; ++br) { const float ww = w[br] * rW; const v4u p = pv[b][br];
            o[b][0] += ww * bflo(p.x); o[b][1] += ww * bfhi(p.x); o[b][2] += ww * bflo(p.y); o[b][3] += ww * bfhi(p.y);
            o[b][4] += ww * bflo(p.z); o[b][5] += ww * bfhi(p.z); o[b][6] += ww * bflo(p.w); o[b][7] += ww * bfhi(p.w); }
        float s = 0.f;
#pragma unroll
        for (int e = 0; e < 8; ++e) s += o[b][e] * o[b][e];
        ss[b] = s;
    }
#pragma unroll
    for (int b = 0; b < NB; ++b) ss[b] = wave_sum(ss[b]);
#pragma unroll
    for (int b = 0; b < NB; ++b) {
        const float rs = fast_rsq(ss[b] * (1.f / 512.f) + LN_EPS);
        v4u ov; ov.x = pkbf(o[b][0] * rs, o[b][1] * rs); ov.y = pkbf(o[b][2] * rs, o[b][3] * rs); ov.z = pkbf(o[b][4] * rs, o[b][5] * rs); ov.w = pkbf(o[b][6] * rs, o[b][7] * rs);
        *(v4u*)(mixed + (tok0 + b * tstride) * DM + 8 * lane) = ov;
    }
}
template <int NB>
__device__ __forceinline__ void conv_tokens(const bf16* proj, const float* cw, bf16* mixed, size_t tok0, size_t tstride, int lane) {
    const f32x4 w0 = *(const f32x4*)(cw + 4 * lane), w1 = *(const f32x4*)(cw + 256 + 4 * lane), w2 = *(const f32x4*)(cw + 512 + 4 * lane);
    v2u zz[NB][3], gb[NB];
#pragma unroll
    for (int b = 0; b < NB; ++b) { const size_t tok = tok0 + b * tstride; const int t = (int)(tok & (SEQ - 1));
#pragma unroll
        for (int j = 0; j < 3; ++j) { zz[b][j] = (v2u){0u, 0u};
            if (t - 2 + j >= 0) zz[b][j] = *(const v2u*)(proj + (tok - 2 + j) * PW + OGC + 4 * lane); }
        gb[b] = *(const v2u*)(proj + tok * PW + OGB + 4 * lane); }
    f32x4 y[NB]; float ss[NB];
#pragma unroll
    for (int b = 0; b < NB; ++b) {
        f32x4 acc = (f32x4){0.f, 0.f, 0.f, 0.f};
#pragma unroll
        for (int j = 0; j < 3; ++j) { const v2u g = zz[b][j];
            const f32x4 z = (f32x4){bflo(g.x), bfhi(g.x), bflo(g.y), bfhi(g.y)};
            acc += z * (j == 0 ? w0 : (j == 1 ? w1 : w2)); }
        y[b] = (f32x4){bflo(gb[b].x), bfhi(gb[b].x), bflo(gb[b].y), bfhi(gb[b].y)} * acc;
        ss[b] = (y[b][0] * y[b][0] + y[b][1] * y[b][1]) + (y[b][2] * y[b][2] + y[b][3] * y[b][3]);
    }
#pragma unroll
    for (int b = 0; b < NB; ++b) ss[b] = wave_sum(ss[b]);
#pragma unroll
    for (int b = 0; b < NB; ++b) {
        const float rs = fast_rsq(ss[b] * (1.f / 256.f) + LN_EPS);
        v2u w; w.x = pkbf(y[b][0] * rs, y[b][1] * rs); w.y = pkbf(y[b][2] * rs, y[b][3] * rs);
        *(v2u*)(mixed + (tok0 + b * tstride) * DM + 768 + 4 * lane) = w;
    }
}

struct RSel { int e0, e1, pbin; unsigned half0, r0, r1, rp; float g0, g1; bool own; };
__device__ __forceinline__ void route_block(const bf16* S, const bf16* Wrt  , const float* cr, const float* dr, const float* g1v, const float* b1v, bf16* XN, int* ELIST, int* EDEST, float* EGATE, int* PLIST, gu32* cnt  ,
                                            int blk, LAS unsigned char* lds, int wave_s) {
    const int lane = pg8::lane_id_v(), wid = wave_s, tid = wid * 64 + lane, t16 = lane & 15, q4 = lane >> 4;
    LAS unsigned* hist = (LAS unsigned*)(lds + TB_OFF) + TB_HIST;
    LAS unsigned* base = (LAS unsigned*)(lds + TB_OFF) + TB_BASE;
    if (tid < NCNT) hist[tid] = 0u;
    const unsigned tokA = (unsigned)blk * 256u + 32u * wid + t16, tokB = tokA + 16u;
    const bf16* srA = S + (size_t)tokA * DM + 8 * q4; const bf16* srB = S + (size_t)tokB * DM + 8 * q4;
    v4u ra[32], rb[32];
#pragma unroll
    for (int s = 0; s < 32; ++s) ra[s] = *(const v4u*)(srA + 32 * s);
    LAS float* gbl = (LAS float*)(lds + RING_OFF);
    { const f32x4 gq = *(const f32x4*)(((tid < 256) ? g1v : b1v) + 4 * (tid & 255)); *(LAS f32x4*)(gbl + 4 * tid) = gq; }
    LAS unsigned char* wl = lds + RING_OFF + 8192;
#pragma unroll
    for (int i = 0; i < 9; ++i) { const int pc = tid + 512 * i, p = pc >> 7, c16 = pc & 127;
        const int src = (p < 16) ? (8 * (p >> 2) + (p & 3)) : ((p < 32) ? (8 * ((p - 16) >> 2) + 4 + (p & 3)) : p);
        *(LAS v4u*)(wl + p * 2064 + c16 * 16) = *(const v4u*)(Wrt + (size_t)src * DM + c16 * 8); }
    __syncthreads();
    const LAS unsigned char* wa0 = wl + t16 * 2064 + 16 * q4; const LAS unsigned char* wa1 = wa0 + 16 * 2064; const LAS unsigned char* wa2 = wl + (32 + (t16 & 3)) * 2064 + 16 * q4;

#define RT_MM(r_, c0_, c1_, c2_, mu_, rstd_)                                                                                                                   \
    f32x4 c0_ = (f32x4){0.f, 0.f, 0.f, 0.f}, c1_ = c0_, c2_ = c0_; float mu_, rstd_;                                                                            \
    {   float ssum = 0.f, ssq = 0.f;                                                                                                                            \
        _Pragma("unroll") for (int s4 = 0; s4 < 32; s4 += 4) {                                                                                                  \
            bf16x8 A0[4], A1[4], A2[4];                                                                                                                         \
            _Pragma("unroll") for (int q = 0; q < 4; ++q) { A0[q] = *(const LAS bf16x8*)(wa0 + 64 * (s4 + q)); A1[q] = *(const LAS bf16x8*)(wa1 + 64 * (s4 + q)); A2[q] = *(const LAS bf16x8*)(wa2 + 64 * (s4 + q)); } \
            _Pragma("unroll") for (int q = 0; q < 4; ++q) { const v4u x = r_[s4 + q]; const bf16x8 bfr = __builtin_bit_cast(bf16x8, x);                        \
                c0_ = __builtin_amdgcn_mfma_f32_16x16x32_bf16(A0[q], bfr, c0_, 0, 0, 0);                                                                        \
                c1_ = __builtin_amdgcn_mfma_f32_16x16x32_bf16(A1[q], bfr, c1_, 0, 0, 0);                                                                        \
                c2_ = __builtin_amdgcn_mfma_f32_16x16x32_bf16(A2[q], bfr, c2_, 0, 0, 0);                                                                        \
                const float x0 = bflo(x.x), x1 = bfhi(x.x), x2 = bflo(x.y), x3 = bfhi(x.y), x4 = bflo(x.z), x5 = bfhi(x.z), x6 = bflo(x.w), x7 = bfhi(x.w);     \
                ssum += ((x0 + x1) + (x2 + x3)) + ((x4 + x5) + (x6 + x7));                                                                                      \
                ssq += ((x0 * x0 + x1 * x1) + (x2 * x2 + x3 * x3)) + ((x4 * x4 + x5 * x5) + (x6 * x6 + x7 * x7)); }                                             \
        }                                                                                                                                                       \
        ssum = sum_x32(sum_x16(ssum)); ssq = sum_x32(sum_x16(ssq));                                                                                             \
        mu_ = ssum * (1.f / 1024.f); const float var = ssq * (1.f / 1024.f) - mu_ * mu_; rstd_ = fast_rsq(var + LN_EPS); }

#define RT_SEL(sel_, c0_, c1_, c2_, mu_, rstd_)                                                                                                                 \
    RSel sel_;                                                                                                                                                  \
    {   const float rsmu = rstd_ * mu_;                                                                                                                         \
        const f32x4 crA = *(const f32x4*)(cr + 8 * q4), crB = *(const f32x4*)(cr + 8 * q4 + 4), drA = *(const f32x4*)(dr + 8 * q4), drB = *(const f32x4*)(dr + 8 * q4 + 4); \
        const f32x4 crG = *(const f32x4*)(cr + 32), drG = *(const f32x4*)(dr + 32);                                                                             \
        const f32x4 gl = rstd_ * c2_ - rsmu * crG + drG;                                                                                                        \
        float gmax = gl[0]; int gi = 0;                                                                                                                         \
        if (gl[1] > gmax) { gmax = gl[1]; gi = 1; }                                                                                                             \
        if (gl[2] > gmax) { gmax = gl[2]; gi = 2; }                                                                                                             \
        if (gl[3] > gmax) { gmax = gl[3]; gi = 3; }                                                                                                             \
        const float gp = 1.0f / (expf(gl[0] - gmax) + expf(gl[1] - gmax) + expf(gl[2] - gmax) + expf(gl[3] - gmax));                                            \
        const f32x4 ea = rstd_ * c0_ - rsmu * crA + drA, eb = rstd_ * c1_ - rsmu * crB + drB;                                                                   \
        float v0 = -INFINITY, v1 = -INFINITY; int i0 = 0, i1 = 0;                                                                                               \
        _Pragma("unroll") for (int j = 0; j < 8; ++j) { const float v = (j < 4) ? ea[j & 3] : eb[j & 3];                                                        \
            if (v > v0) { v1 = v0; i1 = i0; v0 = v; i0 = j; } else if (v > v1) { v1 = v; i1 = j; } }                                                            \
        const float e1 = expf(v1 - v0);                                                                                                                         \
        sel_.g0 = gp / (1.0f + e1); sel_.g1 = gp * e1 / (1.0f + e1);                                                                                            \
        sel_.e0 = gi * 8 + i0; sel_.e1 = gi * 8 + i1;                                                                                                           \
        const int ia = i0 < i1 ? i0 : i1, ib = i0 < i1 ? i1 : i0;                                                                                               \
        sel_.pbin = gi * 28 + ((ia * (15 - ia)) >> 1) + (ib - ia - 1);                                                                                          \
        sel_.half0 = (i0 < i1) ? 0u : 1u;                                                                                                                       \
        sel_.own = (q4 == gi); sel_.r0 = 0u; sel_.r1 = 0u; sel_.rp = 0u;                                                                                        \
        if (sel_.own) { sel_.r0 = __hip_atomic_fetch_add(hist + sel_.e0, 1u, __ATOMIC_RELAXED, __HIP_MEMORY_SCOPE_WORKGROUP); sel_.r1 = __hip_atomic_fetch_add(hist + sel_.e1, 1u, __ATOMIC_RELAXED, __HIP_MEMORY_SCOPE_WORKGROUP); \
                        sel_.rp = __hip_atomic_fetch_add(hist + NEB + sel_.pbin, 1u, __ATOMIC_RELAXED, __HIP_MEMORY_SCOPE_WORKGROUP); } }

#define RT_NORM(r_, xrow_, mu_, rstd_, PREF_)                                                                                                                   \
    _Pragma("unroll") for (int s = 0; s < 32; ++s) { v4u x = r_[s]; asm volatile("" : "+v"(x));        \
        const f32x4 ga = *(const LAS f32x4*)(gbl + 32 * s + 8 * q4), gb = *(const LAS f32x4*)(gbl + 32 * s + 8 * q4 + 4), ba = *(const LAS f32x4*)(gbl + 1024 + 32 * s + 8 * q4), bb = *(const LAS f32x4*)(gbl + 1024 + 32 * s + 8 * q4 + 4); \
        f32x4 x0 = (f32x4){bflo(x.x), bfhi(x.x), bflo(x.y), bfhi(x.y)}, x1 = (f32x4){bflo(x.z), bfhi(x.z), bflo(x.w), bfhi(x.w)};                               \
        x0 = (x0 - mu_) * rstd_ * ga + ba; x1 = (x1 - mu_) * rstd_ * gb + bb;                                                                                   \
        v4u w; w.x = pkbf(x0[0], x0[1]); w.y = pkbf(x0[2], x0[3]); w.z = pkbf(x1[0], x1[1]); w.w = pkbf(x1[2], x1[3]);                                          \
        *(v4u*)(xrow_ + 32 * s) = w;                                                                                                                            \
        PREF_                                                                                                                                                   \
        if ((s & 3) == 3) __builtin_amdgcn_sched_barrier(0); }

    RT_MM(ra, a0, a1, a2, muA, rstdA)
    { bf16* xrA = XN + (size_t)tokA * DM + 8 * q4;
      RT_NORM(ra, xrA, muA, rstdA, rb[s] = *(const v4u*)(srB + 32 * s);) }
    RT_SEL(selA, a0, a1, a2, muA, rstdA)
    RT_MM(rb, b0, b1, b2, muB, rstdB)
    RT_SEL(selB, b0, b1, b2, muB, rstdB)
    __syncthreads();
    unsigned gbase = 0u;
    const int tid2 = wid * 64 + pg8::lane_id_v();
    if (tid2 < NCNT) gbase = __hip_atomic_fetch_add(cnt + tid2, hist[tid2], RLX_AGENT);
    { bf16* xrB = XN + (size_t)tokB * DM + 8 * q4;
      RT_NORM(rb, xrB, muB, rstdB, ;) }
#undef RT_MM
#undef RT_SEL
#undef RT_NORM
    if (tid2 < NCNT) base[tid2] = gbase;
    __syncthreads();
#pragma unroll
    for (int g = 0; g < 2; ++g) { const RSel& sl = g ? selB : selA; const unsigned tok = g ? tokB : tokA;
        if (sl.own) {
            const unsigned ps = base[NEB + sl.pbin] + sl.rp;
            PLIST[(size_t)sl.pbin * NTOK + ps] = (int)tok;
            const size_t s0 = (size_t)sl.e0 * NTOK + base[sl.e0] + sl.r0, s1 = (size_t)sl.e1 * NTOK + base[sl.e1] + sl.r1;
            ELIST[s0] = (int)tok; EGATE[s0] = sl.g0; EDEST[s0] = (int)(((unsigned)sl.pbin << 18) | (ps << 1) | sl.half0);
            ELIST[s1] = (int)tok; EGATE[s1] = sl.g1; EDEST[s1] = (int)(((unsigned)sl.pbin << 18) | (ps << 1) | (sl.half0 ^ 1u));
        } }
    __syncthreads();
}

__device__ __forceinline__ void moe_setup(const gu32* cnt, const int* ELIST, const int* EDEST, const float* EGATE, const int* PLIST, int G, int vcu, LAS unsigned char* lds, int wave_s) {
    const int tid = wave_s * 64 + pg8::lane_id_v();
    LAS int* tb = (LAS int*)(lds + TB_OFF);
    LAS int* tbE = tb + TB_TBE; LAS int* clE = tb + TB_CLE; LAS int* tbP = tb + TB_TBP; LAS int* clP = tb + TB_CLP;
    LAS int* ut = (LAS int*)(lds + UT_OFF);
    LAS int* tab = (LAS int*)(lds + TAB_OFF); LAS float* tab2 = (LAS float*)(lds + TAB2_OFF); LAS unsigned short* gtab = (LAS unsigned short*)(lds + GTAB_OFF);
    if (tid < NEB) clE[tid] = (int)__hip_atomic_load(cnt + tid, RLX_AGENT);
    else if (tid < NCNT) clP[tid - NEB] = (int)__hip_atomic_load(cnt + tid, RLX_AGENT);
    __syncthreads();
    if (tid < NEB) { int a = 0; for (int j = 0; j < NEB; ++j) { const int tj = (clE[j] + 255) >> 8; a += (j < tid) ? tj : 0; if (tid == NEB - 1 && j == NEB - 1) tbE[NEB] = a + tj; } tbE[tid] = a; }
    else if (tid < NCNT) { const int me = tid - NEB; int a = 0; for (int j = 0; j < NPB; ++j) { const int tj = (clP[j] + 255) >> 8; a += (j < me) ? tj : 0; if (me == NPB - 1 && j == NPB - 1) tbP[NPB] = a + tj; } tbP[me] = a; }
    __syncthreads();
    LAS int* ut6 = (LAS int*)(lds + P6UT_OFF); LAS unsigned short* tab6 = (LAS unsigned short*)(lds + P6TAB_OFF);
    if (tid < NU_MAX) {
        const int L = tid * G + vcu;
        int nv = -1, tile = 0, pn = 0, bin = 0, rb = 0;
        if (L < tbE[NEB] * 4) { tile = L >> 2; pn = L & 3;
            for (int b = 0; b < NEB; ++b) if (tile >= tbE[b] && tile < tbE[b + 1]) bin = b;
            rb = (tile - tbE[bin]) * 256; nv = clE[bin] - rb; nv = nv > 256 ? 256 : nv; }
        ut[tid * 8 + 0] = tile; ut[tid * 8 + 1] = pn; ut[tid * 8 + 2] = bin; ut[tid * 8 + 3] = bin; ut[tid * 8 + 4] = rb; ut[tid * 8 + 5] = nv; ut[tid * 8 + 6] = tid;
    } else if (tid >= 64 && tid < 64 + NU6_MAX) {
        const int i6 = tid - 64, L = i6 * G + vcu;
        int nv = -1, tile = 0, pn = 0, bin = 0, rb = 0, e = 0, e2 = 0;
        if (L < tbP[NPB] * 4) { tile = L >> 2; pn = L & 3;
            for (int b = 0; b < NPB; ++b) if (tile >= tbP[b] && tile < tbP[b + 1]) bin = b;
            rb = (tile - tbP[bin]) * 256; nv = clP[bin] - rb; nv = nv > 256 ? 256 : nv;
            const int gi = bin / 28; int idx = bin % 28, ia = 0; while (idx >= 7 - ia) { idx -= 7 - ia; ++ia; }
            e = gi * 8 + ia; e2 = gi * 8 + ia + 1 + idx; }
        ut6[i6 * 8 + 0] = tile; ut6[i6 * 8 + 1] = pn; ut6[i6 * 8 + 2] = e; ut6[i6 * 8 + 3] = bin; ut6[i6 * 8 + 4] = rb; ut6[i6 * 8 + 5] = nv; ut6[i6 * 8 + 6] = e2;
    }
    __syncthreads();
    {
        constexpr int NE = NU_MAX * 256 / (NWAVES * 64), NE6 = NU6_MAX * 256 / (NWAVES * 64);
        int tokv[NE], dv[NE]; float gv[NE]; int tok6[NE6];
#pragma unroll
        for (int q = 0; q < NE; ++q) { const int en = tid + q * (NWAVES * 64), i = en >> 8, r = en & 255; const int nv = ut[i * 8 + 5];
            tokv[q] = 0; dv[q] = -1; gv[q] = 0.f;
            if (r < nv) { const size_t idx = (size_t)ut[i * 8 + 3] * NTOK + ut[i * 8 + 4] + r; tokv[q] = ELIST[idx]; dv[q] = EDEST[idx]; gv[q] = EGATE[idx]; } }
#pragma unroll
        for (int q = 0; q < NE6; ++q) { const int en = tid + q * (NWAVES * 64), i = en >> 8, r = en & 255; const int nv = ut6[i * 8 + 5];
            tok6[q] = 0xffff;
            if (r < nv) tok6[q] = PLIST[(size_t)ut6[i * 8 + 3] * NTOK + ut6[i * 8 + 4] + r]; }
#pragma unroll
        for (int q = 0; q < NE; ++q) { const int en = tid + q * (NWAVES * 64); gtab[en] = (unsigned short)tokv[q]; tab[en] = dv[q]; tab2[en] = gv[q]; }
#pragma unroll
        for (int q = 0; q < NE6; ++q) tab6[tid + q * (NWAVES * 64)] = (unsigned short)tok6[q];
    }
    __syncthreads();
    if (tid < NU6_MAX) ut6[tid * 8 + 4] = tid;
    __syncthreads();
}

__global__ void __launch_bounds__(NWAVES * 64, 2) mega_fwd(Args args) {
    extern __shared__ __attribute__((aligned(16))) unsigned char lds_raw[];
    LAS unsigned char* lds = (LAS unsigned char*)lds_raw;
    volatile LAS unsigned* MISC = (volatile LAS unsigned*)(lds + MISC_OFF);
    const int wave = __builtin_amdgcn_readfirstlane((int)threadIdx.x >> 6);
#define LANE_TID() const int lane = pg8::lane_id_v(); const int tid = wave * 64 + lane; (void)tid
    const int G = gridDim.x; const int bx = blockIdx.x; const int vcu = (G % 8 == 0) ? (bx % 8) * (G / 8) + bx / 8 : bx;
    unsigned char* ws_top = args.ws;
    gu32* ctl = (gu32*)(ws_top + WS_CTL);
#define WS_PTRS() GAS unsigned char* wsg_ = (GAS unsigned char*)ws_top; asm volatile("" : "+s"(wsg_)); unsigned char* ws = (unsigned char*)wsg_;     \
    float* VEC = (float*)(ws + WS_VEC); float* CS = (float*)(ws + WS_ROPE); \
    bf16* WIN = (bf16*)(ws + WS_WIN); bf16* WOUT = (bf16*)(ws + WS_WOUT); bf16* WRT = (bf16*)(ws + WS_WRT); bf16* WSGU = (bf16*)(ws + WS_WSGU); \
    bf16* WGU = (bf16*)(ws + WS_WGU); bf16* WD = (bf16*)(ws + WS_WD); \
    bf16* Sb = (bf16*)(ws + WS_S); float* ST = (float*)(ws + WS_ST); float* RS0 = (float*)(ws + WS_RS0); bf16* XN1 = (bf16*)(ws + WS_MIXED); \
    bf16* PROJ = (bf16*)(ws + WS_PROJ); bf16* MIXED = (bf16*)(ws + WS_MIXED); bf16* PART = (bf16*)(ws + WS_PART); float* ML = (float*)(ws + WS_ML); \
    bf16* Hb = (bf16*)(ws + WS_H); int* ELIST = (int*)(ws + WS_ELIST); int* EDEST = (int*)(ws + WS_EDEST); float* EGATE = (float*)(ws + WS_EGATE); int* PLIST = (int*)(ws + WS_PLIST); \
    (void)VEC; (void)CS; (void)WIN; (void)WOUT; (void)WRT; (void)WSGU; (void)WGU; (void)WD; (void)Sb; (void)ST; (void)RS0; (void)XN1; (void)PROJ; (void)MIXED; (void)PART; (void)ML; (void)Hb; (void)ELIST; (void)EDEST; (void)EGATE; (void)PLIST
    const float* x_in = args.in[0]; const float* w_in = args.in[1]; const float* w_out = args.in[2]; const float* branch_gain = args.in[3]; const float* sgu_gain = args.in[4];
    const float* sgu_w = args.in[5]; const float* sgu_b = args.in[6]; const float* conv_w = args.in[7]; const float* ln_gain = args.in[8]; const float* ln_bias = args.in[9];
    const float* rgw = args.in[10]; const float* rgb = args.in[11]; const float* rew = args.in[12]; const float* reb = args.in[13];
    const float* ewg = args.in[14]; const float* ewu = args.in[15]; const float* ewd = args.in[16];

    { LANE_TID(); for (int u = tid; u < (LDS_BYTES - TAB_OFF) / 4; u += NWAVES * 64) ((LAS unsigned*)(lds + TAB_OFF))[u] = 0u; }
    __syncthreads();
    XcdBarrier bar = xcd_barrier_post((unsigned*)(ctl + CW_BAR), MISC + 8);
    const int gw = vcu * NWAVES + wave, NGW = G * NWAVES;
    const bool own_rows = (G == NTOK / 256);
#define GU_CONVERT() do { const int lane_c = pg8::lane_id_v(); for (int it0 = gw; it0 < 2048; it0 += NGW) { \
        const int it = it0 >> 1, e = it >> 5, mat = (it >> 4) & 1, n0 = (it & 15) * 32, kh = (it0 & 1) * 512; \
        const float* W = (mat ? ewu : ewg) + ((size_t)l * 32 + e) * DM * 512; \
        conv_item3(W + (size_t)kh * 512, 512, 512, ColId(), n0, WGU + ((size_t)e * 1024 + (n0 >> 7) * 256 + ((n0 & 127) >> 5) * 32 + mat) * DM + kh, 2, scr, lane_c, DM, 1); } } while (0)
#define LOCAL_SEAM() do { asm volatile("s_waitcnt vmcnt(0)" ::: "memory"); __builtin_amdgcn_fence(__ATOMIC_RELEASE, "workgroup"); __syncthreads(); __builtin_amdgcn_fence(__ATOMIC_ACQUIRE, "workgroup"); } while (0)
#ifndef REP_MASK
#define REP_MASK 0
#endif
#define REPS(idx) for (int rep_ = 0; rep_ < 1 + ((REP_MASK >> (idx)) & 1); ++rep_)
#ifdef STAMP_A
    volatile LAS unsigned* tacc = (volatile LAS unsigned*)(lds + MISC_OFF + 64);
    unsigned long long t_last = __builtin_amdgcn_s_memrealtime();
#define STAMP(ty) do { const unsigned long long _n = __builtin_amdgcn_s_memrealtime(); if (wave == 0 && pg8::lane_id_v() == 0) tacc[ty] += (unsigned)(_n - t_last); t_last = _n; } while (0)
#else
#define STAMP(ty) do { } while (0)
#endif
    LAS float* scr = (LAS float*)(lds + RING_OFF + wave * 16384);
    const int lo = args.ph_lo, hi_ph = args.ph_hi;
#ifndef PHASE_MASK
#define PHASE_MASK 0xFFFFu
#endif
#define IN(k) (((PHASE_MASK >> ((k) == 0 ? 0 : ((k) == 99 ? 9 : 1 + (((k) - 1) & 15)))) & 1u) && lo <= (k) && (k) < hi_ph)

    if (IN(0)) REPS(0) {
        WS_PTRS(); LANE_TID();
        for (int i = gw * 64 + lane; i < 1024; i += NGW * 64) { VEC[V_ONES + i] = 1.0f; VEC[V_ZEROS + i] = 0.0f; }
        const int NRW = NGW - 512, rw = gw - 512;
        if (rw >= 0)
        for (int m0 = rw; m0 < NTOK; m0 += 8 * NRW) {
            f32x4 v[8][4];
#pragma unroll
            for (int b = 0; b < 8; ++b) { const int m = m0 + b * NRW; const GAS f32x4* xr = (const GAS f32x4*)(x_in + (size_t)(m < NTOK ? m : 0) * DM) + lane;
#pragma unroll
                for (int j = 0; j < 4; ++j) v[b][j] = xr[64 * j]; }
#pragma unroll
            for (int b = 0; b < 8; ++b) { const int m = m0 + b * NRW; if (m < NTOK) { GAS v2u* o8 = (GAS v2u*)(Sb + (size_t)m * DM) + lane;
#pragma unroll
                for (int j = 0; j < 4; ++j) { v2u w; w.x = pkbf(v[b][j][0], v[b][j][1]); w.y = pkbf(v[b][j][2], v[b][j][3]); o8[64 * j] = w; }
                if (lane < 32) ST[(size_t)m * 32 + lane] = (lane == 1) ? 1024.0f * (1.0f - LN_EPS) : 0.0f; } }
        }
        for (int i = gw * 64 + lane; i < SEQ * 32; i += NGW * 64) { const int t = i >> 5, f = i & 31; const float inv_freq = powf(10000.0f, -(float)f / 32.0f); const float ang = (float)t * inv_freq;
            float sn, cn; sincosf(ang, &sn, &cn); CS[2 * i] = cn; CS[2 * i + 1] = sn; }
        constexpr int I_IN = 4 * 88, I_OUT = 4 * 32;
        for (int it = gw; it < I_IN + I_OUT; it += NGW) {
            if (it < I_IN) { const int l = it / 88, nb = it % 88, n0 = nb * 32;
                const float* sc = (l == 0) ? nullptr : ln_gain + (size_t)(l - 1) * 2048 + 1024; const float* bk = (l == 0) ? nullptr : ln_bias + (size_t)(l - 1) * 2048 + 1024;
                bf16* wt = WIN + ((size_t)l * PW + n0) * DM; float* cs = VEC + V_CIN + l * PW + n0; float* ds = VEC + V_DIN + l * PW + n0;
                if (n0 < 1024) conv_item(w_in + (size_t)l * DM * PW, DM, PW, ColRope(), n0, wt, 1, sc, bk, cs, ds, scr, lane);
                else if (n0 >= OGC) conv_item(w_in + (size_t)l * DM * PW, DM, PW, ColConv(), n0, wt, 1, sc, bk, cs, ds, scr, lane);
                else conv_item(w_in + (size_t)l * DM * PW, DM, PW, ColId(), n0, wt, 1, sc, bk, cs, ds, scr, lane);
            } else { const int r = it - I_IN, l = r / 32, n0 = (r % 32) * 32;
                conv_item(w_out + (size_t)l * DM * DM, DM, DM, ColId(), n0, WOUT + ((size_t)l * DM + n0) * DM, 1, branch_gain + (size_t)l * 1024, nullptr, nullptr, nullptr, scr, lane); }
        }
        for (int i = gw * 64 + lane; i < 4 * 4 * 128 * 128; i += NGW * 64) {
            const int p = i & 15, s = (i & 112) + 8 * ((p & 7) >> 2) + 4 * (p >> 3) + (p & 3), t = (i >> 7) & 127; WSGU[i] = (bf16)(pkbf((s <= t) ? sgu_w[(i & ~127) + s] : 0.0f, 0.f) & 0xffffu); }
        for (int it = gw; it < 4 * 64; it += NGW) {
            const int l = it >> 6, n = it & 63; const float* g1 = ln_gain + (size_t)l * 2048; const float* b1 = ln_bias + (size_t)l * 2048;
            float cs = 0.f, ds = 0.f;
            for (int k = lane; k < DM; k += 64) { float w = 0.f; if (n < 32) w = rew[((size_t)l * DM + k) * 32 + n]; else if (n < 36) w = rgw[((size_t)l * DM + k) * 4 + (n - 32)];
                const float v = rbf(w * g1[k]); cs += v; ds += b1[k] * w; WRT[((size_t)l * 64 + n) * DM + k] = (bf16)(pkbf(v, 0.f) & 0xffffu); }
            cs = wave_sum(cs); ds = wave_sum(ds);
            if (lane == 0) { float bias = 0.f; if (n < 32) bias = reb[l * 32 + n]; else if (n < 36) bias = rgb[l * 4 + n - 32]; VEC[V_CR + l * 64 + n] = cs; VEC[V_DR + l * 64 + n] = ds + bias; }
        }
        xcd_barrier(bar);
        STAMP(0);
    }

    for (int l = 0; l < args.nlayers; ++l) {
        const int pb = 1 + l * 16;
        const float* G1 = ln_gain + (size_t)l * 2048; const float* B1 = ln_bias + (size_t)l * 2048;
        gu32* cnt = ctl + CW_CNT + l * 256;

        if (IN(pb + 0)) REPS(1) {
            WS_PTRS();
#ifdef STAGGER_P1
            if (vcu & 1) { const unsigned long long s0_ = __builtin_amdgcn_s_memrealtime(); while (__builtin_amdgcn_s_memrealtime() - s0_ < (unsigned long long)(STAGGER_P1)) __builtin_amdgcn_s_sleep(8); }
#endif
            pg8::Gemm g{Sb, WIN + (size_t)l * PW * DM, DM}; pg8::DenseOrder S; S.init(NTOK, PW, DM, G, bx);
            { LAS float* xt = (LAS float*)(lds + TAB_OFF); const int tid_ = wave * 64 + pg8::lane_id_v();
              for (int i = tid_; i < PW; i += NWAVES * 64) { xt[XT_C + i] = VEC[V_CIN + l * PW + i]; xt[XT_D + i] = VEC[V_DIN + l * PW + i]; }
              if (tid_ == 0) ((LAS int*)xt)[XT_LASTPM] = -1;
              __syncthreads(); }
            EpiProj E{PROJ, VEC + V_CIN + l * PW, VEC + V_DIN + l * PW, ST, RS0, CS, (LAS float*)(lds + TAB_OFF)};
            pg8::gemm_phase<EpiProj, pg8::DenseOrder, false>(lds + RING_OFF, g, S, E, nullptr, wave);
            xcd_barrier(bar);
            STAMP(1);
        }
        if (IN(pb + 1)) REPS(2) {
            WS_PTRS();
            attn_phase(PROJ, PART, ML, vcu, G, lds, wave);
            xcd_barrier(bar);
            STAMP(2);
        }
        if (IN(pb + 2)) REPS(3) {
            WS_PTRS(); LANE_TID();
            TS_DECL(); TS_BEGIN(301);
            if (own_rows) {
                const int cls = vcu & 3;
                if (cls == 1) { GU_CONVERT(); __syncthreads(); }
                const size_t t0 = (size_t)vcu * 256 + wave * 32;
#pragma unroll 1
                for (int st = 0; st < 2; ++st) {
                    if ((st == 0) == ((cls & 1) != 0)) { for (int c = 2 * vcu; c < 2 * vcu + 2; ++c) sgu_unit(PROJ, MIXED, WSGU + (size_t)l * 4 * 128 * 128, sgu_gain + (size_t)l * 256, sgu_b + (size_t)l * 512, c, lds, wave); }
                    else { for (int j = 0; j < 32; j += 4) { combine_tokens<4>(PART, ML, MIXED, t0 + j, (size_t)1, lane); conv_tokens<4>(PROJ, conv_w + (size_t)l * 768, MIXED, t0 + j, (size_t)1, lane); } }
                }
                if (cls == 2) { __syncthreads(); GU_CONVERT(); }
                LOCAL_SEAM();
            } else {
            for (int c = vcu; c < NTOK / 128; c += G) sgu_unit(PROJ, MIXED, WSGU + (size_t)l * 4 * 128 * 128, sgu_gain + (size_t)l * 256, sgu_b + (size_t)l * 512, c, lds, wave);
            TS_END(301, lds, wave); TS_BEGIN(302);
            for (int m = gw; m < NTOK; m += 4 * NGW) { combine_tokens<4>(PART, ML, MIXED, (size_t)m, (size_t)NGW, lane); conv_tokens<4>(PROJ, conv_w + (size_t)l * 768, MIXED, (size_t)m, (size_t)NGW, lane); }
            TS_END(302, lds, wave);
            xcd_barrier(bar);
            }
            STAMP(3);
        }
        if (IN(pb + 3)) REPS(4) {
            WS_PTRS();
            pg8::Gemm g{MIXED, WOUT + (size_t)l * DM * DM, DM}; pg8::DenseOrder S; S.init(NTOK, DM, DM, G, bx); if (own_rows) S.own_pm = vcu;
            const float* Gp = (l == 0) ? VEC + V_ONES : ln_gain + (size_t)(l - 1) * 2048 + 1024;
            const float* Bp = (l == 0) ? VEC + V_ZEROS : ln_bias + (size_t)(l - 1) * 2048 + 1024;
            EpiRes1 E{Sb, RS0, Gp, Bp, (rep_ == ((REP_MASK >> 4) & 1)) ? Sb : PROJ};
            pg8::gemm_phase<EpiRes1, pg8::DenseOrder, false>(lds + RING_OFF, g, S, E, nullptr, wave);
            if (own_rows) { LOCAL_SEAM(); if ((vcu & 3) == 3) { GU_CONVERT(); __syncthreads(); } } else xcd_barrier(bar);
            STAMP(4);
        }
        if (IN(pb + 4)) REPS(5) {
            WS_PTRS(); LANE_TID();
            for (int blk = vcu; blk < NTOK / 256; blk += G) route_block(Sb, WRT + (size_t)l * 64 * DM, VEC + V_CR + l * 64, VEC + V_DR + l * 64, G1, B1, XN1, ELIST, EDEST, EGATE, PLIST, cnt, blk, lds, wave);
            if (!own_rows || (vcu & 3) == 0) GU_CONVERT();
            xcd_barrier(bar);
            STAMP(5);
        }
        if (IN(pb + 5)) REPS(6) {
            WS_PTRS();
            { TS_DECL(); TS_BEGIN(501); moe_setup(cnt, ELIST, EDEST, EGATE, PLIST, G, vcu, lds, wave); TS_END(501, lds, wave); }
            pg8::Gemm g{XN1, WGU, DM}; MoeOrder S{(const LAS int*)(lds + UT_OFF), DM, DM, (size_t)1024 * DM * 2, NU_MAX};
            EpiSwiglu E{Hb, (const LAS int*)(lds + TAB_OFF), (const LAS float*)(lds + TAB2_OFF), (const LAS int*)(lds + TB_OFF) + TB_TBP};
            pg8::gemm_phase<EpiSwiglu, MoeOrder, true, false>(lds + RING_OFF, g, S, E, (const LAS unsigned short*)(lds + GTAB_OFF), wave);
            {   const int T5 = __builtin_amdgcn_readfirstlane(((const LAS int*)(lds + TB_OFF))[TB_TBE + NEB]) * 4, nmax = (T5 + G - 1) / G;
                int x = T5 - (nmax - 1) * G; if (x >= G) x = 0;
                if (vcu >= x) { LANE_TID(); __syncthreads();
                    for (int it = (vcu - x) * NWAVES + wave; it < 1024; it += (G - x) * NWAVES) { const int e = it >> 5, n0 = (it & 31) * 32;
                        conv_item3(ewd + ((size_t)l * 32 + e) * 512 * DM, 512, DM, ColId(), n0, WD + ((size_t)e * 1024 + n0) * 512, 1, scr, lane); } } }
            xcd_barrier(bar);
            STAMP(6);
        }
        if (IN(pb + 6)) REPS(7) {
            WS_PTRS();
            pg8::Gemm g{Hb, WD, DM}; MoeOrder S{(const LAS int*)(lds + P6UT_OFF), DM, 512, (size_t)1024 * 512 * 2, NU6_MAX};
            EpiDown E{Sb, XN1, (const LAS unsigned short*)(lds + P6TAB_OFF), ST};
            pg8::gemm_phase<EpiDown, MoeOrder, false, true>(lds + RING_OFF, g, S, E, nullptr, wave);
            xcd_barrier(bar);
            STAMP(7);
        }
    }
    if (IN(99)) REPS(9) {
        WS_PTRS(); LANE_TID();
        const int l = args.nlayers - 1;
        const float* G2 = ln_gain + (size_t)l * 2048 + 1024; const float* B2 = ln_bias + (size_t)l * 2048 + 1024;
        const unsigned poison = (__hip_atomic_load(ctl + CW_BAR + XB_TMO, RLX_AGENT) != 0u);
        for (int m0 = gw; m0 < NTOK; m0 += 4 * NGW) {
            float s[4], q[4]; v4u o[4][2];
#pragma unroll
            for (int b = 0; b < 4; ++b) { const int m = m0 + b * NGW; s[b] = 0.f; q[b] = 0.f;
                if (lane < 16) { const f32x2 p = *(const f32x2*)(ST + (size_t)m * 32 + 2 * lane); s[b] = p.x; q[b] = p.y; }
#pragma unroll
                for (int j = 0; j < 2; ++j) o[b][j] = *(const v4u*)(Sb + (size_t)m * DM + 512 * j + 8 * lane); }
#pragma unroll
            for (int b = 0; b < 4; ++b) { s[b] = wave_sum(s[b]); q[b] = wave_sum(q[b]); }
#pragma unroll
            for (int b = 0; b < 4; ++b) { const int m = m0 + b * NGW;
                const float mu = s[b] * (1.f / 1024.f); const float var = q[b] * (1.f / 1024.f) - mu * mu; float rstd = fast_rsq(var + LN_EPS);
                if (poison) rstd = __builtin_nanf("");
#pragma unroll
                for (int j = 0; j < 2; ++j) {
                    const int c = 512 * j + 8 * lane;
                    const f32x4 g0 = *(const f32x4*)(G2 + c), g1 = *(const f32x4*)(G2 + c + 4), b0 = *(const f32x4*)(B2 + c), b1 = *(const f32x4*)(B2 + c + 4);
                    f32x4 x0 = (f32x4){bflo(o[b][j].x), bfhi(o[b][j].x), bflo(o[b][j].y), bfhi(o[b][j].y)}, x1 = (f32x4){bflo(o[b][j].z), bfhi(o[b][j].z), bflo(o[b][j].w), bfhi(o[b][j].w)};
                    x0 = (x0 - mu) * rstd * g0 + b0; x1 = (x1 - mu) * rstd * g1 + b1;
                    *(f32x4*)(args.out + (size_t)m * DM + c) = x0; *(f32x4*)(args.out + (size_t)m * DM + c + 4) = x1;
                } }
        }
    }
#undef IN
#ifdef TSEC
    { __syncthreads(); const unsigned tot = ((volatile LAS unsigned*)(lds + MISC_OFF + 64))[wave]; const unsigned long long s0 = __builtin_amdgcn_s_memrealtime();
      while (__builtin_amdgcn_s_memrealtime() - s0 < (unsigned long long)tot) __builtin_amdgcn_s_sleep(8); }
#endif
}

static int g_grid = 0;
static int mega_prepare() {
    if (g_grid != 0) return g_grid;
    int dev = 0, cus = 0, per_cu = 0;
    if (hipGetDevice(&dev) != hipSuccess || hipDeviceGetAttribute(&cus, hipDeviceAttributeMultiprocessorCount, dev) != hipSuccess) { g_grid = -1; return g_grid; }
    if (hipFuncSetAttribute((const void*)mega_fwd, hipFuncAttributeMaxDynamicSharedMemorySize, LDS_BYTES) != hipSuccess) { fprintf(stderr, "hipFuncSetAttribute failed\n"); g_grid = -1; return g_grid; }
    if (hipOccupancyMaxActiveBlocksPerMultiprocessor(&per_cu, (const void*)mega_fwd, NWAVES * 64, LDS_BYTES) != hipSuccess || per_cu < 1) { fprintf(stderr, "occupancy query: %d blocks per CU\n", per_cu); }
    (void)hipGetLastError();
    g_grid = cus;
    return g_grid;
}
static void mega_launch(void* const* d_in, float* out, unsigned char* ws, hipStream_t stream, int ph_lo, int ph_hi, int nlayers) {
    const int grid = mega_prepare(); if (grid <= 0) return;
    (void)hipMemsetAsync(ws + WS_CTL, 0, CTL_ZERO_BYTES, stream);
    Args a{};
    for (int i = 0; i < 17; ++i) a.in[i] = (const float*)d_in[i];
    a.out = out; a.ws = ws; a.ph_lo = ph_lo; a.ph_hi = ph_hi; a.nlayers = nlayers; a.pad = 0;
    hipLaunchKernelGGL(mega_fwd, dim3(grid), dim3(NWAVES * 64), LDS_BYTES, stream, a);
}
extern "C" void kernel_launch(void* const* d_in, const int* in_sizes, int n_in, void* d_out, int out_size, void* d_ws, size_t ws_size, hipStream_t stream) {
    if (n_in != 17 || ws_size < WS_END) { fprintf(stderr, "kernel_launch: unexpected n_in %d / ws_size %zu\n", n_in, ws_size); return; }
    mega_launch(d_in, (float*)d_out, (unsigned char*)d_ws, stream, 0, 100, NL);
}
```
